# Optimizing an MI355X kernel written in HIP

```python
import jax, jax.numpy as jnp
from jax import lax
import numpy as np

D_MODEL = 2048
BATCH = 1
SEQ = 8192
DEPTH = 1

N_META = 16
D_MIX = D_MODEL
GLA_HEADS = 4
GLA_DK = 128
GLA_DV = 256
GLA_DK_TOT = GLA_HEADS * GLA_DK
GLA_DV_TOT = GLA_HEADS * GLA_DV
GLA_RANK = 16
GLA_TAU = 16.0
GLA_CHUNK = 64
FOX_HEADS = 8
FOX_HD = 128
FOX_W = FOX_HEADS * FOX_HD
FOX_BLOCK = 128
PAD_FRONT = FOX_BLOCK - N_META
N_GROUPS = 4
EXPERTS_PER_GROUP = 8
TOP_K = 2
D_EXPERT = 512
EPS = 1e-6
SPLIT_SIZES = (FOX_W, FOX_W, FOX_W, FOX_HEADS, GLA_DK_TOT, GLA_DK_TOT, GLA_DV_TOT, GLA_DV_TOT, GLA_RANK)
D_IN_PROJ = 3 * FOX_W + FOX_HEADS + 2 * GLA_DK_TOT + 2 * GLA_DV_TOT + GLA_RANK

kernel_name = "hymba_gla_fox_hiermoe_block"


def _rmsnorm(x, g):
    xf = x.astype(jnp.float32)
    y = xf * lax.rsqrt(jnp.mean(xf * xf, axis=-1, keepdims=True) + EPS)
    return (y * g.astype(jnp.float32)).astype(x.dtype)


def _pad_front(a):
    return jnp.pad(a, [(0, 0), (PAD_FRONT, 0)] + [(0, 0)] * (a.ndim - 2))


def _split_cols(proj):
    out = []
    start = 0
    for s in SPLIT_SIZES:
        out.append(proj[..., start:start + s])
        start += s
    return out


def gla_mixer(q, k, v, r, z, w_gate2, b_gate, norm_g):
    f32 = jnp.float32
    B, L, _ = q.shape
    T = L + PAD_FRONT
    C = GLA_CHUNK
    N = T // C
    log_a = jax.nn.log_sigmoid((z @ w_gate2).astype(f32) + b_gate.astype(f32)) / GLA_TAU

    def heads(a, d):
        return _pad_front(a.astype(f32).reshape(B, L, GLA_HEADS, d))

    def chunks(a):
        return a.reshape(B, N, C, GLA_HEADS, a.shape[-1])

    qc = chunks(heads(q, GLA_DK) * GLA_DK ** -0.5)
    kc = chunks(heads(k, GLA_DK))
    vc = chunks(heads(v, GLA_DV))
    gc = chunks(heads(log_a, GLA_DK))
    b = jnp.cumsum(gc, axis=2)
    b_ref = b[:, :, C // 2:C // 2 + 1]
    b_last = b[:, :, C - 1:]
    causal = jnp.tril(jnp.ones((C, C), dtype=bool))
    A = jnp.einsum('bnihd,bnjhd->bnhij', qc * jnp.exp(b - b_ref), kc * jnp.exp(b_ref - b))
    A = jnp.where(causal, A, 0.0)
    o_intra = jnp.einsum('bnhij,bnjhv->bnihv', A, vc)
    U = jnp.einsum('bnjhd,bnjhv->bnhdv', kc * jnp.exp(b_last - b), vc)
    decay = jnp.exp(b_last[:, :, 0])

    def step(S, inp):
        dec, u = inp
        return dec[..., None] * S + u, S

    S0 = jnp.zeros((B, GLA_HEADS, GLA_DK, GLA_DV), f32)
    _, S_prev = lax.scan(step, S0, (jnp.moveaxis(decay, 1, 0), jnp.moveaxis(U, 1, 0)))
    S_prev = jnp.moveaxis(S_prev, 0, 1)
    o_inter = jnp.einsum('bnihd,bnhdv->bnihv', qc * jnp.exp(b), S_prev)
    o = (o_intra + o_inter).reshape(B, T, GLA_HEADS, GLA_DV)[:, PAD_FRONT:]
    o = _rmsnorm(o, norm_g) * jax.nn.silu(r.astype(f32).reshape(B, L, GLA_HEADS, GLA_DV))
    return o.reshape(B, L, GLA_DV_TOT)


def fox_mixer(q, k, v, f_logit, b_f, norm_g):
    f32 = jnp.float32
    B, L, _ = q.shape
    T = L + PAD_FRONT

    def heads(a):
        return _pad_front(a.astype(f32).reshape(B, L, FOX_HEADS, FOX_HD))

    qh = heads(q) * FOX_HD ** -0.5
    kh = heads(k)
    vh = heads(v)
    log_f = _pad_front(jax.nn.log_sigmoid(f_logit.astype(f32) + b_f.astype(f32)))
    c = jnp.cumsum(log_f, axis=1).transpose(0, 2, 1)
    neg = jnp.finfo(f32).min
    outs = []
    for i in range(T // FOX_BLOCK):
        q0, q1 = i * FOX_BLOCK, (i + 1) * FOX_BLOCK
        s = jnp.einsum('bqhd,bkhd->bhqk', qh[:, q0:q1], kh[:, :q1])
        s = s + c[:, :, q0:q1, None] - c[:, :, None, :q1]
        qpos = jnp.arange(q0, q1)[:, None]
        kpos = jnp.arange(q1)[None, :]
        mask = (kpos <= qpos) & (kpos >= PAD_FRONT)
        p = jax.nn.softmax(jnp.where(mask, s, neg), axis=-1)
        outs.append(jnp.einsum('bhqk,bkhd->bqhd', p, vh[:, :q1]))
    o = jnp.concatenate(outs, axis=1)[:, PAD_FRONT:]
    o = _rmsnorm(o, norm_g)
    return o.reshape(B, L, FOX_W)


def hier_moe(u, w_rg, b_rg, w_re, b_re, w_g, w_u, w_d):
    f32 = jnp.float32
    B, L, D = u.shape
    xt = u.reshape(B * L, D)
    p_group = jax.nn.softmax((xt @ w_rg).astype(f32) + b_rg.astype(f32), axis=-1)
    g_idx = jnp.argmax(p_group, axis=-1)
    p_g = jnp.max(p_group, axis=-1)
    e_logits = jnp.einsum('nd,gde->nge', xt, w_re).astype(f32) + b_re.astype(f32)
    e_logits = jnp.take_along_axis(e_logits, g_idx[:, None, None], axis=1)[:, 0]
    p_e = jax.nn.softmax(e_logits, axis=-1)
    top_v, top_i = lax.top_k(p_e, TOP_K)
    top_v = top_v / jnp.sum(top_v, axis=-1, keepdims=True)
    w_sel = jnp.sum(jax.nn.one_hot(top_i, EXPERTS_PER_GROUP, dtype=f32) * top_v[..., None], axis=1)
    combine = (jax.nn.one_hot(g_idx, N_GROUPS, dtype=f32) * p_g[:, None])[:, :, None] * w_sel[:, None, :]
    y = jnp.zeros((B * L, D), f32)
    for g in range(N_GROUPS):
        hg = jax.nn.silu(jnp.einsum('nd,edf->nef', xt, w_g[g])) * jnp.einsum('nd,edf->nef', xt, w_u[g])
        y = y + jnp.einsum('nef,efd->nd', hg * combine[:, g, :, None].astype(hg.dtype), w_d[g])
    return y.astype(u.dtype).reshape(B, L, D)


def setup_inputs(seed: int = 0) -> dict:
    key = jax.random.key(seed)
    ks = jax.random.split(key, 20)
    nrm = jax.random.normal
    D = D_MODEL
    return {
        "x": nrm(ks[0], (BATCH, SEQ, D), jnp.float32),
        "meta_tokens": nrm(ks[1], (N_META, D), jnp.float32),
        "norm1_g": 1.0 + 0.02 * nrm(ks[2], (DEPTH, D), jnp.float32),
        "w_in": nrm(ks[3], (DEPTH, D, D_IN_PROJ), jnp.float32) * D ** -0.5,
        "b_fox_f": 3.0 + 0.1 * nrm(ks[4], (DEPTH, FOX_HEADS), jnp.float32),
        "gla_w_gate2": nrm(ks[5], (DEPTH, GLA_RANK, GLA_DK_TOT), jnp.float32) * GLA_RANK ** -0.5,
        "gla_b_gate": 0.1 * nrm(ks[6], (DEPTH, GLA_DK_TOT), jnp.float32),
        "gla_norm_g": 1.0 + 0.02 * nrm(ks[7], (DEPTH, GLA_DV), jnp.float32),
        "fox_norm_g": 1.0 + 0.02 * nrm(ks[8], (DEPTH, FOX_HD), jnp.float32),
        "w_out": nrm(ks[9], (DEPTH, D_MIX, D), jnp.float32) * D_MIX ** -0.5,
        "norm2_g": 1.0 + 0.02 * nrm(ks[10], (DEPTH, D), jnp.float32),
        "w_router_group": nrm(ks[11], (DEPTH, D, N_GROUPS), jnp.float32) * D ** -0.5,
        "b_router_group": 0.01 * nrm(ks[12], (DEPTH, N_GROUPS), jnp.float32),
        "w_router_expert": nrm(ks[13], (DEPTH, N_GROUPS, D, EXPERTS_PER_GROUP), jnp.float32) * D ** -0.5,
        "b_router_expert": 0.01 * nrm(ks[14], (DEPTH, N_GROUPS, EXPERTS_PER_GROUP), jnp.float32),
        "w_exp_gate": nrm(ks[15], (DEPTH, N_GROUPS, EXPERTS_PER_GROUP, D, D_EXPERT), jnp.float32) * D ** -0.5,
        "w_exp_up": nrm(ks[16], (DEPTH, N_GROUPS, EXPERTS_PER_GROUP, D, D_EXPERT), jnp.float32) * D ** -0.5,
        "w_exp_down": nrm(ks[17], (DEPTH, N_GROUPS, EXPERTS_PER_GROUP, D_EXPERT, D), jnp.float32) * D_EXPERT ** -0.5,
        "norm_f_g": 1.0 + 0.02 * nrm(ks[18], (D,), jnp.float32),
    }


def reference(x, meta_tokens, norm1_g, w_in, b_fox_f, gla_w_gate2, gla_b_gate, gla_norm_g, fox_norm_g,
              w_out, norm2_g, w_router_group, b_router_group, w_router_expert, b_router_expert,
              w_exp_gate, w_exp_up, w_exp_down, norm_f_g):
    B = x.shape[0]
    meta = jnp.broadcast_to(meta_tokens[None].astype(x.dtype), (B, N_META, D_MODEL))
    h = jnp.concatenate([meta, x], axis=1)
    for l in range(DEPTH):
        u = _rmsnorm(h, norm1_g[l])
        proj = u @ w_in[l]
        fq, fk, fv, ff, gq, gk, gv, gr, gz = _split_cols(proj)
        o_gla = gla_mixer(gq, gk, gv, gr, gz, gla_w_gate2[l], gla_b_gate[l], gla_norm_g[l])
        o_fox = fox_mixer(fq, fk, fv, ff, b_fox_f[l], fox_norm_g[l])
        mix = jnp.concatenate([o_gla, o_fox], axis=-1).astype(h.dtype)
        h = h + mix @ w_out[l]
        u2 = _rmsnorm(h, norm2_g[l])
        h = h + hier_moe(u2, w_router_group[l], b_router_group[l], w_router_expert[l], b_router_expert[l],
                         w_exp_gate[l], w_exp_up[l], w_exp_down[l])
    out = _rmsnorm(h, norm_f_g)[:, N_META:]
    return out
```

```cpp
#include <hip/hip_runtime.h>
#include <stdint.h>
#include <cstdio>
#ifndef FOX_SKIP
#define FOX_SKIP 1
#endif
#ifndef DUP_PHASE
#define DUP_PHASE 0
#endif

typedef unsigned short bf16_t;
#define DM 2048
#define SEQ 8192
#define NMETA 16
#define LR 8256
#define NR_A0 8448
#define NPROJ 6168
#define EPS 1e-6f
#define SCALE128 0.08838834764831845f

__device__ __forceinline__ float bf2f(bf16_t b) { return __uint_as_float(((unsigned)b) << 16); }
__device__ __forceinline__ bf16_t f2bf(float f) { unsigned u = __float_as_uint(f); return (bf16_t)((u + 0x7fffu + ((u >> 16) & 1u)) >> 16); }
__device__ __forceinline__ unsigned pk2(float lo, float hi) { return (unsigned)f2bf(lo) | ((unsigned)f2bf(hi) << 16); }
template <int M> __device__ __forceinline__ float sw_xor(float v) { return __int_as_float(__builtin_amdgcn_ds_swizzle(__float_as_int(v), (M << 10) | 0x1f)); }
__device__ __forceinline__ float x32_sum(float v) { auto r = __builtin_amdgcn_permlane32_swap(__float_as_uint(v), __float_as_uint(v), false, false); return __uint_as_float(r[0]) + __uint_as_float(r[1]); }
__device__ __forceinline__ float x32_max(float v) { auto r = __builtin_amdgcn_permlane32_swap(__float_as_uint(v), __float_as_uint(v), false, false); return fmaxf(__uint_as_float(r[0]), __uint_as_float(r[1])); }
__device__ __forceinline__ float wave_sum(float v) { v += sw_xor<1>(v); v += sw_xor<2>(v); v += sw_xor<4>(v); v += sw_xor<8>(v); v += sw_xor<16>(v); return x32_sum(v); }
__device__ __forceinline__ float wave_max(float v) { v = fmaxf(v, sw_xor<1>(v)); v = fmaxf(v, sw_xor<2>(v)); v = fmaxf(v, sw_xor<4>(v)); v = fmaxf(v, sw_xor<8>(v)); v = fmaxf(v, sw_xor<16>(v)); return x32_max(v); }
__device__ __forceinline__ float shfl_from(float v, int srclane) { return __int_as_float(__builtin_amdgcn_ds_bpermute(srclane << 2, __float_as_int(v))); }
__device__ __forceinline__ int shfl_from_i(int v, int srclane) { return __builtin_amdgcn_ds_bpermute(srclane << 2, v); }
__device__ __forceinline__ float fexp(float x) { return __builtin_amdgcn_exp2f(x * 1.4426950408889634f); }
__device__ __forceinline__ float logsigmoidf(float x) { return fminf(x, 0.f) - 0.6931471805599453f * __builtin_amdgcn_logf(1.f + fexp(-fabsf(x))); }
__device__ __forceinline__ float siluf(float x) { return x * __builtin_amdgcn_rcpf(1.f + fexp(-x)); }

constexpr size_t MiB = 1u << 20;
constexpr size_t OFF_CTL = 0;
constexpr size_t OFF_A0 = 1 * MiB;
constexpr size_t OFF_FQ = OFF_A0 + (size_t)NR_A0 * DM * 2;
constexpr size_t OFF_FK = OFF_FQ + (size_t)8 * SEQ * 128 * 2;
constexpr size_t OFF_FV = OFF_FK + (size_t)8 * LR * 128 * 2;
constexpr size_t OFF_FLOG = OFF_FV + (size_t)8 * LR * 128 * 2;
constexpr size_t OFF_CB = OFF_FLOG + (size_t)8 * LR * 4;
constexpr size_t OFF_GQ = OFF_CB + (size_t)8 * LR * 4;
constexpr size_t OFF_GK = OFF_GQ + (size_t)4 * LR * 128 * 2;
constexpr size_t OFF_GV = OFF_GK + (size_t)4 * LR * 128 * 2;
constexpr size_t OFF_GR = OFF_GV + (size_t)4 * LR * 256 * 2;
constexpr size_t OFF_GZ = OFF_GR + (size_t)SEQ * 1024 * 2;
constexpr size_t OFF_GLAO = OFF_GZ + (size_t)LR * 16 * 4;
constexpr size_t OFF_MIX = OFF_GLAO + (size_t)SEQ * 1024 * 4;
constexpr size_t OFF_U2 = OFF_GV;
constexpr size_t OFF_INVMAP = OFF_MIX + (size_t)SEQ * DM * 2;
constexpr size_t OFF_WTS = OFF_INVMAP + (size_t)32 * SEQ * 4;
constexpr size_t OFF_HBUF = OFF_GLAO;
constexpr size_t OFF_Y = OFF_A0;
constexpr size_t WS_END = OFF_WTS + (size_t)SEQ * 2 * 4;
static_assert(OFF_Y + (size_t)2 * SEQ * DM * 2 <= OFF_FV && OFF_HBUF + (size_t)24576 * 512 * 2 <= OFF_MIX && OFF_U2 + (size_t)SEQ * DM * 2 <= OFF_GZ, "overlays");

struct P {
    const float *x, *meta, *g1, *w_in, *b_f, *w2, *bg, *gla_g, *fox_g, *w_out, *g2, *w_rg, *b_rg, *w_re, *b_re, *wg, *wu, *wd, *gf;
    float* out; unsigned char* ws;
};

#define LAS __attribute__((address_space(3)))
#define GAS __attribute__((address_space(1)))
typedef short bf16x8 __attribute__((ext_vector_type(8)));
typedef short v4i16_t __attribute__((ext_vector_type(4)));
typedef float f32x4 __attribute__((ext_vector_type(4)));
typedef float f32x2 __attribute__((ext_vector_type(2)));
typedef unsigned u32x4 __attribute__((ext_vector_type(4)));
typedef unsigned u32x2 __attribute__((ext_vector_type(2)));
typedef __bf16 bf16x2_t __attribute__((ext_vector_type(2)));
template <class T> __device__ __forceinline__ T nt_load(const T* p) { return __builtin_nontemporal_load(p); }
template <class T> __device__ __forceinline__ void nt_store(T v, T* p) { __builtin_nontemporal_store(v, p); }
__device__ __forceinline__ void st16_wt(void* p, u32x4 v) { asm volatile("global_store_dwordx4 %0, %1, off sc1\n\ts_nop 1" :: "v"(p), "v"(v) : "memory"); }
__device__ __forceinline__ void st16_wt(void* p, f32x4 v) { asm volatile("global_store_dwordx4 %0, %1, off sc1\n\ts_nop 1" :: "v"(p), "v"(v) : "memory"); }
__device__ __forceinline__ unsigned cvtpk(float lo, float hi) { f32x2 v = {lo, hi}; bf16x2_t b = __builtin_convertvector(v, bf16x2_t); return __builtin_bit_cast(unsigned, b); }
constexpr int NWAVES = 8;
constexpr int RING_BYTES = 131072, LDSCTL_OFF = RING_BYTES, MISC_OFF = LDSCTL_OFF + 320, LDS_BYTES = 147456;

constexpr size_t OFF_WINT = WS_END;
constexpr size_t OFF_WOUTT = OFF_WINT + (size_t)6176 * DM * 2;
constexpr size_t OFF_WG16 = OFF_WOUTT + (size_t)DM * DM * 2;
constexpr size_t OFF_WU16 = OFF_WG16 + (size_t)32 * DM * 512 * 2;
constexpr size_t OFF_WD16 = OFF_WU16 + (size_t)32 * DM * 512 * 2;
constexpr size_t OFF_DT = OFF_WD16;
constexpr size_t OFF_BBUF = OFF_DT + (size_t)32 * DM * 512 * 2;
constexpr size_t WS_END2 = OFF_BBUF + (size_t)128 * 4 * 64 * 128 * 4;

namespace pg8 {
constexpr int BM = 256, BK = 64, HALF = 128, HTB = HALF * BK * 2, STAGE_BYTES = 8 * HTB, NXCD = 8, WGM = 8;
__host__ __device__ __forceinline__ int lds_byte(int r, int c) { const int st = (r >> 4) * 2 + (c >> 5), rr = r & 15, cc = c & 31, ob = rr * 64 + cc * 2; return st * 1024 + (ob ^ (((ob >> 9) & 1) << 5)); }
__host__ __device__ __forceinline__ void stage_rc(int b, int& R, int& C) { const int st = b / 1024, sb = b % 1024, swz = sb ^ (((sb >> 9) & 1) << 5); R = (st >> 1) * 16 + swz / 64; C = (st & 1) * 32 + (swz % 64) / 2; }
__host__ __device__ __forceinline__ int perm32(int rho) { const int n = rho >> 4, i = rho & 15; return 8 * (i >> 2) + 4 * n + (i & 3); }

struct Unit { int pm, pn; const char* A; const char* B; int e, rt, ce, hoff, nv; unsigned ldb, bhs; };

struct DenseSched {
    int nM, nN, nwg, G, c, K; const char* A; const char* Bt;
    __device__ void init(int M, int N, int K_, int G_, int c_, const void* A_, const void* Bt_) { nM = M / BM; nN = N / BM; nwg = nM * nN; G = G_; c = c_; K = K_; A = (const char*)A_; Bt = (const char*)Bt_; }
    __device__ bool next(int i, Unit& u) const {
        const long L = (long)i * G + c; if (L >= nwg) return false;
        int wgid = (int)L; { const int q = nwg / NXCD, r = nwg % NXCD, xcd = wgid % NXCD, off = wgid / NXCD; wgid = (xcd < r ? xcd * (q + 1) : r * (q + 1) + (xcd - r) * q) + off; }
        const int nig = WGM * nN, gid = wgid / nig, fm = gid * WGM, gsz = (nM - fm) < WGM ? (nM - fm) : WGM;
        u.pm = fm + ((wgid % nig) % gsz); u.pn = (wgid % nig) / gsz;
        u.A = A + (size_t)u.pm * BM * K * 2; u.B = Bt + (size_t)u.pn * BM * K * 2; u.e = 0; u.rt = 0; u.ce = 0; u.hoff = 0; u.nv = BM; u.ldb = 0; u.bhs = 0; return true;
    }
    __device__ __forceinline__ unsigned arow_off(const Unit&, int R) const { return (unsigned)(R * K * 2); }
};
struct OneUnitSched {
    Unit u; const int* idx; int shift; unsigned rowbytes; int rowadd;
    __device__ bool next(int i, Unit& o) const { if (i != 0) return false; o = u; return true; }
    __device__ __forceinline__ unsigned arow_off(const Unit& uu, int R) const {
        const int pos = uu.rt * BM + R; int row = 0;
        if (pos < uu.ce) row = idx ? (idx[pos] >> shift) : pos;
        return (unsigned)(row + rowadd) * rowbytes;
    }
};

template <class Epi, class Sched, bool ALIGN_EPI, bool SP2, bool ROWSKIP = false, bool BNAT = false>
__device__ __forceinline__ void gemm_phase(LAS unsigned char* lds, const int K, const Sched& S, const Epi& E) {
    int tid = threadIdx.x; asm volatile("" : "+v"(tid));
    const int wid = __builtin_amdgcn_readfirstlane(tid >> 6), lane = tid & 63, wr = wid >> 2, wc = wid & 3, fr = lane & 15, fq = lane >> 4;
    const int nt = K / BK;
    Unit cur, nxt; int ui = 0;
    if (!S.next(0, cur)) return;
    unsigned voffA[2][2], voffB[2];
#pragma unroll
    for (int i = 0; i < 2; ++i) { int R, C; stage_rc(tid * 16 + i * 8192, R, C); const int Rb = Epi::PERM ? ((R & ~31) + perm32(R & 31)) : R;
        voffA[0][i] = S.arow_off(cur, R) + (unsigned)(C * 2); voffA[1][i] = S.arow_off(cur, HALF + R) + (unsigned)(C * 2); voffB[i] = (unsigned)(Rb * K + C) * 2u;
        if constexpr (BNAT) {
            const int b_ = tid * 16 + i * 8192, k_ = b_ >> 8, p_ = (b_ >> 4) & 15;
            voffB[i] = (unsigned)k_ * cur.ldb + (unsigned)((p_ ^ ((k_ & 3) << 2)) * 16); } }
    const size_t kstep = (size_t)(BK * 2);
    const size_t hstep = (size_t)HALF * K * 2;
    const size_t kstepB = BNAT ? (size_t)BK * cur.ldb : kstep, hstepB = BNAT ? (size_t)cur.bhs : hstep;
    const int boffT = (8 * fq + ((lane >> 2) & 3)) * 256 + ((4 * (wc ^ ((lane >> 2) & 3)) + (lane & 3)) << 4);
    const unsigned ldsw = (unsigned)wid * 1024u;
    const int aoff = lds_byte(wr * 64 + fr, fq * 8), boff = lds_byte(wc * 32 + fr, fq * 8);
#define PG8_SA(b, h) (((b) * 2 + (h)) * HTB)
#define PG8_SB(b, h) ((4 + (b) * 2 + (h)) * HTB)
#define PG8_STAGE(bufoff, gbase, voff) do { _Pragma("unroll") for (int _i = 0; _i < 2; ++_i) \
        __builtin_amdgcn_global_load_lds((const unsigned*)((const char*)(gbase) + (voff)[_i]), (LAS unsigned*)(lds + (bufoff) + ldsw + _i * 8192), 16, 0, 0); } while (0)
#define PG8_LDA(dst, b, h) do { _Pragma("unroll") for (int m = 0; m < 4; ++m) _Pragma("unroll") for (int k = 0; k < 2; ++k) dst[m][k] = *(const LAS bf16x8*)(lds + PG8_SA(b, h) + aoff + m * 2048 + k * 1024); } while (0)
#define PG8_TR(off_) __builtin_amdgcn_ds_read_tr16_b64_v4i16((LAS v4i16_t*)(lds + (off_)))
#define PG8_LDB(dst, b, h) do { _Pragma("unroll") for (int n = 0; n < 2; ++n) _Pragma("unroll") for (int k = 0; k < 2; ++k) { \
        if constexpr (BNAT) { const v4i16_t lo_ = PG8_TR(PG8_SB(b, h) + boffT + k * 8192 + n * 8), hi_ = PG8_TR(PG8_SB(b, h) + boffT + k * 8192 + 1024 + n * 8); \
                              dst[n][k] = (bf16x8){lo_[0], lo_[1], lo_[2], lo_[3], hi_[0], hi_[1], hi_[2], hi_[3]}; } \
        else dst[n][k] = *(const LAS bf16x8*)(lds + PG8_SB(b, h) + boff + n * 2048 + k * 1024); } } while (0)
#define PG8_MMA(ai, bj, At, Bt) do { __builtin_amdgcn_s_setprio(1); _Pragma("unroll") for (int m = 0; m < 4; ++m) { if (!ROWSKIP || m < mm[ai]) { _Pragma("unroll") for (int n = 0; n < 2; ++n) _Pragma("unroll") for (int k = 0; k < 2; ++k) \
        acc[ai][bj][m][n] = __builtin_amdgcn_mfma_f32_16x16x32_bf16(Bt[n][k], At[m][k], acc[ai][bj][m][n], 0, 0, 0); } } __builtin_amdgcn_s_setprio(0); } while (0)
#define PG8_WAIT_V(n) asm volatile("s_waitcnt vmcnt(" #n ")" ::: "memory")
#define PG8_WAIT_L(n) asm volatile("s_waitcnt lgkmcnt(" #n ")" ::: "memory")
#define PG8_BAR __builtin_amdgcn_s_barrier()
#define PG8_SCHED __builtin_amdgcn_sched_barrier(0)
    f32x4 acc[2][2][4][2];
#pragma unroll
    for (int a = 0; a < 2; ++a)
#pragma unroll
        for (int b = 0; b < 2; ++b)
#pragma unroll
            for (int m = 0; m < 4; ++m)
#pragma unroll
                for (int n = 0; n < 2; ++n) acc[a][b][m][n] = (f32x4){0.f, 0.f, 0.f, 0.f};
    bf16x8 At[4][2], B0[2][2], B1[2][2];
    const char* cA = cur.A; const char* cB = cur.B;
    int mm[2];
#define PG8_SETMM(u_) do { _Pragma("unroll") for (int a_ = 0; a_ < 2; ++a_) { int v_ = ((u_).nv - a_ * HALF - wr * 64 + 15) >> 4; mm[a_] = v_ < 0 ? 0 : (v_ > 4 ? 4 : v_); } } while (0)
    PG8_SETMM(cur);
    if constexpr (SP2) {
        PG8_STAGE(PG8_SB(0, 0), cB, voffB); PG8_STAGE(PG8_SB(0, 1), cB + hstepB, voffB); PG8_STAGE(PG8_SA(0, 0), cA, voffA[0]); PG8_STAGE(PG8_SA(0, 1), cA, voffA[1]);
        if (wr == 1) PG8_BAR;
        PG8_WAIT_V(2); PG8_BAR;
        PG8_STAGE(PG8_SB(1, 0), cB + kstepB, voffB); PG8_STAGE(PG8_SA(1, 0), cA + kstep, voffA[0]); PG8_STAGE(PG8_SB(1, 1), cB + hstepB + kstepB, voffB);
        PG8_WAIT_V(6); PG8_BAR;
    } else {
        PG8_STAGE(PG8_SB(0, 0), cB, voffB); PG8_STAGE(PG8_SA(0, 0), cA, voffA[0]); PG8_STAGE(PG8_SB(0, 1), cB + hstepB, voffB); PG8_STAGE(PG8_SA(0, 1), cA, voffA[1]);
        if (wr == 1) PG8_BAR;
        PG8_WAIT_V(4); PG8_BAR;
        PG8_STAGE(PG8_SB(1, 0), cB + kstepB, voffB); PG8_STAGE(PG8_SA(1, 0), cA + kstep, voffA[0]); PG8_STAGE(PG8_SB(1, 1), cB + hstepB + kstepB, voffB);
        PG8_WAIT_V(6); PG8_BAR;
    }
    for (;;) {
        const bool has_next = S.next(ui + 1, nxt);
        const char* nA = has_next ? nxt.A : cA; const char* nB = has_next ? nxt.B : cB;
        for (int t = 0; t < nt; t += 2) {
            const bool last = (t == nt - 2);
            const char* a1 = cA + (size_t)(t + 1) * kstep;
            const char* a2 = last ? nA : cA + (size_t)(t + 2) * kstep; const char* b2 = last ? nB : cB + (size_t)(t + 2) * kstepB;
            const char* a3 = a2 + kstep; const char* b3 = b2 + kstepB;
            if constexpr (SP2) {
            PG8_LDB(B0, 0, 0); PG8_LDB(B1, 0, 1); PG8_SCHED; PG8_LDA(At, 0, 0); PG8_STAGE(PG8_SA(1, 1), a1, voffA[1]);
            PG8_WAIT_V(8); PG8_WAIT_L(0); PG8_BAR; PG8_MMA(0, 0, At, B0); PG8_MMA(0, 1, At, B1); PG8_BAR; PG8_SCHED;
            PG8_LDA(At, 0, 1); PG8_STAGE(PG8_SB(0, 0), b2, voffB); PG8_STAGE(PG8_SB(0, 1), b2 + hstepB, voffB); PG8_STAGE(PG8_SA(0, 0), a2, voffA[0]);
            PG8_WAIT_V(8); PG8_WAIT_L(0); PG8_BAR; PG8_MMA(1, 0, At, B0); PG8_MMA(1, 1, At, B1); PG8_BAR; PG8_SCHED;
            PG8_LDB(B0, 1, 0); PG8_LDB(B1, 1, 1); PG8_SCHED; PG8_LDA(At, 1, 0); PG8_STAGE(PG8_SA(0, 1), a2, voffA[1]);
            PG8_WAIT_V(8); PG8_WAIT_L(0); PG8_BAR; PG8_MMA(0, 0, At, B0); PG8_MMA(0, 1, At, B1); PG8_BAR; PG8_SCHED;
            PG8_LDA(At, 1, 1); PG8_STAGE(PG8_SB(1, 0), b3, voffB); PG8_STAGE(PG8_SB(1, 1), b3 + hstepB, voffB); PG8_STAGE(PG8_SA(1, 0), a3, voffA[0]);
            PG8_WAIT_V(8); PG8_WAIT_L(0); PG8_BAR; PG8_MMA(1, 0, At, B0); PG8_MMA(1, 1, At, B1); PG8_BAR; PG8_SCHED;
            } else {
            PG8_LDB(B0, 0, 0); PG8_SCHED; PG8_LDA(At, 0, 0); PG8_STAGE(PG8_SA(1, 1), a1, voffA[1]);
            PG8_WAIT_L(8); PG8_BAR; PG8_WAIT_L(0); PG8_MMA(0, 0, At, B0); PG8_BAR; PG8_SCHED;
            PG8_LDB(B1, 0, 1); PG8_STAGE(PG8_SB(0, 0), b2, voffB);
            PG8_BAR; PG8_WAIT_L(0); PG8_MMA(0, 1, At, B1); PG8_BAR;
            PG8_LDA(At, 0, 1); PG8_STAGE(PG8_SA(0, 0), a2, voffA[0]);
            PG8_BAR; PG8_WAIT_L(0); PG8_MMA(1, 0, At, B0); PG8_BAR; PG8_SCHED;
            PG8_STAGE(PG8_SB(0, 1), b2 + hstepB, voffB);
            PG8_WAIT_V(6); PG8_BAR; PG8_MMA(1, 1, At, B1); PG8_BAR;
            PG8_LDB(B0, 1, 0); PG8_SCHED; PG8_LDA(At, 1, 0); PG8_STAGE(PG8_SA(0, 1), a2, voffA[1]);
            PG8_WAIT_L(8); PG8_BAR; PG8_WAIT_L(0); PG8_MMA(0, 0, At, B0); PG8_BAR; PG8_SCHED;
            PG8_LDB(B1, 1, 1); PG8_STAGE(PG8_SB(1, 0), b3, voffB);
            PG8_BAR; PG8_WAIT_L(0); PG8_MMA(0, 1, At, B1); PG8_BAR;
            PG8_LDA(At, 1, 1); PG8_STAGE(PG8_SA(1, 0), a3, voffA[0]);
            PG8_BAR; PG8_WAIT_L(0); PG8_MMA(1, 0, At, B0); PG8_BAR; PG8_SCHED;
            PG8_STAGE(PG8_SB(1, 1), b3 + hstepB, voffB);
            PG8_WAIT_V(6); PG8_BAR; PG8_MMA(1, 1, At, B1); PG8_BAR;
            }
        }
        if constexpr (ALIGN_EPI) { if (wr == 0) PG8_BAR; }
        E(acc, cur, wr, wc, fr, fq);
        if (!has_next) break;
#pragma unroll
        for (int a = 0; a < 2; ++a)
#pragma unroll
            for (int b = 0; b < 2; ++b)
#pragma unroll
                for (int m = 0; m < 4; ++m)
#pragma unroll
                    for (int n = 0; n < 2; ++n) acc[a][b][m][n] = (f32x4){0.f, 0.f, 0.f, 0.f};
        cur = nxt; cA = nA; cB = nB; ++ui; PG8_SETMM(cur);
        if constexpr (ALIGN_EPI) { if (wr == 1) PG8_BAR; }
    }
    PG8_WAIT_V(0);
    if constexpr (!ALIGN_EPI) { if (wr == 0) PG8_BAR; }
    PG8_BAR;
#undef PG8_SETMM
#undef PG8_SA
#undef PG8_SB
#undef PG8_STAGE
#undef PG8_LDA
#undef PG8_LDB
#undef PG8_TR
#undef PG8_MMA
#undef PG8_WAIT_V
#undef PG8_WAIT_L
#undef PG8_BAR
#undef PG8_SCHED
}
}

__device__ __forceinline__ void inproj_dest(int t, size_t& off, int& stride, bool& xonly) {
    xonly = false;
    if (t < 8) { off = OFF_FQ + (size_t)t * SEQ * 256; stride = 128; xonly = true; }
    else if (t < 16) { off = OFF_FK + (size_t)(t - 8) * LR * 256; stride = 128; }
    else if (t < 24) { off = OFF_FV + (size_t)(t - 16) * LR * 256; stride = 128; }
    else if (t < 28) { off = OFF_GQ + (size_t)(t - 24) * LR * 256; stride = 128; }
    else if (t < 32) { off = OFF_GK + (size_t)(t - 28) * LR * 256; stride = 128; }
    else if (t < 40) { off = OFF_GV + (size_t)((t - 32) >> 1) * LR * 512 + (size_t)((t & 1) * 256); stride = 256; }
    else { off = OFF_GR + (size_t)(t - 40) * 256; stride = 1024; xonly = true; }
}
struct EpiInproj {
    static constexpr bool PERM = true;
    unsigned char* ws;
    __device__ __forceinline__ void operator()(const f32x4 (&acc)[2][2][4][2], const pg8::Unit& u, int wr, int wc, int fr, int fq) const {
        const int rbase = u.pm * 256 + wr * 64 + fr;
#pragma unroll
        for (int bj = 0; bj < 2; ++bj) {
            size_t off; int stride; bool xonly;
            inproj_dest(u.pn * 2 + bj, off, stride, xonly);
            bf16_t* base = (bf16_t*)(ws + off) + wc * 32 + 8 * fq + (size_t)(xonly ? 0 : 64) * stride;
#pragma unroll
            for (int ai = 0; ai < 2; ++ai)
#pragma unroll
                for (int m = 0; m < 4; ++m) {
                    const int prow = rbase + ai * 128 + m * 16;
                    const f32x4 v0 = acc[ai][bj][m][0], v1 = acc[ai][bj][m][1];
                    u32x4 w; w.x = cvtpk(v0[0], v0[1]); w.y = cvtpk(v0[2], v0[3]); w.z = cvtpk(v1[0], v1[1]); w.w = cvtpk(v1[2], v1[3]);
                    st16_wt(base + (size_t)prow * stride, w);
                }
        }
    }
};
struct EpiOutproj {
    static constexpr bool PERM = false;
    const float* x; float* out;
    __device__ __forceinline__ void operator()(const f32x4 (&acc)[2][2][4][2], const pg8::Unit& u, int wr, int wc, int fr, int fq) const {
        const int col0 = u.pn * 256 + wc * 32 + 4 * fq;
#pragma unroll
        for (int ai = 0; ai < 2; ++ai)
#pragma unroll
            for (int m = 0; m < 4; ++m) {
                const size_t off = (size_t)(u.pm * 256 + ai * 128 + wr * 64 + m * 16 + fr) * DM + col0;
#pragma unroll
                for (int bj = 0; bj < 2; ++bj)
#pragma unroll
                    for (int n = 0; n < 2; ++n) { const f32x4 xv = nt_load((const f32x4*)(x + off + bj * 128 + n * 16)); st16_wt(out + off + bj * 128 + n * 16, xv + acc[ai][bj][m][n]); }
            }
    }
};
struct EpiGateUp {
    static constexpr bool PERM = true;
    bf16_t* HB;
    __device__ __forceinline__ void operator()(const f32x4 (&acc)[2][2][4][2], const pg8::Unit& u, int wr, int wc, int fr, int fq) const {
        const int col = u.pn * 128 + wc * 32 + 8 * fq;
#pragma unroll
        for (int ai = 0; ai < 2; ++ai)
#pragma unroll
            for (int m = 0; m < 4; ++m) {
                const int pos = u.rt * 256 + ai * 128 + wr * 64 + m * 16 + fr;
                if (pos >= u.ce) continue;
                const f32x4 g0 = acc[ai][0][m][0], g1 = acc[ai][0][m][1], u0 = acc[ai][1][m][0], u1 = acc[ai][1][m][1];
                u32x4 w; w.x = cvtpk(siluf(g0[0]) * u0[0], siluf(g0[1]) * u0[1]); w.y = cvtpk(siluf(g0[2]) * u0[2], siluf(g0[3]) * u0[3]);
                w.z = cvtpk(siluf(g1[0]) * u1[0], siluf(g1[1]) * u1[1]); w.w = cvtpk(siluf(g1[2]) * u1[2], siluf(g1[3]) * u1[3]);
                st16_wt(HB + (size_t)(u.hoff + pos) * 512 + col, w);
            }
    }
};
struct EpiDown {
    static constexpr bool PERM = true;
    bf16_t* Y; const int* invmap; const float* wts;
    __device__ __forceinline__ void operator()(const f32x4 (&acc)[2][2][4][2], const pg8::Unit& u, int wr, int wc, int fr, int fq) const {
        const int col = u.pn * 256 + wc * 32 + 8 * fq;
#pragma unroll
        for (int ai = 0; ai < 2; ++ai)
#pragma unroll
            for (int m = 0; m < 4; ++m) {
                const int pos = u.rt * 256 + ai * 128 + wr * 64 + m * 16 + fr;
                if (pos >= u.ce) continue;
                const int t2 = invmap[(size_t)u.e * SEQ + pos]; const float wt = wts[t2];
                bf16_t* dst = Y + (size_t)(t2 & 1) * SEQ * DM + (size_t)(t2 >> 1) * DM + col;
#pragma unroll
                for (int bj = 0; bj < 2; ++bj) { const f32x4 v0 = acc[ai][bj][m][0] * wt, v1 = acc[ai][bj][m][1] * wt;
                    u32x4 w; w.x = cvtpk(v0[0], v0[1]); w.y = cvtpk(v0[2], v0[3]); w.z = cvtpk(v1[0], v1[1]); w.w = cvtpk(v1[2], v1[3]);
                    st16_wt(dst + bj * 128, w); }
            }
    }
};

struct TrLoad { f32x4 v[8]; };
template <class ColFn>
__device__ __forceinline__ void tr_issue(TrLoad& t, const float* W, int ldw, ColFn colfn, int k0, int lane) {
    const int kq = lane >> 3, nq = lane & 7, sc = colfn(nq);
#pragma unroll
    for (int i = 0; i < 8; ++i) t.v[i] = sc >= 0 ? nt_load((const f32x4*)(W + (size_t)(k0 + 8 * i + kq) * ldw + sc)) : (f32x4){0.f, 0.f, 0.f, 0.f};
}
__device__ __forceinline__ void tr_finish(const TrLoad& t, bf16_t* WTrow0  , int K, int k0, LAS float* scr, int lane) {
    const int kq = lane >> 3, nq = lane & 7;
#pragma unroll
    for (int i = 0; i < 8; ++i) { LAS float* d = scr + (8 * i + kq) * 33 + 4 * nq; d[0] = t.v[i][0]; d[1] = t.v[i][1]; d[2] = t.v[i][2]; d[3] = t.v[i][3]; }
    asm volatile("s_waitcnt lgkmcnt(0)" ::: "memory");
    const int c = lane & 7;
#pragma unroll
    for (int j = 0; j < 4; ++j) { const int n = (lane >> 3) + 8 * j; const LAS float* s = scr + (8 * c) * 33 + n;
        u32x4 o; o.x = cvtpk(s[0 * 33], s[1 * 33]); o.y = cvtpk(s[2 * 33], s[3 * 33]); o.z = cvtpk(s[4 * 33], s[5 * 33]); o.w = cvtpk(s[6 * 33], s[7 * 33]);
        *(u32x4*)(WTrow0 + (size_t)n * K + k0 + 8 * c) = o; }
    asm volatile("s_waitcnt lgkmcnt(0)" ::: "memory");
}
__device__ __forceinline__ void prep_row(const P& p, int row, int lane) {
    bf16_t* A0 = (bf16_t*)(p.ws + OFF_A0);
    uint2* dst = (uint2*)(A0 + (size_t)row * DM);
    const float* src = row < SEQ ? p.x + (size_t)row * DM : p.meta + (size_t)(row - SEQ) * DM;
    float4 v[8]; float ss = 0.f;
#pragma unroll
    for (int j = 0; j < 8; ++j) { const f32x4 t_ = nt_load((const f32x4*)src + lane + 64 * j); v[j] = make_float4(t_[0], t_[1], t_[2], t_[3]); ss += v[j].x * v[j].x + v[j].y * v[j].y + v[j].z * v[j].z + v[j].w * v[j].w; }
    ss = wave_sum(ss);
    const float rs = rsqrtf(ss * (1.f / DM) + EPS);
#pragma unroll
    for (int j = 0; j < 8; ++j) {
        const float4 g = ((const float4*)p.g1)[lane + 64 * j];
        dst[lane + 64 * j] = make_uint2(cvtpk(v[j].x * rs * g.x, v[j].y * rs * g.y), cvtpk(v[j].z * rs * g.z, v[j].w * rs * g.w));
    }
}
constexpr size_t EXP_NG4 = (size_t)32 * DM * 512 / 4;
__device__ __forceinline__ void cast_family(const float* src, unsigned char* dstb, size_t gt, size_t NT, size_t lo, size_t hi) {
    const f32x4* s4 = (const f32x4*)src; uint2* d2 = (uint2*)dstb;
#define CST(i_, v_) d2[i_] = make_uint2(cvtpk(v_[0], v_[1]), cvtpk(v_[2], v_[3]))
    size_t i0 = lo + gt;
    for (; i0 + 7 * NT < hi; i0 += 8 * NT) {
        const f32x4 v0 = s4[i0], v1 = s4[i0 + NT], v2 = s4[i0 + 2 * NT], v3 = s4[i0 + 3 * NT], v4 = s4[i0 + 4 * NT], v5 = s4[i0 + 5 * NT], v6 = s4[i0 + 6 * NT], v7 = s4[i0 + 7 * NT];
        CST(i0, v0); CST(i0 + NT, v1); CST(i0 + 2 * NT, v2); CST(i0 + 3 * NT, v3); CST(i0 + 4 * NT, v4); CST(i0 + 5 * NT, v5); CST(i0 + 6 * NT, v6); CST(i0 + 7 * NT, v7);
    }
    for (; i0 < hi; i0 += NT) { const f32x4 v = s4[i0]; CST(i0, v); }
#undef CST
}
__device__ __forceinline__ void phase_prep(const P& p, LAS unsigned char* lds, int vcu, int G) {
    int tid = threadIdx.x; asm volatile("" : "+v"(tid));
    const int lane = tid & 63, wave = __builtin_amdgcn_readfirstlane(tid >> 6);
    LAS float* scr = (LAS float*)(lds + wave * 16384);
    const int gw = vcu * NWAVES + wave, NGW = G * NWAVES;
    for (int r = gw; r < SEQ + NMETA; r += NGW) prep_row(p, r, lane);
    { const int gt = vcu * 512 + tid, NT = G * 512;
      bf16_t* FK = (bf16_t*)(p.ws + OFF_FK); bf16_t* FV = (bf16_t*)(p.ws + OFF_FV);
      bf16_t* GQ = (bf16_t*)(p.ws + OFF_GQ); bf16_t* GK = (bf16_t*)(p.ws + OFF_GK); bf16_t* GV = (bf16_t*)(p.ws + OFF_GV);
      float* FLOG = (float*)(p.ws + OFF_FLOG); float* GZ = (float*)(p.ws + OFF_GZ);
      for (int i = gt; i < 8 * 48 * 128; i += NT) { const int h = i / (48 * 128), r = i % (48 * 128); FK[(size_t)h * LR * 128 + r] = 0; FV[(size_t)h * LR * 128 + r] = 0;
          if (h < 4) { GQ[(size_t)h * LR * 128 + r] = 0; GK[(size_t)h * LR * 128 + r] = 0; } }
      for (int i = gt; i < 4 * 48 * 256; i += NT) { const int h = i / (48 * 256), r = i % (48 * 256); GV[(size_t)h * LR * 256 + r] = 0; }
      for (int i = gt; i < 8 * 48; i += NT) FLOG[i] = 0.f;
      for (int i = gt; i < 48 * 16; i += NT) GZ[i] = 0.f; }
    constexpr int I_IN = 193 * 32, I_OUT = 64 * 32, I_ALL = I_IN + I_OUT;
    auto issue = [&](TrLoad& t, int it, bf16_t*& dst, int& K, int& k0) {
        int r = it;
        if (r < I_IN) { const int nb = r % 193, kb = r / 193, n0 = nb * 32; K = DM; k0 = kb * 64; dst = (bf16_t*)(p.ws + OFF_WINT) + (size_t)n0 * DM;
            tr_issue(t, p.w_in, NPROJ, [&](int g) { const int n = n0 + 4 * g; if (n < 3072) return n; if (n < 6144) return n + 8; if (n < 6152) return n - 3072; if (n < 6168) return n; return -1; }, k0, lane); return; }
        r -= I_IN;
        if (r < I_OUT) { const int nb = r & 63, kb = r >> 6, n0 = nb * 32; K = DM; k0 = kb * 64; dst = (bf16_t*)(p.ws + OFF_WOUTT) + (size_t)n0 * DM;
            tr_issue(t, p.w_out, DM, [&](int g) { return n0 + 4 * g; }, k0, lane); return; }
    };
    for (int it = gw; it < I_ALL; it += 2 * NGW) {
        TrLoad ta, tb; bf16_t* da; bf16_t* db = nullptr; int Ka, Kb = 0, k0a, k0b = 0;
        issue(ta, it, da, Ka, k0a);
        const bool two = it + NGW < I_ALL;
        if (two) issue(tb, it + NGW, db, Kb, k0b);
        tr_finish(ta, da, Ka, k0a, scr, lane);
        if (two) tr_finish(tb, db, Kb, k0b, scr, lane);
    }
}
__device__ __forceinline__ void phase_inproj(const P& p, LAS unsigned char* lds, int G, int bid) {
    { pg8::DenseSched S; S.init(SEQ, 6144, DM, G, bid, p.ws + OFF_A0, p.ws + OFF_WINT);
      EpiInproj E{p.ws};
      pg8::gemm_phase<EpiInproj, pg8::DenseSched, true, true>(lds, DM, S, E); }
    int tid = threadIdx.x; asm volatile("" : "+v"(tid));
    const int lane = tid & 63, w = __builtin_amdgcn_readfirstlane(tid >> 6), r16 = lane & 15, q = lane >> 4;
    LAS float* part = (LAS float*)lds;
    for (int j = bid; j < 192; j += G) {
        const bf16_t* Ap = (const bf16_t*)(p.ws + OFF_A0) + (size_t)(SEQ + r16) * DM + 256 * w + 8 * q;
        const bf16_t* Bp = (const bf16_t*)(p.ws + OFF_WINT) + (size_t)(32 * j + r16) * DM + 256 * w + 8 * q;
        f32x4 acc0 = (f32x4){0.f, 0.f, 0.f, 0.f}, acc1 = acc0;
#pragma unroll
        for (int ks = 0; ks < 8; ++ks) {
            const bf16x8 af = *(const bf16x8*)(Ap + 32 * ks), b0 = *(const bf16x8*)(Bp + 32 * ks), b1 = *(const bf16x8*)(Bp + (size_t)16 * DM + 32 * ks);
            acc0 = __builtin_amdgcn_mfma_f32_16x16x32_bf16(af, b0, acc0, 0, 0, 0);
            acc1 = __builtin_amdgcn_mfma_f32_16x16x32_bf16(af, b1, acc1, 0, 0, 0);
        }
#pragma unroll
        for (int i = 0; i < 4; ++i) { part[((w * 2 + 0) * 16 + 4 * q + i) * 16 + r16] = acc0[i]; part[((w * 2 + 1) * 16 + 4 * q + i) * 16 + r16] = acc1[i]; }
        __syncthreads();
        { const int m = tid >> 5, cl = tid & 31; float sum = 0.f;
#pragma unroll
          for (int ww = 0; ww < 8; ++ww) sum += part[((ww * 2 + (cl >> 4)) * 16 + m) * 16 + (cl & 15)];
          const int c = 32 * j + cl; size_t off; int stride; bool xonly;
          inproj_dest(c >> 7, off, stride, xonly);
          if (!xonly) ((bf16_t*)(p.ws + off))[(size_t)(48 + m) * stride + (c & 127)] = f2bf(sum); }
        __syncthreads();
    }
    for (int i = bid; i < 257; i += G) {
        const bf16_t* Ap = (const bf16_t*)(p.ws + OFF_A0) + (size_t)(32 * i + r16) * DM + 256 * w + 8 * q;
        const bf16_t* Bp = (const bf16_t*)(p.ws + OFF_WINT) + (size_t)(6144 + r16) * DM + 256 * w + 8 * q;
        f32x4 acc[2][2];
#pragma unroll
        for (int a_ = 0; a_ < 2; ++a_)
#pragma unroll
            for (int b_ = 0; b_ < 2; ++b_) acc[a_][b_] = (f32x4){0.f, 0.f, 0.f, 0.f};
#pragma unroll
        for (int ks = 0; ks < 8; ++ks) {
            const bf16x8 a0 = *(const bf16x8*)(Ap + 32 * ks), a1 = *(const bf16x8*)(Ap + (size_t)16 * DM + 32 * ks);
            const bf16x8 b0 = *(const bf16x8*)(Bp + 32 * ks), b1 = *(const bf16x8*)(Bp + (size_t)16 * DM + 32 * ks);
            acc[0][0] = __builtin_amdgcn_mfma_f32_16x16x32_bf16(a0, b0, acc[0][0], 0, 0, 0); acc[0][1] = __builtin_amdgcn_mfma_f32_16x16x32_bf16(a0, b1, acc[0][1], 0, 0, 0);
            acc[1][0] = __builtin_amdgcn_mfma_f32_16x16x32_bf16(a1, b0, acc[1][0], 0, 0, 0); acc[1][1] = __builtin_amdgcn_mfma_f32_16x16x32_bf16(a1, b1, acc[1][1], 0, 0, 0);
        }
#pragma unroll
        for (int a_ = 0; a_ < 2; ++a_)
#pragma unroll
            for (int b_ = 0; b_ < 2; ++b_)
#pragma unroll
                for (int ii = 0; ii < 4; ++ii) part[((w * 4 + a_ * 2 + b_) * 16 + 4 * q + ii) * 16 + r16] = acc[a_][b_][ii];
        __syncthreads();
#pragma unroll
        for (int o = 0; o < 2; ++o) { const int idx = tid + 512 * o, row = idx >> 5, col = idx & 31; float sum = 0.f;
#pragma unroll
            for (int ww = 0; ww < 8; ++ww) sum += part[((ww * 4 + (row >> 4) * 2 + (col >> 4)) * 16 + (row & 15)) * 16 + (col & 15)];
            const int prow = 32 * i + row;
            if (prow < SEQ + NMETA && col < 24) { const int lrow = prow < SEQ ? 64 + prow : 48 + (prow - SEQ);
                if (col < 8) ((float*)(p.ws + OFF_FLOG))[(size_t)lrow * 8 + col] = sum; else ((float*)(p.ws + OFF_GZ))[(size_t)lrow * 16 + (col - 8)] = sum; } }
        __syncthreads();
    }
}
__device__ __forceinline__ void phase_outproj(const P& p, LAS unsigned char* lds, int G, int bid) {
    pg8::DenseSched S; S.init(SEQ, DM, DM, G, bid, p.ws + OFF_MIX, p.ws + OFF_WOUTT);
    EpiOutproj E{p.x, p.out};
    pg8::gemm_phase<EpiOutproj, pg8::DenseSched, true, true>(lds, DM, S, E);
}
constexpr int MOE_PLAN_OFF = LDSCTL_OFF + 1024;
struct MoeLane { int e, ce, nt, nbig, nsm, hoff, ib4, is4, ib8, is8, tb4, ts4, tb8, ts8; };
__device__ __forceinline__ MoeLane moe_lane(const unsigned* cnt, int tid) {
    MoeLane m; m.e = tid & 31;
    m.ce = (int)cnt[m.e]; m.nt = (m.ce + 255) >> 8; const int lastrows = m.ce - (m.nt - 1) * 256;
    m.nbig = (m.nt > 0 && lastrows < 128) ? m.nt - 1 : m.nt; m.nsm = m.nt - m.nbig;
    int pb = m.nbig, ps = m.nsm, ph = m.nt * 256;
#pragma unroll
    for (int o = 1; o < 32; o <<= 1) { const int tb = shfl_from_i(pb, tid - o), ts = shfl_from_i(ps, tid - o), th = shfl_from_i(ph, tid - o); if (m.e >= o) { pb += tb; ps += ts; ph += th; } }
    const int totb = shfl_from_i(pb, 31), tots = shfl_from_i(ps, 31);
    m.hoff = ph - m.nt * 256; m.ib4 = pb * 4; m.is4 = ps * 4; m.ib8 = pb * 8; m.is8 = ps * 8; m.tb4 = totb * 4; m.ts4 = tots * 4; m.tb8 = totb * 8; m.ts8 = tots * 8;
    return m;
}
__device__ __forceinline__ void moe_rec(LAS unsigned char* lds, int k, const MoeLane& m, int tid, int ncol, bool small, int idx, int type) {
    const int incl = small ? (ncol == 4 ? m.is4 : m.is8) : (ncol == 4 ? m.ib4 : m.ib8);
    const int mine = (small ? m.nsm : m.nbig) * ncol, excl = incl - mine;
    const bool hit = idx >= 0 && idx >= excl && idx < incl && tid < 32;
    const unsigned long long bm = __ballot(hit);
    LAS int* rec = (LAS int*)(lds + MOE_PLAN_OFF) + k * 8;
    if (bm == 0ull) { if (tid == 0) rec[0] = -1; }
    else if (hit) { const int loc = idx - excl, rt = (small ? m.nbig : 0) + loc / ncol; rec[0] = m.e; rec[1] = rt; rec[2] = loc % ncol; rec[3] = m.ce; rec[4] = m.hoff;
                    const int nv = m.ce - rt * 256; rec[5] = nv > 256 ? 256 : nv; rec[6] = type; }
}
template <int PHASE> __device__ __forceinline__ void moe_plan(const unsigned* cnt, int G, int c, LAS unsigned char* lds) {
    int tid = threadIdx.x; asm volatile("" : "+v"(tid));
    if (tid < 64) {
        const MoeLane m = moe_lane(cnt, tid);
#pragma unroll 1
        for (int k = 0; k < 8; ++k) {
            if (PHASE == 0) moe_rec(lds, k, m, tid, 4, false, k * G + c, 0);
            else if (PHASE == 2) moe_rec(lds, k, m, tid, 8, true, k * G + c, 1);
            else {
                const int ns = m.ts4;
                if (ns >= G) {
                    const int nsk = (ns - c + G - 1) / G;
                    if (k < nsk) moe_rec(lds, k, m, tid, 4, true, k * G + c, 0); else moe_rec(lds, k, m, tid, 8, false, (k - nsk) * G + c, 1);
                } else if (c < ns) { if (k == 0) moe_rec(lds, k, m, tid, 4, true, c, 0); else if (k == 1) moe_rec(lds, k, m, tid, 8, false, c, 1); else moe_rec(lds, k, m, tid, 8, false, -1, 1); }
                else moe_rec(lds, k, m, tid, 8, false, ns + (c - ns) + k * (G - ns), 1);
            }
        }
    }
    __syncthreads();
}
__device__ __forceinline__ bool moe_unit_rec(LAS unsigned char* lds, int k, pg8::Unit& u, int& type) {
    if (k >= 8) return false;
    const volatile LAS int* rec = (const volatile LAS int*)(lds + MOE_PLAN_OFF) + k * 8;
    const int e = __builtin_amdgcn_readfirstlane(rec[0]);
    if (e < 0) return false;
    u.e = e; u.rt = __builtin_amdgcn_readfirstlane(rec[1]); u.pn = __builtin_amdgcn_readfirstlane(rec[2]); u.pm = 0;
    u.ce = __builtin_amdgcn_readfirstlane(rec[3]); u.hoff = __builtin_amdgcn_readfirstlane(rec[4]); u.nv = __builtin_amdgcn_readfirstlane(rec[5]);
    type = __builtin_amdgcn_readfirstlane(rec[6]);
    return true;
}
struct MoeDownSched {
    LAS unsigned char* lds; const char* HB; const char* DT; int k0;
    __device__ bool next(int i, pg8::Unit& u) const {
        int type; if (!moe_unit_rec(lds, k0 + i, u, type) || type != 1) return false;
        u.A = HB + (size_t)(u.hoff + u.rt * 256) * 1024; u.B = DT + ((size_t)u.e * 512 * DM + u.pn * 256) * 2; u.ldb = 4096u; u.bhs = 256u; return true;
    }
    __device__ __forceinline__ unsigned arow_off(const pg8::Unit&, int R) const { return (unsigned)(R * 1024); }
};
template <int PHASE> __device__ __forceinline__ void phase_moe(const P& p, LAS unsigned char* lds, int G, int bid) {
    moe_plan<PHASE>((const unsigned*)(p.ws + OFF_CTL), G, bid, lds);
    int k = 0;
    if (PHASE != 2) {
        EpiGateUp E{(bf16_t*)(p.ws + OFF_HBUF)};
        for (;; ++k) {
            pg8::OneUnitSched S; int type; if (!moe_unit_rec(lds, k, S.u, type) || type != 0) break;
            S.u.A = (const char*)(p.ws + OFF_U2); S.u.B = (const char*)(p.ws + OFF_WG16) + ((size_t)S.u.e * DM * 512 + S.u.pn * 128) * 2;
            S.u.ldb = 1024u; S.u.bhs = (unsigned)(OFF_WU16 - OFF_WG16);
            S.idx = (const int*)(p.ws + OFF_INVMAP) + (size_t)S.u.e * SEQ; S.shift = 1; S.rowbytes = DM * 2; S.rowadd = 0;
            pg8::gemm_phase<EpiGateUp, pg8::OneUnitSched, true, true, true, true>(lds, DM, S, E);
        }
    }
    if (PHASE != 0) {
        MoeDownSched S{lds, (const char*)(p.ws + OFF_HBUF), (const char*)(p.ws + OFF_WD16), k};
        EpiDown E{(bf16_t*)(p.ws + OFF_Y), (const int*)(p.ws + OFF_INVMAP), (const float*)(p.ws + OFF_WTS)};
        pg8::gemm_phase<EpiDown, MoeDownSched, true, true, true, true>(lds, 512, S, E);
    }
}

#include <hip/hip_bf16.h>
namespace fx {
using bf16 = __hip_bfloat16;
typedef short s16x4 __attribute__((ext_vector_type(4)));
typedef float f32x16 __attribute__((ext_vector_type(16)));
template <class A, class Bt> struct same_t { static constexpr bool v = false; };
template <class A> struct same_t<A, A> { static constexpr bool v = true; };
constexpr int D = 128; constexpr float THR = 8.f; constexpr bool WSKIP = false;
constexpr float SCALE = 0.08838834764831845f;
constexpr int NW = 8, QBLK = 32, KVBLK = 64, QB = NW * QBLK;
constexpr int SHM_V = KVBLK * D * 2, SHM_K = KVBLK * D * 2;
constexpr int FOX_BIAS_OFF = 2 * SHM_V + 2 * SHM_K + NW * 64 * 4;
#define KSWZ(row, colB) ((row) * 256 + ((colB) ^ (((row) & 7) << 4)))
#define SBAR() __builtin_amdgcn_sched_barrier(0)
__device__ __forceinline__ int v_st(int k, int c) { const int kk = (k & ~0xC) | ((k & 4) << 1) | ((k & 8) >> 1); return ((kk >> 3) * 4 + (c >> 5)) * 512 + ((kk & 7) * 32 + (c & 31)) * 2; }
__device__ __forceinline__ int v_rd_base(int lane) { return ((lane & 3) << 3) | (((lane >> 2) & 3) << 6) | (((lane >> 4) & 1) << 5) | (((lane >> 5) & 1) << 8); }
constexpr int v_rd_off(int d0, int ks, int half) { return d0 * 512 + ks * 4096 + half * 2048; }
__device__ __forceinline__ int crow(int r, int hi) { return (r & 3) + 8 * (r >> 2) + 4 * hi; }

__device__ __forceinline__ bf16x8 pack8(f32x4 a, f32x4 b) {
    u32x4 w = {cvtpk(a[0], a[1]), cvtpk(a[2], a[3]), cvtpk(b[0], b[1]), cvtpk(b[2], b[3])};
    return *reinterpret_cast<bf16x8*>(&w);
}
template <class T> __device__ __forceinline__ bf16x8 load8(const T* p) {
    if constexpr (same_t<T, float>::v) { return pack8(*(const f32x4*)p, *(const f32x4*)(p + 4)); }
    else { return *reinterpret_cast<const bf16x8*>(p); }
}
__device__ __forceinline__ void mask_tile(f32x16& p0, f32x16& p1, int dq, unsigned W) {
    const float NEG = -__builtin_inff();
#pragma unroll
    for (int r = 0; r < 16; ++r) {
        const int c = (r & 3) + 8 * (r >> 2);
        if ((unsigned)(dq - c) >= W) p0[r] = NEG;
        if ((unsigned)(dq - c - 32) >= W) p1[r] = NEG;
    }
}
__device__ __forceinline__ void partialSM(f32x16& p0, f32x16& p1, float& m_reg, float& mn, float& alpha) {
    float pmax = p0[0]; for (int r = 1; r < 16; ++r) pmax = fmaxf(pmax, p0[r]); for (int r = 0; r < 16; ++r) pmax = fmaxf(pmax, p1[r]);
    { auto rr = __builtin_amdgcn_permlane32_swap(__float_as_uint(pmax), __float_as_uint(pmax), false, false);
      pmax = fmaxf(__uint_as_float(rr[0]), __uint_as_float(rr[1])); }
    constexpr float C2 = 1.4426950408889634f * SCALE;
    if (__builtin_expect(__all((pmax - m_reg) * SCALE <= THR), 1)) { mn = m_reg; alpha = 1.f; }
    else { mn = fmaxf(m_reg, pmax); alpha = __builtin_amdgcn_exp2f((m_reg - mn) * C2); m_reg = mn; }
    const float mnL = -mn * C2;
    for (int r = 0; r < 16; ++r) p0[r] = fmaf(p0[r], C2, mnL); for (int r = 0; r < 16; ++r) p1[r] = fmaf(p1[r], C2, mnL);
    for (int r = 0; r < 16; ++r) p0[r] = __builtin_amdgcn_exp2f(p0[r]);
}
__device__ __forceinline__ void finishSM(f32x16& p0, f32x16& p1, float alpha, float& l_reg, bf16x8& pa0, bf16x8& pa1, bf16x8& pa2, bf16x8& pa3) {
    for (int r = 0; r < 16; ++r) p1[r] = __builtin_amdgcn_exp2f(p1[r]);
    float ps = 0; for (int r = 0; r < 16; ++r) ps += p0[r]; for (int r = 0; r < 16; ++r) ps += p1[r];
    { auto rr = __builtin_amdgcn_permlane32_swap(__float_as_uint(ps), __float_as_uint(ps), false, false);
      ps = __uint_as_float(rr[0]) + __uint_as_float(rr[1]); }
    l_reg = l_reg * alpha + ps;
#define PK4(P, B_, OUT) do { unsigned a0 = cvtpk(P[B_+0], P[B_+1]), a1 = cvtpk(P[B_+2], P[B_+3]);                          \
        unsigned b0 = cvtpk(P[B_+4], P[B_+5]), b1 = cvtpk(P[B_+6], P[B_+7]);                                             \
        auto r0 = __builtin_amdgcn_permlane32_swap(a0, b0, false, false); auto r1 = __builtin_amdgcn_permlane32_swap(a1, b1, false, false); \
        u32x4 w = {r0[0], r1[0], r0[1], r1[1]}; OUT = *reinterpret_cast<bf16x8*>(&w); } while (0)
    PK4(p0, 0, pa0); PK4(p0, 8, pa1); PK4(p1, 0, pa2); PK4(p1, 8, pa3);
#undef PK4
}
template <int KB, bool SK>
__device__ __forceinline__ void qkt(f32x16& p0, f32x16& p1, const char* K_lds, int r32, int hi, const bf16x8* qr, bool act, const float* bias) {
    if (SK && !act) { const float NEG = -__builtin_inff();
#pragma unroll
        for (int r = 0; r < 16; ++r) { p0[r] = NEG; p1[r] = NEG; } return; }
    { const f32x4* bp = (const f32x4*)(bias + 4 * hi);
#pragma unroll
      for (int g = 0; g < 4; ++g) { const f32x4 a = bp[2 * g], b = bp[8 + 2 * g];
          p0[4 * g] = a[0]; p0[4 * g + 1] = a[1]; p0[4 * g + 2] = a[2]; p0[4 * g + 3] = a[3];
          p1[4 * g] = b[0]; p1[4 * g + 1] = b[1]; p1[4 * g + 2] = b[2]; p1[4 * g + 3] = b[3]; } }
    const char* kb[4];
#pragma unroll
    for (int dd = 0; dd < 4; ++dd) kb[dd] = K_lds + KB * SHM_K + KSWZ(r32, (dd * 16 + hi * 8) * 2);
#pragma unroll
    for (int d0 = 0; d0 < 8; ++d0) { const char* a = kb[d0 & 3] + (d0 >> 2) * 128;
        bf16x8 b0 = *reinterpret_cast<const bf16x8*>(a);
        bf16x8 b1 = *reinterpret_cast<const bf16x8*>(a + 32 * 256);
        p0 = __builtin_amdgcn_mfma_f32_32x32x16_bf16(b0, qr[d0], p0, 0, 0, 0);
        p1 = __builtin_amdgcn_mfma_f32_32x32x16_bf16(b1, qr[d0], p1, 0, 0, 0); }
}
template <int VB, bool SK>
__device__ __forceinline__ void pv_tile(f32x16* o, int vb0, bf16x8 pa0, bf16x8 pa1, bf16x8 pa2, bf16x8 pa3, bool act) {
    if (SK && !act) return;
#define TRRD(dst, off) asm volatile("ds_read_b64_tr_b16 %0, %1 offset:%2" : "=&v"(dst) : "v"(vb0), "i"(off) : "memory")
#define PV_D0(d0) do { s16x4 l0, l1, l2, l3, h0, h1, h2, h3; constexpr int b_ = VB * SHM_V + v_rd_off(d0, 0, 0);     \
        TRRD(l0, b_); TRRD(h0, b_ + 2048); TRRD(l1, b_ + 4096); TRRD(h1, b_ + 6144); TRRD(l2, b_ + 8192); TRRD(h2, b_ + 10240); TRRD(l3, b_ + 12288); TRRD(h3, b_ + 14336); \
        asm volatile("s_waitcnt lgkmcnt(0)" ::: "memory"); SBAR();                 \
        o[d0] = __builtin_amdgcn_mfma_f32_32x32x16_bf16(pa0, (bf16x8){l0[0], l0[1], l0[2], l0[3], h0[0], h0[1], h0[2], h0[3]}, o[d0], 0, 0, 0);   \
        o[d0] = __builtin_amdgcn_mfma_f32_32x32x16_bf16(pa1, (bf16x8){l1[0], l1[1], l1[2], l1[3], h1[0], h1[1], h1[2], h1[3]}, o[d0], 0, 0, 0);   \
        o[d0] = __builtin_amdgcn_mfma_f32_32x32x16_bf16(pa2, (bf16x8){l2[0], l2[1], l2[2], l2[3], h2[0], h2[1], h2[2], h2[3]}, o[d0], 0, 0, 0);   \
        o[d0] = __builtin_amdgcn_mfma_f32_32x32x16_bf16(pa3, (bf16x8){l3[0], l3[1], l3[2], l3[3], h3[0], h3[1], h3[2], h3[3]}, o[d0], 0, 0, 0); } while (0)
    PV_D0(0); PV_D0(1); PV_D0(2); PV_D0(3);
#undef PV_D0
#undef TRRD
}

template <class TIn, class TOut> struct BlockRef { const TIn* Q; const TIn* K; const TIn* V; TOut* O; int P0; const float* bias; const float* g; int jlo; };
template <class TIn> struct Seam {
    bf16x8 qr[8];
    bf16x8 st_v0, st_v1, st_k0, st_k1; f32x4 sf0, sf1, sf2, sf3;
    f32x4 tq[16];
};
__device__ __forceinline__ int swa_jlo(int P0, int W) { const int lowk = P0 - W + 1; return lowk > 0 ? lowk / KVBLK : 0; }
#define ROW(p, k0, rr) ((p) + (size_t)((k0) + (rr)) * D + sc)
#define VMW() asm volatile("s_waitcnt vmcnt(0)" ::: "memory")
#define VMWN(n) asm volatile("s_waitcnt vmcnt(%0)" :: "i"(n) : "memory")
#define SLOAD_H(Kp, Vp, k0) do { S.st_v0 = load8<TIn>(ROW(Vp, k0, sr)); S.st_v1 = load8<TIn>(ROW(Vp, k0, 32 + sr));              \
                         S.st_k0 = load8<TIn>(ROW(Kp, k0, sr)); S.st_k1 = load8<TIn>(ROW(Kp, k0, 32 + sr)); } while (0)
#define SWRITE_HK(bf) do { *(bf16x8*)(K_lds + (bf) * SHM_K + kws) = S.st_k0; *(bf16x8*)(K_lds + (bf) * SHM_K + kws + 32 * 256) = S.st_k1; } while (0)
#define SWRITE_HV(bf) do { *(bf16x8*)(V_lds + (bf) * SHM_V + vst0) = S.st_v0; *(bf16x8*)(V_lds + (bf) * SHM_V + vst1) = S.st_v1; } while (0)
#define SWRITE_H(bf) do { SWRITE_HV(bf); SWRITE_HK(bf); } while (0)
#define SLOAD_F(p, k0) do { S.sf0 = *(const f32x4*)ROW(p, k0, sr); S.sf1 = *(const f32x4*)(ROW(p, k0, sr) + 4);                \
                            S.sf2 = *(const f32x4*)ROW(p, k0, 32 + sr); S.sf3 = *(const f32x4*)(ROW(p, k0, 32 + sr) + 4); } while (0)
#define SWRITE_KF(bf) do { *(bf16x8*)(K_lds + (bf) * SHM_K + kws) = pack8(S.sf0, S.sf1); *(bf16x8*)(K_lds + (bf) * SHM_K + kws + 32 * 256) = pack8(S.sf2, S.sf3); } while (0)
#define SWRITE_VF(bf) do { *(bf16x8*)(V_lds + (bf) * SHM_V + vst0) = pack8(S.sf0, S.sf1); *(bf16x8*)(V_lds + (bf) * SHM_V + vst1) = pack8(S.sf2, S.sf3); } while (0)
template <class TIn, class TOut>
__device__ __forceinline__ void causal_swa_prime(const BlockRef<TIn, TOut>& cur, int W, char* lds, Seam<TIn>& S) {
    constexpr bool F32 = same_t<TIn, float>::v;
    int tid = threadIdx.x; asm volatile("" : "+v"(tid));
    const int wid = __builtin_amdgcn_readfirstlane(tid >> 6), lane = tid & 63, r32 = lane & 31, hi = lane >> 5;
    const int sr = tid >> 4, sc = (tid & 15) * 8, kws = KSWZ(sr, sc * 2); char* K_lds = lds + 2 * SHM_V;
    const int kb0 = cur.jlo * KVBLK;
    for (int d0 = 0; d0 < 8; ++d0) S.qr[d0] = load8<TIn>(cur.Q + (size_t)(wid * QBLK + r32) * D + d0 * 16 + hi * 8);
    if constexpr (F32) { SLOAD_F((const float*)cur.K, kb0); VMW(); SWRITE_KF(0); SBAR(); SLOAD_F((const float*)cur.V, kb0); }
    else { SLOAD_H(cur.K, cur.V, kb0); VMW(); SWRITE_HK(0); }
    __syncthreads();
}
template <class TIn, class TOut>
__device__ __forceinline__ void causal_swa_block(const BlockRef<TIn, TOut>& cur, const BlockRef<TIn, TOut>& nxt, int skv, int W, char* lds, Seam<TIn>& S) {
    constexpr bool F32 = same_t<TIn, float>::v;
    int tid = threadIdx.x; asm volatile("" : "+v"(tid));
    const int wid = __builtin_amdgcn_readfirstlane(tid >> 6), lane = tid & 63, r32 = lane & 31, hi = lane >> 5;
    const int j_lo = cur.jlo;
    int j_hi = (cur.P0 + QB - 1) / KVBLK + 1; if (j_hi > skv / KVBLK) j_hi = skv / KVBLK;
    const int NT = j_hi - j_lo;
    const int kbn = swa_jlo(nxt.P0, W) * KVBLK;
    const int qlo = cur.P0 + wid * QBLK, qm = qlo + r32 - 4 * hi;
    char* V_lds = lds; char* K_lds = lds + 2 * SHM_V;
    float* ws = (float*)(lds + 2 * SHM_V + 2 * SHM_K) + wid * 64; float* li_l = ws, * al_l = ws + 32;
    float m_reg = -1e30f, l_reg = 0; f32x16 o[4] = {};
    const int sr = tid >> 4, sc = (tid & 15) * 8, vst0 = v_st(sr, sc), vst1 = v_st(32 + sr, sc), kws = KSWZ(sr, sc * 2);
    const int vb0 = (int)(uintptr_t)V_lds + v_rd_base(lane);
    const TIn* Kh = cur.K; const TIn* Vh = cur.V;
#define RESC(a) do { if (__any((a) < 1.f)) { if (hi == 0) al_l[r32] = (a); asm volatile("s_waitcnt lgkmcnt(0)" ::: "memory");              \
                     for (int d_ = 0; d_ < 4; ++d_) for (int r = 0; r < 16; ++r) o[d_][r] *= al_l[crow(r, hi)]; } } while (0)
#define KBASE(t) ((j_lo + (t)) * KVBLK)
#define BIAS(t) (cur.bias + (t) * KVBLK)
#define ACT(t) (KBASE(t) <= qlo + QBLK - 1 && KBASE(t) + KVBLK - 1 >= qlo - W + 1)
#define MASKT(P0_, P1_, t) do { const int kb_ = KBASE(t); if ((!SK || ACT(t)) && (kb_ + KVBLK - 1 > qlo || kb_ <= qlo + QBLK - 1 - W)) mask_tile(P0_, P1_, qm - kb_, (unsigned)W); } while (0)
    constexpr int NQL = F32 ? 16 : 8;
    constexpr bool SK = WSKIP && !F32;
#define SEAM_K0() do { VMWN(NQL); if constexpr (F32) { SWRITE_KF(0); SBAR(); SLOAD_F((const float*)nxt.V, kbn); } else { SWRITE_HK(0); } SBAR(); } while (0)
    f32x16 pA0, pA1, pB0, pB1; float mnA, mnB, alA, alB; bf16x8 pa0, pa1, pa2, pa3;
    if constexpr (F32) { VMW(); SWRITE_VF(0); SBAR(); } else { SWRITE_HV(0); SBAR(); }
    if (NT > 1) { if constexpr (F32) SLOAD_F((const float*)Kh, KBASE(1)); else SLOAD_H(Kh, Vh, KBASE(1)); }
    SBAR(); qkt<0, SK>(pA0, pA1, K_lds, r32, hi, S.qr, ACT(0), BIAS(0));
    if constexpr (F32) { if (NT > 1) { VMW(); SWRITE_KF(1); SBAR(); SLOAD_F((const float*)Vh, KBASE(1)); } }
    MASKT(pA0, pA1, 0); partialSM(pA0, pA1, m_reg, mnA, alA);
    if (NT > 1) { VMW(); if constexpr (F32) { SWRITE_VF(1); SBAR(); if (NT > 2) SLOAD_F((const float*)Kh, KBASE(2)); } else SWRITE_H(1); }
    __syncthreads();
#define HALF_STEP(PX0, PX1, mnX, alX, PY0, PY1, alY, t, KB, VB, SB) do {                                                      \
        SBAR(); qkt<KB, SK>(PX0, PX1, K_lds, r32, hi, S.qr, ACT(t), BIAS(t));                                             \
        finishSM(PY0, PY1, alY, l_reg, pa0, pa1, pa2, pa3); SBAR();                                                           \
        if ((t) + 1 < NT) { if constexpr (F32) { VMW(); SWRITE_KF(SB); SBAR(); SLOAD_F((const float*)Vh, KBASE((t) + 1)); }  \
                            else { SLOAD_H(Kh, Vh, KBASE((t) + 1)); } SBAR(); }                                               \
        pv_tile<VB, SK>(o, vb0, pa0, pa1, pa2, pa3, ACT((t) - 1)); MASKT(PX0, PX1, (t)); partialSM(PX0, PX1, m_reg, mnX, alX);                                        \
        __syncthreads();                                                                                                      \
        if ((t) + 1 < NT) { VMW(); if constexpr (F32) { SWRITE_VF(SB); SBAR(); if ((t) + 2 < NT) SLOAD_F((const float*)Kh, KBASE((t) + 2)); } \
                            else { SWRITE_H(SB); } }                                                                          \
        RESC(alX); __syncthreads(); } while (0)
    for (int t = 1; t + 1 < NT; t += 2) {
        HALF_STEP(pB0, pB1, mnB, alB, pA0, pA1, alA, t, 1, 0, 0);
        HALF_STEP(pA0, pA1, mnA, alA, pB0, pB1, alB, t + 1, 0, 1, 1);
    }
    const bool even = (NT & 1) == 0;
    if (even) { SBAR(); qkt<1, SK>(pB0, pB1, K_lds, r32, hi, S.qr, ACT(NT - 1), BIAS(NT - 1)); SBAR(); }
#define QROW(e) (nxt.Q + (size_t)(wid * QBLK + r32) * D + ((e) >> 1) * 16 + hi * 8 + ((e) & 1) * 4)
    if constexpr (F32) { SLOAD_F((const float*)nxt.K, kbn); SBAR();
#pragma unroll
        for (int e = 0; e < 8; ++e) S.tq[e] = *(const f32x4*)QROW(e); }
    SBAR();
    finishSM(pA0, pA1, alA, l_reg, pa0, pa1, pa2, pa3); SBAR();
    if constexpr (F32) {
#pragma unroll
        for (int e = 8; e < 16; ++e) S.tq[e] = *(const f32x4*)QROW(e); SBAR(); }
#undef QROW
    pv_tile<0, SK>(o, vb0, pa0, pa1, pa2, pa3, ACT(even ? NT - 2 : NT - 1));
    if (even) { MASKT(pB0, pB1, NT - 1); partialSM(pB0, pB1, m_reg, mnB, alB); __syncthreads(); RESC(alB);
        finishSM(pB0, pB1, alB, l_reg, pa0, pa1, pa2, pa3); SBAR(); pv_tile<1, SK>(o, vb0, pa0, pa1, pa2, pa3, ACT(NT - 1)); }
    SBAR();
    if (hi == 0) li_l[r32] = l_reg; asm volatile("s_waitcnt lgkmcnt(0)" ::: "memory");
    float rli[16];
#pragma unroll
    for (int r = 0; r < 16; ++r) rli[r] = __builtin_amdgcn_rcpf(li_l[crow(r, hi)]);
    {
        float rs[16];
#pragma unroll
        for (int r = 0; r < 16; ++r) { float s = 0.f;
#pragma unroll
            for (int d0 = 0; d0 < 4; ++d0) { o[d0][r] *= rli[r]; s += o[d0][r] * o[d0][r]; }
            s += sw_xor<1>(s); s += sw_xor<2>(s); s += sw_xor<4>(s); s += sw_xor<8>(s); s += sw_xor<16>(s);
            rs[r] = rsqrtf(s * (1.f / 128.f) + 1e-6f); }
        float gg[4];
#pragma unroll
        for (int d0 = 0; d0 < 4; ++d0) gg[d0] = cur.g[d0 * 32 + r32];
        TOut* Ow = cur.O + (size_t)(wid * QBLK) * 2048;
#pragma unroll
        for (int r = 0; r < 16; ++r) { const int orow = crow(r, hi);
#pragma unroll
            for (int d0 = 0; d0 < 4; ++d0) { const float v = o[d0][r] * rs[r] * gg[d0]; const float vn = sw_xor<1>(v);
                if ((r32 & 1) == 0) *(unsigned*)(Ow + (size_t)orow * 2048 + d0 * 32 + r32) = cvtpk(v, vn); } }
    }
    if constexpr (F32) {
#pragma unroll
        for (int d0 = 0; d0 < 8; ++d0) S.qr[d0] = pack8(S.tq[2 * d0], S.tq[2 * d0 + 1]); }
    __syncthreads();
#undef RESC
#undef KBASE
#undef BIAS
#undef ACT
#undef MASKT
#undef SEAM_K0
#undef HALF_STEP
}
#undef ROW
#undef VMW
#undef VMWN
#undef SLOAD_H
#undef SWRITE_HK
#undef SWRITE_HV
#undef SWRITE_H
#undef SLOAD_F
#undef SWRITE_KF
#undef SWRITE_VF
}

constexpr size_t OFF_NORMS = 32768;
__device__ __forceinline__ float sumsq8(uint4 v) {
    const float a0 = __uint_as_float(v.x << 16), a1 = __uint_as_float(v.x & 0xffff0000u), a2 = __uint_as_float(v.y << 16), a3 = __uint_as_float(v.y & 0xffff0000u);
    const float a4 = __uint_as_float(v.z << 16), a5 = __uint_as_float(v.z & 0xffff0000u), a6 = __uint_as_float(v.w << 16), a7 = __uint_as_float(v.w & 0xffff0000u);
    return (a0 * a0 + a1 * a1) + (a2 * a2 + a3 * a3) + (a4 * a4 + a5 * a5) + (a6 * a6 + a7 * a7);
}
__device__ __forceinline__ void phase_norms(const P& p, unsigned char* lds, int G, int bid) {
    int tid = threadIdx.x; asm volatile("" : "+v"(tid));
    const int lane = tid & 63, w = tid >> 6, sub = lane >> 4, l16 = lane & 15, gw = bid * NWAVES + w, NGW = G * NWAVES;
    float* red = (float*)lds;
    float mq[8], mk[8];
#pragma unroll
    for (int h = 0; h < 8; ++h) { mq[h] = 0.f; mk[h] = 0.f; }
    for (int g = gw; g < LR / 4; g += NGW) {
        uint4 vq[8], vk[8];
#pragma unroll
        for (int h = 0; h < 8; ++h) {
            vk[h] = *(const uint4*)((const bf16_t*)(p.ws + OFF_FK) + ((size_t)h * LR + g * 4 + sub) * 128 + l16 * 8);
            vq[h] = g < SEQ / 4 ? *(const uint4*)((const bf16_t*)(p.ws + OFF_FQ) + ((size_t)h * SEQ + g * 4 + sub) * 128 + l16 * 8) : make_uint4(0u, 0u, 0u, 0u);
        }
#pragma unroll
        for (int h = 0; h < 8; ++h) {
            float a = sumsq8(vq[h]), b = sumsq8(vk[h]);
            a += sw_xor<1>(a); b += sw_xor<1>(b); a += sw_xor<2>(a); b += sw_xor<2>(b);
            a += sw_xor<4>(a); b += sw_xor<4>(b); a += sw_xor<8>(a); b += sw_xor<8>(b);
            mq[h] = fmaxf(mq[h], a); mk[h] = fmaxf(mk[h], b);
        }
    }
#pragma unroll
    for (int h = 0; h < 8; ++h) { const float a = wave_max(mq[h]), b = wave_max(mk[h]); if (lane == 0) { red[(h * 2) * 8 + w] = a; red[(h * 2 + 1) * 8 + w] = b; } }
    __syncthreads();
    if (tid < 16) { float m = 0.f;
#pragma unroll
        for (int q = 0; q < 8; ++q) m = fmaxf(m, red[tid * 8 + q]);
        ((float*)(p.ws + OFF_NORMS))[(size_t)bid * 16 + tid] = m; }
    __syncthreads();
}

__device__ __forceinline__ void phase_fox(const P& p, unsigned char* lds_g, int G, int bid) {
    using namespace fx;
    for (int it = bid; it < 256; it += G) {
        int tid = threadIdx.x; asm volatile("" : "+v"(tid));
        const int lane = tid & 63, w = tid >> 6;
        const int h = it & 7, qb = 31 - (it >> 3);
        const int P0 = 64 + qb * 256, j_hi = (P0 + QB - 1) / KVBLK + 1;
        const float* CBh = (const float*)(p.ws + OFF_CB) + (size_t)h * LR;
        float* sc = (float*)(lds_g + FOX_BIAS_OFF);
        { float a = 0.f, b = 0.f; const float* NR = (const float*)(p.ws + OFF_NORMS);
          for (int i = tid; i < G; i += 512) { a = fmaxf(a, NR[(size_t)i * 16 + 2 * h]); b = fmaxf(b, NR[(size_t)i * 16 + 2 * h + 1]); }
          a = wave_max(a); b = wave_max(b); if (lane == 0) { sc[w] = a; sc[8 + w] = b; } }
        __syncthreads();
        float qm = 0.f, km = 0.f;
#pragma unroll
        for (int q = 0; q < 8; ++q) { qm = fmaxf(qm, sc[q]); km = fmaxf(km, sc[8 + q]); }
        const float T = 2.f * SCALE * sqrtf(qm * km) + 30.f;
        const float thr = CBh[P0] - T * (1.f / SCALE);
        const int j_lo = !FOX_SKIP ? (__syncthreads(), 0) : __syncthreads_count(tid < j_hi && !(CBh[64 * tid + 63 < LR ? 64 * tid + 63 : LR - 1] >= thr));
        { const f32x4* src = (const f32x4*)(CBh + j_lo * 64);
          f32x4* dst = (f32x4*)(lds_g + FOX_BIAS_OFF);
          for (int i = tid; i < (j_hi - j_lo) * 16; i += 512) dst[i] = src[i]; }
        __syncthreads();
        BlockRef<bf16, bf16> cur;
        cur.Q = (const bf16*)(p.ws + OFF_FQ) + ((size_t)h * SEQ + qb * 256) * 128;
        cur.K = (const bf16*)(p.ws + OFF_FK) + (size_t)h * LR * 128;
        cur.V = (const bf16*)(p.ws + OFF_FV) + (size_t)h * LR * 128;
        cur.O = (bf16*)(p.ws + OFF_MIX) + (size_t)(qb * 256) * DM + 1024 + h * 128;
        cur.P0 = P0; cur.bias = (const float*)(lds_g + FOX_BIAS_OFF); cur.g = p.fox_g; cur.jlo = j_lo;
        Seam<bf16> S;
        causal_swa_prime<bf16, bf16>(cur, 1 << 30, (char*)lds_g, S);
        causal_swa_block<bf16, bf16>(cur, cur, LR, 1 << 30, (char*)lds_g, S);
    }
}

constexpr size_t OFF_UB = OFF_A0;
constexpr size_t OFF_SB = OFF_GLAO;
constexpr size_t OFF_DEC = 65536;
constexpr size_t WS_END_GLA = OFF_DEC + (size_t)128 * 4 * 128 * 4;
static_assert(WS_END_GLA <= OFF_A0, "ws map");
namespace gla {
using fx::s16x4; using fx::f32x16;
constexpr int L_ZS = 0, L_SEG = 4096, L_EX = 6144, L_V = 8192, L_A0 = 40960, L_A1 = 58368, L_A2 = 75776;
constexpr int RS = 272;
constexpr int KTS = 144;
#define GLA_TRRD(dst, base, off) asm volatile("ds_read_b64_tr_b16 %0, %1 offset:%2" : "=&v"(dst) : "v"(base), "i"(off) : "memory")
#define GLA_PK4(P, B_, OUT) do { unsigned a0 = cvtpk(P[B_+0], P[B_+1]), a1 = cvtpk(P[B_+2], P[B_+3]);                          \
        unsigned b0 = cvtpk(P[B_+4], P[B_+5]), b1 = cvtpk(P[B_+6], P[B_+7]);                                             \
        auto r0 = __builtin_amdgcn_permlane32_swap(a0, b0, false, false); auto r1 = __builtin_amdgcn_permlane32_swap(a1, b1, false, false); \
        u32x4 w_ = {r0[0], r1[0], r0[1], r1[1]}; OUT = __builtin_bit_cast(bf16x8, w_); } while (0)

struct CastPlan { const f32x4* s[6]; u32x2* d[6]; };
__device__ __forceinline__ CastPlan cast_plan_p1(const P& p, int it) { CastPlan c;
#pragma unroll
    for (int k = 0; k < 4; ++k) { c.s[k] = (const f32x4*)p.wg + (size_t)it * 16384 + k * 4096; c.d[k] = (u32x2*)(p.ws + OFF_WG16) + (size_t)it * 16384 + k * 4096; }
#pragma unroll
    for (int k = 0; k < 2; ++k) { c.s[4 + k] = (const f32x4*)p.wu + (size_t)it * 16384 + k * 4096; c.d[4 + k] = (u32x2*)(p.ws + OFF_WU16) + (size_t)it * 16384 + k * 4096; }
    return c; }
__device__ __forceinline__ CastPlan cast_plan_p3(const P& p, int it) { CastPlan c;
#pragma unroll
    for (int k = 0; k < 2; ++k) { c.s[k] = (const f32x4*)p.wu + (size_t)it * 16384 + 8192 + k * 4096; c.d[k] = (u32x2*)(p.ws + OFF_WU16) + (size_t)it * 16384 + 8192 + k * 4096; }
#pragma unroll
    for (int k = 0; k < 4; ++k) { c.s[2 + k] = (const f32x4*)p.wd + (size_t)it * 16384 + k * 4096; c.d[2 + k] = (u32x2*)(p.ws + OFF_WD16) + (size_t)it * 16384 + k * 4096; }
    return c; }
#define CAST_ISSUE(k) do { _Pragma("unroll") for (int j_ = 0; j_ < 8; ++j_) cv[j_] = nt_load(&cpl.s[k][j_ * 512 + tid]); } while (0)
#define CAST_FIN(k) do { _Pragma("unroll") for (int j_ = 0; j_ < 8; ++j_) nt_store((u32x2){cvtpk(cv[j_][0], cv[j_][1]), cvtpk(cv[j_][2], cv[j_][3])}, &cpl.d[k][j_ * 512 + tid]); } while (0)

__device__ __forceinline__ void stage_zv(const P& p, unsigned char* lds, int n, int h, int tid, bool with_z = true) {
    if (with_z && tid < 256) ((float4*)(lds + L_ZS))[tid] = ((const float4*)((const float*)(p.ws + OFF_GZ) + (size_t)n * 64 * 16))[tid];
    const bf16_t* GV = (const bf16_t*)(p.ws + OFF_GV) + ((size_t)h * LR + n * 64) * 256;
    const int sr = tid >> 4, sc = (tid & 15) * 8;
#pragma unroll
    for (int half = 0; half < 2; ++half)
#pragma unroll
        for (int kk = 0; kk < 2; ++kk) { const int key = sr + 32 * kk;
            const uint4 v = *(const uint4*)(GV + (size_t)key * 256 + half * 128 + sc);
            *(uint4*)(lds + L_V + half * 16384 + fx::v_st(key, sc)) = v; }
}
__device__ __forceinline__ void gate_compute(unsigned char* lds, int n, int tid, const float (&w2r)[16], float bgd, float (&b)[16], float& blast, float& bref) {
    const int d = tid & 127, rq = tid >> 7;
    const float* zs = (const float*)(lds + L_ZS);
    float run = 0.f;
#pragma unroll
    for (int ii = 0; ii < 16; ++ii) {
        const int i = rq * 16 + ii; const float4* z4 = (const float4*)(zs + i * 16);
        float lg = bgd;
#pragma unroll
        for (int q = 0; q < 4; ++q) { const float4 z = z4[q]; lg = fmaf(z.x, w2r[4 * q], lg); lg = fmaf(z.y, w2r[4 * q + 1], lg); lg = fmaf(z.z, w2r[4 * q + 2], lg); lg = fmaf(z.w, w2r[4 * q + 3], lg); }
        float la = logsigmoidf(lg) * (1.f / 16.f);
        if (n == 0 && i < 48) la = 0.f;
        run += la; b[ii] = run;
    }
    float la32;
    { const float4* z4 = (const float4*)(zs + 32 * 16); float lg = bgd;
#pragma unroll
      for (int q = 0; q < 4; ++q) { const float4 z = z4[q]; lg = fmaf(z.x, w2r[4 * q], lg); lg = fmaf(z.y, w2r[4 * q + 1], lg); lg = fmaf(z.z, w2r[4 * q + 2], lg); lg = fmaf(z.w, w2r[4 * q + 3], lg); }
      la32 = logsigmoidf(lg) * (1.f / 16.f); if (n == 0) la32 = 0.f; }
    float* seg = (float*)(lds + L_SEG);
    seg[rq * 128 + d] = run;
    __syncthreads();
    const float s0 = seg[d], s1 = seg[128 + d], s2 = seg[256 + d], s3 = seg[384 + d];
    const float prefix = (rq > 0 ? s0 : 0.f) + (rq > 1 ? s1 : 0.f) + (rq > 2 ? s2 : 0.f);
#pragma unroll
    for (int ii = 0; ii < 16; ++ii) b[ii] += prefix;
    blast = (s0 + s1) + (s2 + s3); bref = s0 + s1 + la32;
}

__device__ __forceinline__ void p1_item(const P& p, unsigned char* lds, int n, int h) {
    int tid = threadIdx.x; asm volatile("" : "+v"(tid));
    const int lane = tid & 63, w = __builtin_amdgcn_readfirstlane(tid >> 6), r = lane & 31, hh = lane >> 5;
    const int d = tid & 127, rq = tid >> 7;
    stage_zv(p, lds, n, h, tid);
    float kv[16], w2r[16];
    { const bf16_t* GK = (const bf16_t*)(p.ws + OFF_GK) + ((size_t)h * LR + n * 64 + rq * 16) * 128 + d;
#pragma unroll
      for (int ii = 0; ii < 16; ++ii) kv[ii] = bf2f(GK[(size_t)ii * 128]); }
#pragma unroll
    for (int r_ = 0; r_ < 16; ++r_) w2r[r_] = p.w2[r_ * 512 + h * 128 + d];
    const float bgd = p.bg[h * 128 + d];
    const CastPlan cpl = cast_plan_p1(p, n * 4 + h); f32x4 cv[8];
    CAST_ISSUE(0);
    __syncthreads();
    float b[16], blast, bref;
    gate_compute(lds, n, tid, w2r, bgd, b, blast, bref);
    CAST_FIN(0); CAST_ISSUE(1);
    { float* BB = (float*)(p.ws + OFF_BBUF) + (((size_t)n * 4 + h) * 64 + rq * 16) * 128 + d;
#pragma unroll
      for (int ii = 0; ii < 16; ++ii) BB[(size_t)ii * 128] = b[ii]; }
    { u32x4 w0, w1;
      float e[16];
#pragma unroll
      for (int ii = 0; ii < 16; ++ii) e[ii] = kv[ii] * fexp(blast - b[ii]);
      w0.x = cvtpk(e[0], e[1]); w0.y = cvtpk(e[2], e[3]); w0.z = cvtpk(e[4], e[5]); w0.w = cvtpk(e[6], e[7]);
      w1.x = cvtpk(e[8], e[9]); w1.y = cvtpk(e[10], e[11]); w1.z = cvtpk(e[12], e[13]); w1.w = cvtpk(e[14], e[15]);
      *(u32x4*)(lds + L_A0 + d * KTS + rq * 32) = w0; *(u32x4*)(lds + L_A0 + d * KTS + rq * 32 + 16) = w1;
      if (rq == 0) ((float*)(p.ws + OFF_DEC))[((size_t)n * 4 + h) * 128 + d] = fexp(blast); }
    CAST_FIN(1); CAST_ISSUE(2);
    __syncthreads();
    const int vb = (int)(uintptr_t)(lds + L_V) + fx::v_rd_base(lane) + (w >> 2) * 16384 + (w & 3) * 512;
    f32x16 acc[4];
#pragma unroll
    for (int db = 0; db < 4; ++db) acc[db] = f32x16{};
#define GLA_P1_KS(ks) do { s16x4 lo, hi4; GLA_TRRD(lo, vb, (ks) * 4096); GLA_TRRD(hi4, vb, (ks) * 4096 + 2048); \
        asm volatile("s_waitcnt lgkmcnt(0)" ::: "memory"); __builtin_amdgcn_sched_barrier(0); \
        const bf16x8 vf = (bf16x8){lo[0], lo[1], lo[2], lo[3], hi4[0], hi4[1], hi4[2], hi4[3]}; \
        _Pragma("unroll") for (int db = 0; db < 4; ++db) { const bf16x8 kf = *(const bf16x8*)(lds + L_A0 + (32 * db + r) * KTS + (16 * (ks) + 8 * hh) * 2); \
            acc[db] = __builtin_amdgcn_mfma_f32_32x32x16_bf16(vf, kf, acc[db], 0, 0, 0); } } while (0)
    GLA_P1_KS(0); GLA_P1_KS(1);
    CAST_FIN(2); CAST_ISSUE(3);
    GLA_P1_KS(2); GLA_P1_KS(3);
#undef GLA_P1_KS
    { unsigned char* stg = lds + 65536 + w * 8192;
#pragma unroll
      for (int x = 0; x < 16; ++x) { const int vrow = fx::crow(x, hh);
#pragma unroll
          for (int db = 0; db < 4; ++db) { const float v = acc[db][x], vn = sw_xor<1>(v);
              if ((r & 1) == 0) *(unsigned*)(stg + vrow * 256 + (32 * db + r) * 2) = cvtpk(v, vn); } }
      asm volatile("s_waitcnt lgkmcnt(0)" ::: "memory");
      CAST_FIN(3); CAST_ISSUE(4);
      bf16_t* UB = (bf16_t*)(p.ws + OFF_UB) + ((size_t)n * 4 + h) * 256 * 128 + (size_t)(32 * w) * 128;
#pragma unroll
      for (int i = 0; i < 8; ++i) { const int row = i * 4 + (lane >> 4), ch = lane & 15;
          *(u32x4*)(UB + (size_t)row * 128 + ch * 8) = *(const u32x4*)(stg + row * 256 + ch * 16); } }
    CAST_FIN(4); CAST_ISSUE(5);
    __syncthreads();
    CAST_FIN(5);
}

__device__ __forceinline__ void scan_thread(const P& p, int gid) {
    const int d2 = gid & 63, hv = gid >> 6, h = hv >> 8;
    const unsigned* UB = (const unsigned*)(p.ws + OFF_UB) + (size_t)hv * 64 + d2;
    unsigned* SB = (unsigned*)(p.ws + OFF_SB) + (size_t)hv * 64 + d2;
    const float2* DEC = (const float2*)(p.ws + OFF_DEC) + (size_t)h * 64 + d2;
    float s0 = 0.f, s1 = 0.f;
    for (int n0 = 0; n0 < 128; n0 += 32) {
        unsigned u[32]; float2 dc[32];
#pragma unroll
        for (int j = 0; j < 32; ++j) { u[j] = UB[(size_t)(n0 + j) * (4 * 256 * 64)]; dc[j] = DEC[(size_t)(n0 + j) * (4 * 64)]; }
#pragma unroll
        for (int j = 0; j < 32; ++j) {
            s0 = fmaf(dc[j].x, s0, __uint_as_float(u[j] << 16)); s1 = fmaf(dc[j].y, s1, __uint_as_float(u[j] & 0xffff0000u));
            SB[(size_t)(n0 + j) * (4 * 256 * 64)] = cvtpk(s0, s1);
        }
    }
}

__device__ __forceinline__ void p3_item(const P& p, unsigned char* lds, int n, int h) {
    int tid = threadIdx.x; asm volatile("" : "+v"(tid));
    const int lane = tid & 63, w = __builtin_amdgcn_readfirstlane(tid >> 6), r = lane & 31, hh = lane >> 5;
    const int d = tid & 127, rq = tid >> 7, rb = w & 1, cg = w >> 1;
    const bool fast = n < 128;
    float qv[16], kv[16], b[16], bref;
    { const size_t off = ((size_t)h * LR + n * 64 + rq * 16) * 128 + d;
      const bf16_t* GQ = (const bf16_t*)(p.ws + OFF_GQ) + off; const bf16_t* GK = (const bf16_t*)(p.ws + OFF_GK) + off;
#pragma unroll
      for (int ii = 0; ii < 16; ++ii) { qv[ii] = bf2f(GQ[(size_t)ii * 128]) * SCALE128; kv[ii] = bf2f(GK[(size_t)ii * 128]); } }
    if (fast) { const float* BB = (const float*)(p.ws + OFF_BBUF) + (((size_t)n * 4 + h) * 64) * 128 + d;
#pragma unroll
        for (int ii = 0; ii < 16; ++ii) b[ii] = BB[(size_t)(rq * 16 + ii) * 128];
        bref = BB[(size_t)32 * 128]; }
    stage_zv(p, lds, n, h, tid, !fast);
    const CastPlan cpl = cast_plan_p3(p, (n - 1) * 4 + h); f32x4 cv[8];
    CAST_ISSUE(0);
    __syncthreads();
    bf16x8 sfr[2][8];
    { const bf16_t* SB = (const bf16_t*)(p.ws + OFF_SB) + ((size_t)(n - 1) * 4 + h) * 256 * 128 + (size_t)(64 * cg + r) * 128 + 8 * hh;
#pragma unroll
      for (int tl = 0; tl < 2; ++tl)
#pragma unroll
          for (int s_ = 0; s_ < 8; ++s_) sfr[tl][s_] = *(const bf16x8*)(SB + (size_t)tl * 32 * 128 + 16 * s_); }
    if (!fast) { float w2r[16], blast;
#pragma unroll
        for (int r_ = 0; r_ < 16; ++r_) w2r[r_] = p.w2[r_ * 512 + h * 128 + d];
        gate_compute(lds, n, tid, w2r, p.bg[h * 128 + d], b, blast, bref); }
    const float ebref = fexp(bref);
#pragma unroll
    for (int ii = 0; ii < 16; ++ii) {
        const int i = rq * 16 + ii;
        const float eq = fexp(b[ii] - bref);
        *(bf16_t*)(lds + L_A0 + i * RS + d * 2) = f2bf(qv[ii] * eq);
        *(bf16_t*)(lds + L_A1 + i * RS + d * 2) = f2bf(qv[ii] * (eq * ebref));
        *(bf16_t*)(lds + L_A2 + i * RS + d * 2) = f2bf(kv[ii] * __builtin_amdgcn_rcpf(eq));
    }
    CAST_FIN(0); CAST_ISSUE(1);
    __syncthreads();
    f32x16 P0 = f32x16{}, P1v = f32x16{};
#pragma unroll
    for (int s_ = 0; s_ < 8; ++s_) {
        const bf16x8 qf = *(const bf16x8*)(lds + L_A0 + (32 * rb + r) * RS + (16 * s_ + 8 * hh) * 2);
        const bf16x8 k0 = *(const bf16x8*)(lds + L_A2 + r * RS + (16 * s_ + 8 * hh) * 2);
        P0 = __builtin_amdgcn_mfma_f32_32x32x16_bf16(k0, qf, P0, 0, 0, 0);
        if (rb) { const bf16x8 k1 = *(const bf16x8*)(lds + L_A2 + (32 + r) * RS + (16 * s_ + 8 * hh) * 2);
                  P1v = __builtin_amdgcn_mfma_f32_32x32x16_bf16(k1, qf, P1v, 0, 0, 0); }
    }
#pragma unroll
    for (int x = 0; x < 16; ++x) { const bool keep = fx::crow(x, hh) <= r; if (rb) { if (!keep) P1v[x] = 0.f; } else { if (!keep) P0[x] = 0.f; } }
    bf16x8 pa0, pa1, pa2, pa3;
    GLA_PK4(P0, 0, pa0); GLA_PK4(P0, 8, pa1); GLA_PK4(P1v, 0, pa2); GLA_PK4(P1v, 8, pa3);
    CAST_FIN(1); CAST_ISSUE(2);
    f32x16 o[2];
#pragma unroll
    for (int tl = 0; tl < 2; ++tl) {
        const int vblk = 2 * cg + tl;
        const int vb = (int)(uintptr_t)(lds + L_V) + fx::v_rd_base(lane) + (vblk >> 2) * 16384 + (vblk & 3) * 512;
        o[tl] = f32x16{};
#define GLA_PV(ks, PA) do { s16x4 lo, hi4; GLA_TRRD(lo, vb, (ks) * 4096); GLA_TRRD(hi4, vb, (ks) * 4096 + 2048); \
        asm volatile("s_waitcnt lgkmcnt(0)" ::: "memory"); __builtin_amdgcn_sched_barrier(0); \
        o[tl] = __builtin_amdgcn_mfma_f32_32x32x16_bf16(PA, (bf16x8){lo[0], lo[1], lo[2], lo[3], hi4[0], hi4[1], hi4[2], hi4[3]}, o[tl], 0, 0, 0); } while (0)
        GLA_PV(0, pa0); GLA_PV(1, pa1);
        if (rb) { GLA_PV(2, pa2); GLA_PV(3, pa3); }
#undef GLA_PV
#pragma unroll
        for (int s_ = 0; s_ < 8; ++s_) {
            const bf16x8 qh = *(const bf16x8*)(lds + L_A1 + (32 * rb + r) * RS + (16 * s_ + 8 * hh) * 2);
            o[tl] = __builtin_amdgcn_mfma_f32_32x32x16_bf16(qh, sfr[tl][s_], o[tl], 0, 0, 0);
        }
    }
    CAST_FIN(2); CAST_ISSUE(3);
    float* ex = (float*)(lds + L_EX);
#pragma unroll
    for (int x = 0; x < 16; ++x) { float s = o[0][x] * o[0][x] + o[1][x] * o[1][x];
        s += sw_xor<1>(s); s += sw_xor<2>(s); s += sw_xor<4>(s); s += sw_xor<8>(s); s += sw_xor<16>(s);
        if (r == 0) ex[(32 * rb + fx::crow(x, hh)) * 4 + cg] = s; }
    CAST_FIN(3); CAST_ISSUE(4);
    __syncthreads();
    const float g0 = p.gla_g[64 * cg + r], g1 = p.gla_g[64 * cg + 32 + r];
#pragma unroll
    for (int x = 0; x < 16; ++x) {
        const int row = 32 * rb + fx::crow(x, hh); const f32x4 e4 = *(const f32x4*)(ex + row * 4);
        const float rs = rsqrtf(((e4[0] + e4[1]) + (e4[2] + e4[3])) * (1.f / 256.f) + EPS);
        const size_t t = (size_t)(n - 1) * 64 + row;
        const bf16_t* GR = (const bf16_t*)(p.ws + OFF_GR) + t * 1024 + h * 256 + 64 * cg + r;
        bf16_t* MX = (bf16_t*)(p.ws + OFF_MIX) + t * DM + h * 256 + 64 * cg + r;
        const float v0 = o[0][x] * rs * g0 * siluf(bf2f(GR[0])), v1 = o[1][x] * rs * g1 * siluf(bf2f(GR[32]));
        const float v0n = sw_xor<1>(v0), v1n = sw_xor<1>(v1);
        if ((r & 1) == 0) { *(unsigned*)MX = cvtpk(v0, v0n); *(unsigned*)(MX + 32) = cvtpk(v1, v1n); }
    }
    CAST_FIN(4); CAST_ISSUE(5);
    __syncthreads();
    CAST_FIN(5);
}
}
__device__ __forceinline__ void phase_gla_p1(const P& p, unsigned char* lds, int G, int bid) { for (int it = bid; it < 512; it += G) gla::p1_item(p, lds, it >> 2, it & 3); }
__device__ __forceinline__ void phase_gla_scan(const P& p, int G, int bid) {
    int tid = threadIdx.x; asm volatile("" : "+v"(tid));
    const int per = (65536 + G - 1) / G;
    for (int i = tid; i < per; i += 512) { const int g = bid * per + i; if (g < 65536) gla::scan_thread(p, g); }
}
__device__ __forceinline__ void phase_gla_p3(const P& p, unsigned char* lds, int G, int bid) { for (int it = bid; it < 512; it += G) gla::p3_item(p, lds, 1 + (it >> 2), it & 3); }


__device__ __forceinline__ void cscan_head(const P& p, unsigned char* lds, int h) {
    int tid = threadIdx.x; asm volatile("" : "+v"(tid));
    const int lane = tid & 63, w = tid >> 6;
    const float* FLOG = (const float*)(p.ws + OFF_FLOG) + h;
    float* CB = (float*)(p.ws + OFF_CB) + (size_t)h * LR;
    const float bf = p.b_f[h];
    const int l0 = tid * 17;
    float v[17]; float run = 0.f;
#pragma unroll
    for (int k = 0; k < 17; ++k) { const int l = l0 + k; const float x = (l >= 48 && l < LR) ? FLOG[(size_t)l * 8] : 0.f; v[k] = x; }
#pragma unroll
    for (int k = 0; k < 17; ++k) { const int l = l0 + k; const float la = (l >= 48 && l < LR) ? logsigmoidf(v[k] + bf) : 0.f; run += la; v[k] = run; }
    float inc = run;
#pragma unroll
    for (int o = 1; o < 64; o <<= 1) { const float t = shfl_from(inc, lane - o); if (lane >= o) inc += t; }
    float* wt = (float*)lds;
    if (lane == 63) wt[w] = inc;
    __syncthreads();
    float woff = 0.f;
#pragma unroll
    for (int q = 0; q < 8; ++q) woff += (q < w) ? wt[q] : 0.f;
    const float pre = woff + (inc - run);
#pragma unroll
    for (int k = 0; k < 17; ++k) { const int l = l0 + k; if (l < LR) CB[l] = l >= 48 ? -(pre + v[k]) * (1.f / SCALE128) : -1e30f; }
    __syncthreads();
}
__device__ __forceinline__ void phase_cscan(const P& p, unsigned char* lds, int G, int bid) { for (int h = bid; h < 8; h += G) cscan_head(p, lds, h); }

__device__ __forceinline__ void router_row(const P& p, int t, int lane) {
    const float4* hr = (const float4*)(p.out + (size_t)t * DM);
    float4 u[8]; float ss = 0.f;
#pragma unroll
    for (int j = 0; j < 8; ++j) { u[j] = hr[lane + 64 * j]; ss += u[j].x * u[j].x + u[j].y * u[j].y + u[j].z * u[j].z + u[j].w * u[j].w; }
    ss = wave_sum(ss); const float rs = rsqrtf(ss * (1.f / DM) + EPS);
    uint2* U2 = (uint2*)((bf16_t*)(p.ws + OFF_U2) + (size_t)t * DM);
    float gl[4] = {0.f, 0.f, 0.f, 0.f};
#pragma unroll
    for (int j = 0; j < 8; ++j) {
        const float4 g = ((const float4*)p.g2)[lane + 64 * j];
        u[j].x *= rs * g.x; u[j].y *= rs * g.y; u[j].z *= rs * g.z; u[j].w *= rs * g.w;
        U2[lane + 64 * j] = make_uint2(cvtpk(u[j].x, u[j].y), cvtpk(u[j].z, u[j].w));
        const float4* wr = (const float4*)p.w_rg + (size_t)(lane + 64 * j) * 4;
        const float4 a = wr[0], b = wr[1], c = wr[2], d = wr[3];
        gl[0] += u[j].x * a.x + u[j].y * b.x + u[j].z * c.x + u[j].w * d.x;
        gl[1] += u[j].x * a.y + u[j].y * b.y + u[j].z * c.y + u[j].w * d.y;
        gl[2] += u[j].x * a.z + u[j].y * b.z + u[j].z * c.z + u[j].w * d.z;
        gl[3] += u[j].x * a.w + u[j].y * b.w + u[j].z * c.w + u[j].w * d.w;
    }
#pragma unroll
    for (int g = 0; g < 4; ++g) gl[g] = wave_sum(gl[g]) + p.b_rg[g];
    int gi = 0; float gm = gl[0];
#pragma unroll
    for (int g = 1; g < 4; ++g) if (gl[g] > gm) { gm = gl[g]; gi = g; }
    float gs = 0.f;
#pragma unroll
    for (int g = 0; g < 4; ++g) gs += expf(gl[g] - gm);
    const float p_g = 1.f / gs;
    float el[8] = {0.f, 0.f, 0.f, 0.f, 0.f, 0.f, 0.f, 0.f};
    const float4* we = (const float4*)(p.w_re + (size_t)gi * DM * 8);
#pragma unroll
    for (int j = 0; j < 8; ++j) {
        const float uu[4] = {u[j].x, u[j].y, u[j].z, u[j].w};
#pragma unroll
        for (int i = 0; i < 4; ++i) {
            const int k = 4 * (lane + 64 * j) + i;
            const float4 a = we[(size_t)k * 2], b = we[(size_t)k * 2 + 1];
            el[0] += uu[i] * a.x; el[1] += uu[i] * a.y; el[2] += uu[i] * a.z; el[3] += uu[i] * a.w;
            el[4] += uu[i] * b.x; el[5] += uu[i] * b.y; el[6] += uu[i] * b.z; el[7] += uu[i] * b.w;
        }
    }
#pragma unroll
    for (int e = 0; e < 8; ++e) el[e] = wave_sum(el[e]) + p.b_re[gi * 8 + e];
    int i0 = 0; float l0 = el[0];
#pragma unroll
    for (int e = 1; e < 8; ++e) if (el[e] > l0) { l0 = el[e]; i0 = e; }
    int i1 = -1; float l1 = -INFINITY;
#pragma unroll
    for (int e = 0; e < 8; ++e) if (e != i0 && el[e] > l1) { l1 = el[e]; i1 = e; }
    const float e1 = expf(l1 - l0), w0 = p_g / (1.f + e1), w1 = p_g * e1 / (1.f + e1);
    if (lane == 0) {
        unsigned* cnt = (unsigned*)(p.ws + OFF_CTL);
        int* invmap = (int*)(p.ws + OFF_INVMAP); float* wts = (float*)(p.ws + OFF_WTS);
        const int E0 = gi * 8 + i0, E1 = gi * 8 + i1;
        const unsigned p0 = atomicAdd(&cnt[E0], 1u); invmap[E0 * SEQ + p0] = t * 2; wts[t * 2] = w0;
        const unsigned p1 = atomicAdd(&cnt[E1], 1u); invmap[E1 * SEQ + p1] = t * 2 + 1; wts[t * 2 + 1] = w1;
    }
}
__device__ __forceinline__ void phase_router(const P& p, unsigned char* lds, int G, int bid) {
    int tid = threadIdx.x; asm volatile("" : "+v"(tid));
    const int lane = tid & 63, w = __builtin_amdgcn_readfirstlane(tid >> 6), r = lane & 15, q = lane >> 4;
    float* red = (float*)lds; float* rsc = (float*)(lds + 1024); float* part = (float*)(lds + 2048); float* lgt = (float*)(lds + 2048 + 49152);
    for (int rb = bid; rb < SEQ / 32; rb += G) {
        const int row0 = rb * 32;
        const float* pa0 = p.out + (size_t)(row0 + r) * DM + 256 * w + 4 * q;
        const float* pa1 = pa0 + (size_t)16 * DM;
        const float* pg = p.g2 + 256 * w + 4 * q;
        const float* pb0 = p.w_rg + (size_t)(256 * w + 4 * q) * 4 + (r < 4 ? r : 0);
        const float* pb1 = p.w_re + ((size_t)(r >> 3) * DM + 256 * w + 4 * q) * 8 + (r & 7);
        const float* pb2 = pb1 + (size_t)2 * DM * 8;
        const float m0 = r < 4 ? 1.f : 0.f;
        f32x4 acc[2][3];
#pragma unroll
        for (int rbk = 0; rbk < 2; ++rbk)
#pragma unroll
            for (int cb = 0; cb < 3; ++cb) acc[rbk][cb] = (f32x4){0.f, 0.f, 0.f, 0.f};
        float ss0 = 0.f, ss1 = 0.f;
#pragma unroll 2
        for (int t = 0; t < 16; ++t) {
            const f32x4 a0 = *(const f32x4*)(pa0 + 16 * t), a1 = *(const f32x4*)(pa1 + 16 * t), g4 = *(const f32x4*)(pg + 16 * t);
            ss0 += (a0[0] * a0[0] + a0[1] * a0[1]) + (a0[2] * a0[2] + a0[3] * a0[3]);
            ss1 += (a1[0] * a1[0] + a1[1] * a1[1]) + (a1[2] * a1[2] + a1[3] * a1[3]);
#pragma unroll
            for (int s_ = 0; s_ < 4; ++s_) {
                const float b0 = pb0[(16 * t + s_) * 4] * (g4[s_] * m0), b1 = pb1[(16 * t + s_) * 8] * g4[s_], b2 = pb2[(16 * t + s_) * 8] * g4[s_];
                acc[0][0] = __builtin_amdgcn_mfma_f32_16x16x4f32(a0[s_], b0, acc[0][0], 0, 0, 0); acc[1][0] = __builtin_amdgcn_mfma_f32_16x16x4f32(a1[s_], b0, acc[1][0], 0, 0, 0);
                acc[0][1] = __builtin_amdgcn_mfma_f32_16x16x4f32(a0[s_], b1, acc[0][1], 0, 0, 0); acc[1][1] = __builtin_amdgcn_mfma_f32_16x16x4f32(a1[s_], b1, acc[1][1], 0, 0, 0);
                acc[0][2] = __builtin_amdgcn_mfma_f32_16x16x4f32(a0[s_], b2, acc[0][2], 0, 0, 0); acc[1][2] = __builtin_amdgcn_mfma_f32_16x16x4f32(a1[s_], b2, acc[1][2], 0, 0, 0);
            }
        }
        ss0 += sw_xor<16>(ss0); ss0 = x32_sum(ss0); ss1 += sw_xor<16>(ss1); ss1 = x32_sum(ss1);
        if (q == 0) { red[w * 32 + r] = ss0; red[w * 32 + 16 + r] = ss1; }
#pragma unroll
        for (int rbk = 0; rbk < 2; ++rbk)
#pragma unroll
            for (int cb = 0; cb < 3; ++cb)
#pragma unroll
                for (int i = 0; i < 4; ++i) part[((w * 2 + rbk) * 16 + 4 * q + i) * 48 + 16 * cb + r] = acc[rbk][cb][i];
        __syncthreads();
        if (tid < 32) { float ss = 0.f;
#pragma unroll
            for (int ww = 0; ww < 8; ++ww) ss += red[ww * 32 + tid];
            rsc[tid] = rsqrtf(ss * (1.f / DM) + EPS); }
        for (int idx = tid; idx < 32 * 48; idx += 512) { const int row = idx / 48, col = idx - row * 48; float sum = 0.f;
#pragma unroll
            for (int ww = 0; ww < 8; ++ww) sum += part[((ww * 2 + (row >> 4)) * 16 + (row & 15)) * 48 + col];
            lgt[idx] = sum; }
        __syncthreads();
        { const float rs0 = rsc[r], rs1 = rsc[16 + r];
          bf16_t* U2 = (bf16_t*)(p.ws + OFF_U2) + (size_t)(row0 + r) * DM + 256 * w + 4 * q;
#pragma unroll 4
          for (int t = 0; t < 16; ++t) { const f32x4 g4 = *(const f32x4*)(pg + 16 * t);
              const f32x4 v0 = *(const f32x4*)(pa0 + 16 * t) * g4 * rs0, v1 = *(const f32x4*)(pa1 + 16 * t) * g4 * rs1;
              *(uint2*)(U2 + 16 * t) = make_uint2(cvtpk(v0[0], v0[1]), cvtpk(v0[2], v0[3]));
              *(uint2*)(U2 + (size_t)16 * DM + 16 * t) = make_uint2(cvtpk(v1[0], v1[1]), cvtpk(v1[2], v1[3])); } }
        if (tid < 32) {
            const int t = row0 + tid; const float rs = rsc[tid]; const float* L = lgt + tid * 48;
            float gl[4];
#pragma unroll
            for (int g = 0; g < 4; ++g) gl[g] = L[g] * rs + p.b_rg[g];
            int gi = 0; float gm = gl[0];
#pragma unroll
            for (int g = 1; g < 4; ++g) if (gl[g] > gm) { gm = gl[g]; gi = g; }
            float gs = 0.f;
#pragma unroll
            for (int g = 0; g < 4; ++g) gs += expf(gl[g] - gm);
            const float p_g = 1.f / gs;
            float el[8];
#pragma unroll
            for (int e = 0; e < 8; ++e) el[e] = L[16 + gi * 8 + e] * rs + p.b_re[gi * 8 + e];
            int i0 = 0; float l0 = el[0];
#pragma unroll
            for (int e = 1; e < 8; ++e) if (el[e] > l0) { l0 = el[e]; i0 = e; }
            int i1 = -1; float l1 = -INFINITY;
#pragma unroll
            for (int e = 0; e < 8; ++e) if (e != i0 && el[e] > l1) { l1 = el[e]; i1 = e; }
            const float e1 = expf(l1 - l0), w0 = p_g / (1.f + e1), w1 = p_g * e1 / (1.f + e1);
            unsigned* cnt = (unsigned*)(p.ws + OFF_CTL);
            int* invmap = (int*)(p.ws + OFF_INVMAP); float* wts = (float*)(p.ws + OFF_WTS);
            const int E0 = gi * 8 + i0, E1 = gi * 8 + i1;
            const unsigned p0 = atomicAdd(&cnt[E0], 1u); invmap[E0 * SEQ + p0] = t * 2; wts[t * 2] = w0;
            const unsigned p1 = atomicAdd(&cnt[E1], 1u); invmap[E1 * SEQ + p1] = t * 2 + 1; wts[t * 2 + 1] = w1;
        }
        __syncthreads();
    }
}
__device__ __forceinline__ void final_row(const P& p, int t, int lane) {
    float4* hr = (float4*)(p.out + (size_t)t * DM);
    const uint2* y0 = (const uint2*)((const bf16_t*)(p.ws + OFF_Y) + (size_t)t * DM);
    const uint2* y1 = (const uint2*)((const bf16_t*)(p.ws + OFF_Y) + (size_t)SEQ * DM + (size_t)t * DM);
    float4 v[8]; float ss = 0.f;
#pragma unroll
    for (int j = 0; j < 8; ++j) {
        { const f32x4 t_ = nt_load((const f32x4*)hr + lane + 64 * j); v[j] = make_float4(t_[0], t_[1], t_[2], t_[3]); }
        const u32x2 a_ = nt_load((const u32x2*)y0 + lane + 64 * j), b_ = nt_load((const u32x2*)y1 + lane + 64 * j); const uint2 a = make_uint2(a_[0], a_[1]), b = make_uint2(b_[0], b_[1]);
        v[j].x += __uint_as_float(a.x << 16) + __uint_as_float(b.x << 16);
        v[j].y += __uint_as_float(a.x & 0xffff0000u) + __uint_as_float(b.x & 0xffff0000u);
        v[j].z += __uint_as_float(a.y << 16) + __uint_as_float(b.y << 16);
        v[j].w += __uint_as_float(a.y & 0xffff0000u) + __uint_as_float(b.y & 0xffff0000u);
        ss += v[j].x * v[j].x + v[j].y * v[j].y + v[j].z * v[j].z + v[j].w * v[j].w;
    }
    ss = wave_sum(ss); float rs = rsqrtf(ss * (1.f / DM) + EPS);
#pragma unroll
    for (int j = 0; j < 8; ++j) {
        const float4 g = ((const float4*)p.gf)[lane + 64 * j];
        nt_store((f32x4){v[j].x * rs * g.x, v[j].y * rs * g.y, v[j].z * rs * g.z, v[j].w * rs * g.w}, (f32x4*)hr + lane + 64 * j);
    }
}
__device__ __forceinline__ void phase_final(const P& p, int G, int bid) {
    int tid = threadIdx.x; asm volatile("" : "+v"(tid));
    const int lane = tid & 63, gw = bid * NWAVES + (tid >> 6);
    for (int t = gw; t < SEQ; t += G * NWAVES) final_row(p, t, lane);
}

constexpr int CW_BAR = 4096;
constexpr size_t CTL_ZERO_BYTES = 32768;
#define XB_TMO      128
#define XB_XCNT(j)  (256  + 64 * (j))
#define XB_XSUB(j)  (1280 + 64 * (j))
#define XB_XGEN(j)  (2304 + 64 * (j))
#define XB_TOP      3328
#define XB_TOPGEN   3392
#define XCD_BAR_WORDS 3456
#define XB_SPIN_CAP (1u << 22)
static_assert((CW_BAR + XCD_BAR_WORDS) * 4 <= (int)CTL_ZERO_BYTES, "barrier words inside the memset region");
__device__ __forceinline__ unsigned xb_ld(unsigned* p)              { return __hip_atomic_load(p, __ATOMIC_RELAXED, __HIP_MEMORY_SCOPE_AGENT); }
__device__ __forceinline__ unsigned xb_add(unsigned* p, unsigned v) { return __hip_atomic_fetch_add(p, v, __ATOMIC_RELAXED, __HIP_MEMORY_SCOPE_AGENT); }
__device__ __forceinline__ unsigned xb_xcc_id() { return (unsigned)__builtin_amdgcn_s_getreg((3 << 11) | 20) & 0xFu; }
#define XB_SPIN(cond, bar) do { unsigned _sp = 0; while (cond) { __builtin_amdgcn_s_sleep(1); \
    if ((++_sp & 255u) == 0u) { if (xb_ld(&(bar)[XB_TMO])) break; if (_sp > XB_SPIN_CAP) { atomicAdd(&(bar)[XB_TMO], 1u); break; } } } } while (0)
struct XcdBarrier { unsigned* bar; unsigned x; volatile LAS unsigned* st; };
__device__ __forceinline__ XcdBarrier xcd_barrier_post(unsigned* bar, volatile LAS unsigned* st) {
    XcdBarrier b; b.bar = bar; b.x = xb_xcc_id(); b.st = st;
    if (threadIdx.x == 0) (void)xb_add(&bar[XB_XCNT(b.x)], 1u);
    return b;
}
__device__ __forceinline__ void xcd_barrier_complete(unsigned* bar, unsigned x, unsigned& nloc, unsigned& nx) {
    const unsigned G = gridDim.x * gridDim.y * gridDim.z;
    unsigned sum, cnt, mine, sp = 0u;
    for (;;) {
        sum = 0u; cnt = 0u; mine = 0u;
#pragma unroll
        for (unsigned j = 0; j < 16; ++j) { const unsigned c = xb_ld(&bar[XB_XCNT(j)]); sum += c; cnt += (c > 0u) ? 1u : 0u; mine = (j == x) ? c : mine; }
        if (sum == G) break;
        __builtin_amdgcn_s_sleep(1);
        if ((++sp & 255u) == 0u) { if (xb_ld(&bar[XB_TMO])) break; if (sp > XB_SPIN_CAP) { atomicAdd(&bar[XB_TMO], 1u); break; } }
    }
    nloc = mine > 0u ? mine : 1u; nx = cnt > 0u ? cnt : 1u;
}
__device__ __forceinline__ void xcd_barrier(const XcdBarrier& b) {
    asm volatile("s_waitcnt vmcnt(0)" ::: "memory");
    __syncthreads();
    if (threadIdx.x == 0) {
        unsigned* bar = b.bar;
        __builtin_amdgcn_s_waitcnt(0);
        unsigned nloc = b.st[0], nx = b.st[1];
        if (nloc == 0u) { xcd_barrier_complete(bar, b.x, nloc, nx); b.st[0] = nloc; b.st[1] = nx; }
        const unsigned old = xb_add(&bar[XB_XSUB(b.x)], 1u);
        const unsigned gen = old / nloc;
        if (old + 1u == (gen + 1u) * nloc) {
            __builtin_amdgcn_fence(__ATOMIC_RELEASE, "agent");
            asm volatile("s_waitcnt vmcnt(0)" ::: "memory");
            const unsigned og = xb_add(&bar[XB_TOP], 1u);
            const unsigned tg = og / nx;
            if (og + 1u == (tg + 1u) * nx) xb_add(&bar[XB_TOPGEN], 1u);
            else XB_SPIN(xb_ld(&bar[XB_TOPGEN]) == tg, bar);
            __builtin_amdgcn_fence(__ATOMIC_ACQUIRE, "agent");
            xb_add(&bar[XB_XGEN(b.x)], 1u);
            asm volatile("s_waitcnt vmcnt(0)" ::: "memory");
        } else {
            XB_SPIN(xb_ld(&bar[XB_XGEN(b.x)]) == gen, bar);
            __builtin_amdgcn_fence(__ATOMIC_ACQUIRE, "agent");
            asm volatile("s_waitcnt vmcnt(0)" ::: "memory");
        }
    }
    __syncthreads();
}

constexpr int P_OFF = MISC_OFF + 128;
static_assert(P_OFF + 50 * 4 <= LDS_BYTES, "P copy inside the LDS control area");
__device__ __forceinline__ unsigned long long lds_u64_uniform(const volatile LAS unsigned long long* s, int i) {
    const unsigned long long v = s[i];
    return ((unsigned long long)(unsigned)__builtin_amdgcn_readfirstlane((int)(unsigned)(v >> 32)) << 32) | (unsigned long long)(unsigned)__builtin_amdgcn_readfirstlane((int)(unsigned)v);
}
__device__ __forceinline__ P load_P(LAS unsigned char* lds) {
    const volatile LAS unsigned long long* s = (const volatile LAS unsigned long long*)(lds + P_OFF);
    P q;
    q.x = (const float*)(const GAS float*)lds_u64_uniform(s, 0); q.meta = (const float*)(const GAS float*)lds_u64_uniform(s, 1); q.g1 = (const float*)(const GAS float*)lds_u64_uniform(s, 2); q.w_in = (const float*)(const GAS float*)lds_u64_uniform(s, 3);
    q.b_f = (const float*)(const GAS float*)lds_u64_uniform(s, 4); q.w2 = (const float*)(const GAS float*)lds_u64_uniform(s, 5); q.bg = (const float*)(const GAS float*)lds_u64_uniform(s, 6); q.gla_g = (const float*)(const GAS float*)lds_u64_uniform(s, 7);
    q.fox_g = (const float*)(const GAS float*)lds_u64_uniform(s, 8); q.w_out = (const float*)(const GAS float*)lds_u64_uniform(s, 9); q.g2 = (const float*)(const GAS float*)lds_u64_uniform(s, 10); q.w_rg = (const float*)(const GAS float*)lds_u64_uniform(s, 11);
    q.b_rg = (const float*)(const GAS float*)lds_u64_uniform(s, 12); q.w_re = (const float*)(const GAS float*)lds_u64_uniform(s, 13); q.b_re = (const float*)(const GAS float*)lds_u64_uniform(s, 14); q.wg = (const float*)(const GAS float*)lds_u64_uniform(s, 15);
    q.wu = (const float*)(const GAS float*)lds_u64_uniform(s, 16); q.wd = (const float*)(const GAS float*)lds_u64_uniform(s, 17); q.gf = (const float*)(const GAS float*)lds_u64_uniform(s, 18); q.out = (float*)(GAS float*)lds_u64_uniform(s, 19);
    q.ws = (unsigned char*)(GAS unsigned char*)lds_u64_uniform(s, 20);
    return q;
}
__global__ void __launch_bounds__(512, 2) k_mega(P p) {
    extern __shared__ __attribute__((aligned(16))) unsigned char lds_raw[];
    LAS unsigned char* lds = (LAS unsigned char*)lds_raw;
    for (int u = threadIdx.x; u < (LDS_BYTES - LDSCTL_OFF) / 4; u += 512) ((LAS unsigned*)(lds + LDSCTL_OFF))[u] = 0u;
    __syncthreads();
    if (threadIdx.x == 0) { LAS unsigned long long* s = (LAS unsigned long long*)(lds + P_OFF);
        s[0] = (unsigned long long)p.x; s[1] = (unsigned long long)p.meta; s[2] = (unsigned long long)p.g1; s[3] = (unsigned long long)p.w_in; s[4] = (unsigned long long)p.b_f;
        s[5] = (unsigned long long)p.w2; s[6] = (unsigned long long)p.bg; s[7] = (unsigned long long)p.gla_g; s[8] = (unsigned long long)p.fox_g; s[9] = (unsigned long long)p.w_out;
        s[10] = (unsigned long long)p.g2; s[11] = (unsigned long long)p.w_rg; s[12] = (unsigned long long)p.b_rg; s[13] = (unsigned long long)p.w_re; s[14] = (unsigned long long)p.b_re;
        s[15] = (unsigned long long)p.wg; s[16] = (unsigned long long)p.wu; s[17] = (unsigned long long)p.wd; s[18] = (unsigned long long)p.gf; s[19] = (unsigned long long)p.out;
        s[20] = (unsigned long long)p.ws; }
    if (threadIdx.x == 0) ((LAS int*)(lds + P_OFF))[48] = (int)gridDim.x;
    (void)xcd_barrier_post((unsigned*)(p.ws + OFF_CTL) + CW_BAR, (volatile LAS unsigned*)(lds + MISC_OFF) + 8);
    __syncthreads();
#define LOAD_G() __builtin_amdgcn_readfirstlane(((const volatile LAS int*)(lds + P_OFF))[48])
#define BARRIER() do { XcdBarrier b_; b_.bar = (unsigned*)((unsigned char*)(GAS unsigned char*)lds_u64_uniform((const volatile LAS unsigned long long*)(lds + P_OFF), 20) + OFF_CTL) + CW_BAR; b_.x = xb_xcc_id(); \
        b_.st = (volatile LAS unsigned*)(lds + MISC_OFF) + 8; xcd_barrier(b_); } while (0)
#define DUPVAL() ((int)__builtin_amdgcn_readfirstlane(((const volatile unsigned*)((unsigned char*)(GAS unsigned char*)lds_u64_uniform((const volatile LAS unsigned long long*)(lds + P_OFF), 20) + OFF_CTL))[64]))
#define RUN(k, body) do { { const P q = load_P(lds); const int G = LOAD_G(), bid = blockIdx.x; body; } BARRIER(); \
        if (DUP_PHASE < 0 || DUP_PHASE == (k)) { if (DUP_PHASE == (k) || DUPVAL() == (k)) { { const P q = load_P(lds); const int G = LOAD_G(), bid = blockIdx.x; body; } BARRIER(); } } } while (0)
    RUN(1, phase_prep(q, lds, bid, G));
    RUN(2, phase_inproj(q, lds, G, bid));
    RUN(3, { phase_cscan(q, lds_raw, G, bid); phase_norms(q, lds_raw, G, bid); phase_gla_p1(q, lds_raw, G, bid); });
    RUN(5, { phase_gla_scan(q, G, bid); phase_fox(q, lds_raw, G, bid); });
    RUN(9, phase_gla_p3(q, lds_raw, G, bid));
    RUN(6, phase_outproj(q, lds, G, bid));
    RUN(100, phase_router(q, lds_raw, G, bid));
    RUN(7, phase_moe<0>(q, lds, G, bid));
    RUN(8, phase_moe<1>(q, lds, G, bid));
    RUN(10, phase_moe<2>(q, lds, G, bid));
#undef RUN
    { const P q = load_P(lds); const int G = LOAD_G(), bid = blockIdx.x; phase_final(q, G, bid); }
}

extern "C" void kernel_launch(void* const* d_in, const int* in_sizes, int n_in, void* d_out, int out_size, void* d_ws, size_t ws_size, hipStream_t stream) {
    static int grid = 0;
    if (grid == 0) {
        if (n_in != 19 || ws_size < WS_END2) { fprintf(stderr, "kernel_launch: bad args n_in=%d ws=%zu need %zu\n", n_in, ws_size, (size_t)WS_END2); grid = -1; return; }
        int dev = 0, cus = 0, per_cu = 0;
        if (hipGetDevice(&dev) != hipSuccess || hipDeviceGetAttribute(&cus, hipDeviceAttributeMultiprocessorCount, dev) != hipSuccess || cus <= 0) { fprintf(stderr, "kernel_launch: device query failed\n"); grid = -1; return; }
        if (hipFuncSetAttribute((const void*)k_mega, hipFuncAttributeMaxDynamicSharedMemorySize, LDS_BYTES) != hipSuccess) { fprintf(stderr, "kernel_launch: hipFuncSetAttribute failed\n"); grid = -1; return; }
        if (hipOccupancyMaxActiveBlocksPerMultiprocessor(&per_cu, (const void*)k_mega, 512, LDS_BYTES) != hipSuccess || per_cu < 1) { fprintf(stderr, "kernel_launch: occupancy query says %d blocks per CU\n", per_cu); (void)hipGetLastError(); grid = -1; return; }
        grid = cus;
    }
    if (grid < 0) return;
    P p{};
    p.x = (const float*)d_in[0]; p.meta = (const float*)d_in[1]; p.g1 = (const float*)d_in[2]; p.w_in = (const float*)d_in[3]; p.b_f = (const float*)d_in[4];
    p.w2 = (const float*)d_in[5]; p.bg = (const float*)d_in[6]; p.gla_g = (const float*)d_in[7]; p.fox_g = (const float*)d_in[8]; p.w_out = (const float*)d_in[9];
    p.g2 = (const float*)d_in[10]; p.w_rg = (const float*)d_in[11]; p.b_rg = (const float*)d_in[12]; p.w_re = (const float*)d_in[13]; p.b_re = (const float*)d_in[14];
    p.wg = (const float*)d_in[15]; p.wu = (const float*)d_in[16]; p.wd = (const float*)d_in[17]; p.gf = (const float*)d_in[18];
    p.out = (float*)d_out; p.ws = (unsigned char*)d_ws;
    (void)hipMemsetAsync((char*)d_ws + OFF_CTL, 0, CTL_ZERO_BYTES, stream);
    if (DUP_PHASE < 0) (void)hipMemsetAsync((char*)d_ws + OFF_CTL + 256, -DUP_PHASE - 1, 1, stream);
    hipLaunchKernelGGL(k_mega, dim3(grid), dim3(512), LDS_BYTES, stream, p);
}
```

```cpp
#include <hip/hip_runtime.h>
#include <stdint.h>
#include <cstdio>
#ifndef FOX_SKIP
#define FOX_SKIP 1
#endif
#ifndef DUP_PHASE
#define DUP_PHASE 0
#endif

typedef unsigned short bf16_t;
#define DM 2048
#define SEQ 8192
#define NMETA 16
#define LR 8256
#define NR_A0 8448
#define NPROJ 6168
#define EPS 1e-6f
#define SCALE128 0.08838834764831845f

__device__ __forceinline__ float bf2f(bf16_t b) { return __uint_as_float(((unsigned)b) << 16); }
__device__ __forceinline__ bf16_t f2bf(float f) { unsigned u = __float_as_uint(f); return (bf16_t)((u + 0x7fffu + ((u >> 16) & 1u)) >> 16); }
__device__ __forceinline__ unsigned pk2(float lo, float hi) { return (unsigned)f2bf(lo) | ((unsigned)f2bf(hi) << 16); }
template <int M> __device__ __forceinline__ float sw_xor(float v) { return __int_as_float(__builtin_amdgcn_ds_swizzle(__float_as_int(v), (M << 10) | 0x1f)); }
__device__ __forceinline__ float x32_sum(float v) { auto r = __builtin_amdgcn_permlane32_swap(__float_as_uint(v), __float_as_uint(v), false, false); return __uint_as_float(r[0]) + __uint_as_float(r[1]); }
__device__ __forceinline__ float x32_max(float v) { auto r = __builtin_amdgcn_permlane32_swap(__float_as_uint(v), __float_as_uint(v), false, false); return fmaxf(__uint_as_float(r[0]), __uint_as_float(r[1])); }
__device__ __forceinline__ float wave_sum(float v) { v += sw_xor<1>(v); v += sw_xor<2>(v); v += sw_xor<4>(v); v += sw_xor<8>(v); v += sw_xor<16>(v); return x32_sum(v); }
__device__ __forceinline__ float wave_max(float v) { v = fmaxf(v, sw_xor<1>(v)); v = fmaxf(v, sw_xor<2>(v)); v = fmaxf(v, sw_xor<4>(v)); v = fmaxf(v, sw_xor<8>(v)); v = fmaxf(v, sw_xor<16>(v)); return x32_max(v); }
__device__ __forceinline__ float shfl_from(float v, int srclane) { return __int_as_float(__builtin_amdgcn_ds_bpermute(srclane << 2, __float_as_int(v))); }
__device__ __forceinline__ int shfl_from_i(int v, int srclane) { return __builtin_amdgcn_ds_bpermute(srclane << 2, v); }
__device__ __forceinline__ float fexp(float x) { return __builtin_amdgcn_exp2f(x * 1.4426950408889634f); }
__device__ __forceinline__ float logsigmoidf(float x) { return fminf(x, 0.f) - 0.6931471805599453f * __builtin_amdgcn_logf(1.f + fexp(-fabsf(x))); }
__device__ __forceinline__ float siluf(float x) { return x * __builtin_amdgcn_rcpf(1.f + fexp(-x)); }

constexpr size_t MiB = 1u << 20;
constexpr size_t OFF_CTL = 0;
constexpr size_t OFF_A0 = 1 * MiB;
constexpr size_t OFF_FQ = OFF_A0 + (size_t)NR_A0 * DM * 2;
constexpr size_t OFF_FK = OFF_FQ + (size_t)8 * SEQ * 128 * 2;
constexpr size_t OFF_FV = OFF_FK + (size_t)8 * LR * 128 * 2;
constexpr size_t OFF_FLOG = OFF_FV + (size_t)8 * LR * 128 * 2;
constexpr size_t OFF_CB = OFF_FLOG + (size_t)8 * LR * 4;
constexpr size_t OFF_GQ = OFF_CB + (size_t)8 * LR * 4;
constexpr size_t OFF_GK = OFF_GQ + (size_t)4 * LR * 128 * 2;
constexpr size_t OFF_GV = OFF_GK + (size_t)4 * LR * 128 * 2;
constexpr size_t OFF_GR = OFF_GV + (size_t)4 * LR * 256 * 2;
constexpr size_t OFF_GZ = OFF_GR + (size_t)SEQ * 1024 * 2;
constexpr size_t OFF_GLAO = OFF_GZ + (size_t)LR * 16 * 4;
constexpr size_t OFF_MIX = OFF_GLAO + (size_t)SEQ * 1024 * 4;
constexpr size_t OFF_U2 = OFF_GV;
constexpr size_t OFF_INVMAP = OFF_MIX + (size_t)SEQ * DM * 2;
constexpr size_t OFF_WTS = OFF_INVMAP + (size_t)32 * SEQ * 4;
constexpr size_t OFF_HBUF = OFF_GLAO;
constexpr size_t OFF_Y = OFF_A0;
constexpr size_t WS_END = OFF_WTS + (size_t)SEQ * 2 * 4;
static_assert(OFF_Y + (size_t)2 * SEQ * DM * 2 <= OFF_FV && OFF_HBUF + (size_t)24576 * 512 * 2 <= OFF_MIX && OFF_U2 + (size_t)SEQ * DM * 2 <= OFF_GZ, "overlays");

struct P {
    const float *x, *meta, *g1, *w_in, *b_f, *w2, *bg, *gla_g, *fox_g, *w_out, *g2, *w_rg, *b_rg, *w_re, *b_re, *wg, *wu, *wd, *gf;
    float* out; unsigned char* ws;
};

#define LAS __attribute__((address_space(3)))
#define GAS __attribute__((address_space(1)))
typedef short bf16x8 __attribute__((ext_vector_type(8)));
typedef short v4i16_t __attribute__((ext_vector_type(4)));
typedef float f32x4 __attribute__((ext_vector_type(4)));
typedef float f32x2 __attribute__((ext_vector_type(2)));
typedef unsigned u32x4 __attribute__((ext_vector_type(4)));
typedef unsigned u32x2 __attribute__((ext_vector_type(2)));
typedef __bf16 bf16x2_t __attribute__((ext_vector_type(2)));
template <class T> __device__ __forceinline__ T nt_load(const T* p) { return __builtin_nontemporal_load(p); }
template <class T> __device__ __forceinline__ void nt_store(T v, T* p) { __builtin_nontemporal_store(v, p); }
__device__ __forceinline__ unsigned cvtpk(float lo, float hi) { f32x2 v = {lo, hi}; bf16x2_t b = __builtin_convertvector(v, bf16x2_t); return __builtin_bit_cast(unsigned, b); }
constexpr int NWAVES = 8;
constexpr int RING_BYTES = 131072, LDSCTL_OFF = RING_BYTES, MISC_OFF = LDSCTL_OFF + 320, LDS_BYTES = 147456;

constexpr size_t OFF_WINT = WS_END;
constexpr size_t OFF_WOUTT = OFF_WINT + (size_t)6176 * DM * 2;
constexpr size_t OFF_WG16 = OFF_WOUTT + (size_t)DM * DM * 2;
constexpr size_t OFF_WU16 = OFF_WG16 + (size_t)32 * DM * 512 * 2;
constexpr size_t OFF_WD16 = OFF_WU16 + (size_t)32 * DM * 512 * 2;
constexpr size_t OFF_DT = OFF_WD16;
constexpr size_t OFF_BBUF = OFF_DT + (size_t)32 * DM * 512 * 2;
constexpr size_t WS_END2 = OFF_BBUF + (size_t)128 * 4 * 64 * 128 * 4;

namespace pg8 {
constexpr int BM = 256, BK = 64, HALF = 128, HTB = HALF * BK * 2, STAGE_BYTES = 8 * HTB, NXCD = 8, WGM = 8;
__host__ __device__ __forceinline__ int lds_byte(int r, int c) { const int st = (r >> 4) * 2 + (c >> 5), rr = r & 15, cc = c & 31, ob = rr * 64 + cc * 2; return st * 1024 + (ob ^ (((ob >> 9) & 1) << 5)); }
__host__ __device__ __forceinline__ void stage_rc(int b, int& R, int& C) { const int st = b / 1024, sb = b % 1024, swz = sb ^ (((sb >> 9) & 1) << 5); R = (st >> 1) * 16 + swz / 64; C = (st & 1) * 32 + (swz % 64) / 2; }
__host__ __device__ __forceinline__ int perm32(int rho) { const int n = rho >> 4, i = rho & 15; return 8 * (i >> 2) + 4 * n + (i & 3); }

struct Unit { int pm, pn; const char* A; const char* B; int e, rt, ce, hoff, nv; unsigned ldb, bhs; };

struct DenseSched {
    int nM, nN, nwg, G, c, K; const char* A; const char* Bt;
    __device__ void init(int M, int N, int K_, int G_, int c_, const void* A_, const void* Bt_) { nM = M / BM; nN = N / BM; nwg = nM * nN; G = G_; c = c_; K = K_; A = (const char*)A_; Bt = (const char*)Bt_; }
    __device__ bool next(int i, Unit& u) const {
        const long L = (long)i * G + c; if (L >= nwg) return false;
        int wgid = (int)L; { const int q = nwg / NXCD, r = nwg % NXCD, xcd = wgid % NXCD, off = wgid / NXCD; wgid = (xcd < r ? xcd * (q + 1) : r * (q + 1) + (xcd - r) * q) + off; }
        const int nig = WGM * nN, gid = wgid / nig, fm = gid * WGM, gsz = (nM - fm) < WGM ? (nM - fm) : WGM;
        u.pm = fm + ((wgid % nig) % gsz); u.pn = (wgid % nig) / gsz;
        u.A = A + (size_t)u.pm * BM * K * 2; u.B = Bt + (size_t)u.pn * BM * K * 2; u.e = 0; u.rt = 0; u.ce = 0; u.hoff = 0; u.nv = BM; u.ldb = 0; u.bhs = 0; return true;
    }
    __device__ __forceinline__ unsigned arow_off(const Unit&, int R) const { return (unsigned)(R * K * 2); }
};
struct OneUnitSched {
    Unit u; const int* idx; int shift; unsigned rowbytes; int rowadd;
    __device__ bool next(int i, Unit& o) const { if (i != 0) return false; o = u; return true; }
    __device__ __forceinline__ unsigned arow_off(const Unit& uu, int R) const {
        const int pos = uu.rt * BM + R; int row = 0;
        if (pos < uu.ce) row = idx ? (idx[pos] >> shift) : pos;
        return (unsigned)(row + rowadd) * rowbytes;
    }
};

template <class Epi, class Sched, bool ALIGN_EPI, bool SP2, bool ROWSKIP = false, bool BNAT = false>
__device__ __forceinline__ void gemm_phase(LAS unsigned char* lds, const int K, const Sched& S, const Epi& E) {
    int tid = threadIdx.x; asm volatile("" : "+v"(tid));
    const int wid = __builtin_amdgcn_readfirstlane(tid >> 6), lane = tid & 63, wr = wid >> 2, wc = wid & 3, fr = lane & 15, fq = lane >> 4;
    const int nt = K / BK;
    Unit cur, nxt; int ui = 0;
    if (!S.next(0, cur)) return;
    unsigned voffA[2][2], voffB[2];
#pragma unroll
    for (int i = 0; i < 2; ++i) { int R, C; stage_rc(tid * 16 + i * 8192, R, C); const int Rb = Epi::PERM ? ((R & ~31) + perm32(R & 31)) : R;
        voffA[0][i] = S.arow_off(cur, R) + (unsigned)(C * 2); voffA[1][i] = S.arow_off(cur, HALF + R) + (unsigned)(C * 2); voffB[i] = (unsigned)(Rb * K + C) * 2u;
        if constexpr (BNAT) {
            const int b_ = tid * 16 + i * 8192, k_ = b_ >> 8, p_ = (b_ >> 4) & 15;
            voffB[i] = (unsigned)k_ * cur.ldb + (unsigned)((p_ ^ ((k_ & 3) << 2)) * 16); } }
    const size_t kstep = (size_t)(BK * 2);
    const size_t hstep = (size_t)HALF * K * 2;
    const size_t kstepB = BNAT ? (size_t)BK * cur.ldb : kstep, hstepB = BNAT ? (size_t)cur.bhs : hstep;
    const int boffT = (8 * fq + ((lane >> 2) & 3)) * 256 + ((4 * (wc ^ ((lane >> 2) & 3)) + (lane & 3)) << 4);
    const unsigned ldsw = (unsigned)wid * 1024u;
    const int aoff = lds_byte(wr * 64 + fr, fq * 8), boff = lds_byte(wc * 32 + fr, fq * 8);
#define PG8_SA(b, h) (((b) * 2 + (h)) * HTB)
#define PG8_SB(b, h) ((4 + (b) * 2 + (h)) * HTB)
#define PG8_STAGE(bufoff, gbase, voff) do { _Pragma("unroll") for (int _i = 0; _i < 2; ++_i) \
        __builtin_amdgcn_global_load_lds((const unsigned*)((const char*)(gbase) + (voff)[_i]), (LAS unsigned*)(lds + (bufoff) + ldsw + _i * 8192), 16, 0, 0); } while (0)
#define PG8_LDA(dst, b, h) do { _Pragma("unroll") for (int m = 0; m < 4; ++m) _Pragma("unroll") for (int k = 0; k < 2; ++k) dst[m][k] = *(const LAS bf16x8*)(lds + PG8_SA(b, h) + aoff + m * 2048 + k * 1024); } while (0)
#define PG8_TR(off_) __builtin_amdgcn_ds_read_tr16_b64_v4i16((LAS v4i16_t*)(lds + (off_)))
#define PG8_LDB(dst, b, h) do { _Pragma("unroll") for (int n = 0; n < 2; ++n) _Pragma("unroll") for (int k = 0; k < 2; ++k) { \
        if constexpr (BNAT) { const v4i16_t lo_ = PG8_TR(PG8_SB(b, h) + boffT + k * 8192 + n * 8), hi_ = PG8_TR(PG8_SB(b, h) + boffT + k * 8192 + 1024 + n * 8); \
                              dst[n][k] = (bf16x8){lo_[0], lo_[1], lo_[2], lo_[3], hi_[0], hi_[1], hi_[2], hi_[3]}; } \
        else dst[n][k] = *(const LAS bf16x8*)(lds + PG8_SB(b, h) + boff + n * 2048 + k * 1024); } } while (0)
#define PG8_MMA(ai, bj, At, Bt) do { __builtin_amdgcn_s_setprio(1); _Pragma("unroll") for (int m = 0; m < 4; ++m) { if (!ROWSKIP || m < mm[ai]) { _Pragma("unroll") for (int n = 0; n < 2; ++n) _Pragma("unroll") for (int k = 0; k < 2; ++k) \
        acc[ai][bj][m][n] = __builtin_amdgcn_mfma_f32_16x16x32_bf16(Bt[n][k], At[m][k], acc[ai][bj][m][n], 0, 0, 0); } } __builtin_amdgcn_s_setprio(0); } while (0)
#define PG8_WAIT_V(n) asm volatile("s_waitcnt vmcnt(" #n ")" ::: "memory")
#define PG8_WAIT_L(n) asm volatile("s_waitcnt lgkmcnt(" #n ")" ::: "memory")
#define PG8_BAR __builtin_amdgcn_s_barrier()
#define PG8_SCHED __builtin_amdgcn_sched_barrier(0)
    f32x4 acc[2][2][4][2];
#pragma unroll
    for (int a = 0; a < 2; ++a)
#pragma unroll
        for (int b = 0; b < 2; ++b)
#pragma unroll
            for (int m = 0; m < 4; ++m)
#pragma unroll
                for (int n = 0; n < 2; ++n) acc[a][b][m][n] = (f32x4){0.f, 0.f, 0.f, 0.f};
    bf16x8 At[4][2], B0[2][2], B1[2][2];
    const char* cA = cur.A; const char* cB = cur.B;
    int mm[2];
#define PG8_SETMM(u_) do { _Pragma("unroll") for (int a_ = 0; a_ < 2; ++a_) { int v_ = ((u_).nv - a_ * HALF - wr * 64 + 15) >> 4; mm[a_] = v_ < 0 ? 0 : (v_ > 4 ? 4 : v_); } } while (0)
    PG8_SETMM(cur);
    if constexpr (SP2) {
        PG8_STAGE(PG8_SB(0, 0), cB, voffB); PG8_STAGE(PG8_SB(0, 1), cB + hstepB, voffB); PG8_STAGE(PG8_SA(0, 0), cA, voffA[0]); PG8_STAGE(PG8_SA(0, 1), cA, voffA[1]);
        if (wr == 1) PG8_BAR;
        PG8_WAIT_V(2); PG8_BAR;
        PG8_STAGE(PG8_SB(1, 0), cB + kstepB, voffB); PG8_STAGE(PG8_SA(1, 0), cA + kstep, voffA[0]); PG8_STAGE(PG8_SB(1, 1), cB + hstepB + kstepB, voffB);
        PG8_WAIT_V(6); PG8_BAR;
    } else {
        PG8_STAGE(PG8_SB(0, 0), cB, voffB); PG8_STAGE(PG8_SA(0, 0), cA, voffA[0]); PG8_STAGE(PG8_SB(0, 1), cB + hstepB, voffB); PG8_STAGE(PG8_SA(0, 1), cA, voffA[1]);
        if (wr == 1) PG8_BAR;
        PG8_WAIT_V(4); PG8_BAR;
        PG8_STAGE(PG8_SB(1, 0), cB + kstepB, voffB); PG8_STAGE(PG8_SA(1, 0), cA + kstep, voffA[0]); PG8_STAGE(PG8_SB(1, 1), cB + hstepB + kstepB, voffB);
        PG8_WAIT_V(6); PG8_BAR;
    }
    for (;;) {
        const bool has_next = S.next(ui + 1, nxt);
        const char* nA = has_next ? nxt.A : cA; const char* nB = has_next ? nxt.B : cB;
        for (int t = 0; t < nt; t += 2) {
            const bool last = (t == nt - 2);
            const char* a1 = cA + (size_t)(t + 1) * kstep;
            const char* a2 = last ? nA : cA + (size_t)(t + 2) * kstep; const char* b2 = last ? nB : cB + (size_t)(t + 2) * kstepB;
            const char* a3 = a2 + kstep; const char* b3 = b2 + kstepB;
            if constexpr (SP2) {
            PG8_LDB(B0, 0, 0); PG8_LDB(B1, 0, 1); PG8_SCHED; PG8_LDA(At, 0, 0); PG8_STAGE(PG8_SA(1, 1), a1, voffA[1]);
            PG8_WAIT_V(8); PG8_WAIT_L(0); PG8_BAR; PG8_MMA(0, 0, At, B0); PG8_MMA(0, 1, At, B1); PG8_BAR; PG8_SCHED;
            PG8_LDA(At, 0, 1); PG8_STAGE(PG8_SB(0, 0), b2, voffB); PG8_STAGE(PG8_SB(0, 1), b2 + hstepB, voffB); PG8_STAGE(PG8_SA(0, 0), a2, voffA[0]);
            PG8_WAIT_V(8); PG8_WAIT_L(0); PG8_BAR; PG8_MMA(1, 0, At, B0); PG8_MMA(1, 1, At, B1); PG8_BAR; PG8_SCHED;
            PG8_LDB(B0, 1, 0); PG8_LDB(B1, 1, 1); PG8_SCHED; PG8_LDA(At, 1, 0); PG8_STAGE(PG8_SA(0, 1), a2, voffA[1]);
            PG8_WAIT_V(8); PG8_WAIT_L(0); PG8_BAR; PG8_MMA(0, 0, At, B0); PG8_MMA(0, 1, At, B1); PG8_BAR; PG8_SCHED;
            PG8_LDA(At, 1, 1); PG8_STAGE(PG8_SB(1, 0), b3, voffB); PG8_STAGE(PG8_SB(1, 1), b3 + hstepB, voffB); PG8_STAGE(PG8_SA(1, 0), a3, voffA[0]);
            PG8_WAIT_V(8); PG8_WAIT_L(0); PG8_BAR; PG8_MMA(1, 0, At, B0); PG8_MMA(1, 1, At, B1); PG8_BAR; PG8_SCHED;
            } else {
            PG8_LDB(B0, 0, 0); PG8_SCHED; PG8_LDA(At, 0, 0); PG8_STAGE(PG8_SA(1, 1), a1, voffA[1]);
            PG8_WAIT_L(8); PG8_BAR; PG8_WAIT_L(0); PG8_MMA(0, 0, At, B0); PG8_BAR; PG8_SCHED;
            PG8_LDB(B1, 0, 1); PG8_STAGE(PG8_SB(0, 0), b2, voffB);
            PG8_BAR; PG8_WAIT_L(0); PG8_MMA(0, 1, At, B1); PG8_BAR;
            PG8_LDA(At, 0, 1); PG8_STAGE(PG8_SA(0, 0), a2, voffA[0]);
            PG8_BAR; PG8_WAIT_L(0); PG8_MMA(1, 0, At, B0); PG8_BAR; PG8_SCHED;
            PG8_STAGE(PG8_SB(0, 1), b2 + hstepB, voffB);
            PG8_WAIT_V(6); PG8_BAR; PG8_MMA(1, 1, At, B1); PG8_BAR;
            PG8_LDB(B0, 1, 0); PG8_SCHED; PG8_LDA(At, 1, 0); PG8_STAGE(PG8_SA(0, 1), a2, voffA[1]);
            PG8_WAIT_L(8); PG8_BAR; PG8_WAIT_L(0); PG8_MMA(0, 0, At, B0); PG8_BAR; PG8_SCHED;
            PG8_LDB(B1, 1, 1); PG8_STAGE(PG8_SB(1, 0), b3, voffB);
            PG8_BAR; PG8_WAIT_L(0); PG8_MMA(0, 1, At, B1); PG8_BAR;
            PG8_LDA(At, 1, 1); PG8_STAGE(PG8_SA(1, 0), a3, voffA[0]);
            PG8_BAR; PG8_WAIT_L(0); PG8_MMA(1, 0, At, B0); PG8_BAR; PG8_SCHED;
            PG8_STAGE(PG8_SB(1, 1), b3 + hstepB, voffB);
            PG8_WAIT_V(6); PG8_BAR; PG8_MMA(1, 1, At, B1); PG8_BAR;
            }
        }
        if constexpr (ALIGN_EPI) { if (wr == 0) PG8_BAR; }
        E(acc, cur, wr, wc, fr, fq);
        if (!has_next) break;
#pragma unroll
        for (int a = 0; a < 2; ++a)
#pragma unroll
            for (int b = 0; b < 2; ++b)
#pragma unroll
                for (int m = 0; m < 4; ++m)
#pragma unroll
                    for (int n = 0; n < 2; ++n) acc[a][b][m][n] = (f32x4){0.f, 0.f, 0.f, 0.f};
        cur = nxt; cA = nA; cB = nB; ++ui; PG8_SETMM(cur);
        if constexpr (ALIGN_EPI) { if (wr == 1) PG8_BAR; }
    }
    PG8_WAIT_V(0);
    if constexpr (!ALIGN_EPI) { if (wr == 0) PG8_BAR; }
    PG8_BAR;
#undef PG8_SETMM
#undef PG8_SA
#undef PG8_SB
#undef PG8_STAGE
#undef PG8_LDA
#undef PG8_LDB
#undef PG8_TR
#undef PG8_MMA
#undef PG8_WAIT_V
#undef PG8_WAIT_L
#undef PG8_BAR
#undef PG8_SCHED
}
}

__device__ __forceinline__ void inproj_dest(int t, size_t& off, int& stride, bool& xonly) {
    xonly = false;
    if (t < 8) { off = OFF_FQ + (size_t)t * SEQ * 256; stride = 128; xonly = true; }
    else if (t < 16) { off = OFF_FK + (size_t)(t - 8) * LR * 256; stride = 128; }
    else if (t < 24) { off = OFF_FV + (size_t)(t - 16) * LR * 256; stride = 128; }
    else if (t < 28) { off = OFF_GQ + (size_t)(t - 24) * LR * 256; stride = 128; }
    else if (t < 32) { off = OFF_GK + (size_t)(t - 28) * LR * 256; stride = 128; }
    else if (t < 40) { off = OFF_GV + (size_t)((t - 32) >> 1) * LR * 512 + (size_t)((t & 1) * 256); stride = 256; }
    else { off = OFF_GR + (size_t)(t - 40) * 256; stride = 1024; xonly = true; }
}
struct EpiInproj {
    static constexpr bool PERM = true;
    unsigned char* ws;
    __device__ __forceinline__ void operator()(const f32x4 (&acc)[2][2][4][2], const pg8::Unit& u, int wr, int wc, int fr, int fq) const {
        const int rbase = u.pm * 256 + wr * 64 + fr;
#pragma unroll
        for (int bj = 0; bj < 2; ++bj) {
            size_t off; int stride; bool xonly;
            inproj_dest(u.pn * 2 + bj, off, stride, xonly);
            bf16_t* base = (bf16_t*)(ws + off) + wc * 32 + 8 * fq + (size_t)(xonly ? 0 : 64) * stride;
#pragma unroll
            for (int ai = 0; ai < 2; ++ai)
#pragma unroll
                for (int m = 0; m < 4; ++m) {
                    const int prow = rbase + ai * 128 + m * 16;
                    const f32x4 v0 = acc[ai][bj][m][0], v1 = acc[ai][bj][m][1];
                    u32x4 w; w.x = cvtpk(v0[0], v0[1]); w.y = cvtpk(v0[2], v0[3]); w.z = cvtpk(v1[0], v1[1]); w.w = cvtpk(v1[2], v1[3]);
                    *(u32x4*)(base + (size_t)prow * stride) = w;
                }
        }
    }
};
struct EpiOutproj {
    static constexpr bool PERM = false;
    const float* x; float* out;
    __device__ __forceinline__ void operator()(const f32x4 (&acc)[2][2][4][2], const pg8::Unit& u, int wr, int wc, int fr, int fq) const {
        const int col0 = u.pn * 256 + wc * 32 + 4 * fq;
#pragma unroll
        for (int ai = 0; ai < 2; ++ai)
#pragma unroll
            for (int m = 0; m < 4; ++m) {
                const size_t off = (size_t)(u.pm * 256 + ai * 128 + wr * 64 + m * 16 + fr) * DM + col0;
#pragma unroll
                for (int bj = 0; bj < 2; ++bj)
#pragma unroll
                    for (int n = 0; n < 2; ++n) { const f32x4 xv = nt_load((const f32x4*)(x + off + bj * 128 + n * 16)); *(f32x4*)(out + off + bj * 128 + n * 16) = xv + acc[ai][bj][m][n]; }
            }
    }
};
struct EpiGateUp {
    static constexpr bool PERM = true;
    bf16_t* HB;
    __device__ __forceinline__ void operator()(const f32x4 (&acc)[2][2][4][2], const pg8::Unit& u, int wr, int wc, int fr, int fq) const {
        const int col = u.pn * 128 + wc * 32 + 8 * fq;
#pragma unroll
        for (int ai = 0; ai < 2; ++ai)
#pragma unroll
            for (int m = 0; m < 4; ++m) {
                const int pos = u.rt * 256 + ai * 128 + wr * 64 + m * 16 + fr;
                if (pos >= u.ce) continue;
                const f32x4 g0 = acc[ai][0][m][0], g1 = acc[ai][0][m][1], u0 = acc[ai][1][m][0], u1 = acc[ai][1][m][1];
                u32x4 w; w.x = cvtpk(siluf(g0[0]) * u0[0], siluf(g0[1]) * u0[1]); w.y = cvtpk(siluf(g0[2]) * u0[2], siluf(g0[3]) * u0[3]);
                w.z = cvtpk(siluf(g1[0]) * u1[0], siluf(g1[1]) * u1[1]); w.w = cvtpk(siluf(g1[2]) * u1[2], siluf(g1[3]) * u1[3]);
                *(u32x4*)(HB + (size_t)(u.hoff + pos) * 512 + col) = w;
            }
    }
};
struct EpiDown {
    static constexpr bool PERM = true;
    bf16_t* Y; const int* invmap; const float* wts;
    __device__ __forceinline__ void operator()(const f32x4 (&acc)[2][2][4][2], const pg8::Unit& u, int wr, int wc, int fr, int fq) const {
        const int col = u.pn * 256 + wc * 32 + 8 * fq;
#pragma unroll
        for (int ai = 0; ai < 2; ++ai)
#pragma unroll
            for (int m = 0; m < 4; ++m) {
                const int pos = u.rt * 256 + ai * 128 + wr * 64 + m * 16 + fr;
                if (pos >= u.ce) continue;
                const int t2 = invmap[(size_t)u.e * SEQ + pos]; const float wt = wts[t2];
                bf16_t* dst = Y + (size_t)(t2 & 1) * SEQ * DM + (size_t)(t2 >> 1) * DM + col;
#pragma unroll
                for (int bj = 0; bj < 2; ++bj) { const f32x4 v0 = acc[ai][bj][m][0] * wt, v1 = acc[ai][bj][m][1] * wt;
                    u32x4 w; w.x = cvtpk(v0[0], v0[1]); w.y = cvtpk(v0[2], v0[3]); w.z = cvtpk(v1[0], v1[1]); w.w = cvtpk(v1[2], v1[3]);
                    *(u32x4*)(dst + bj * 128) = w; }
            }
    }
};

struct TrLoad { f32x4 v[8]; };
template <class ColFn>
__device__ __forceinline__ void tr_issue(TrLoad& t, const float* W, int ldw, ColFn colfn, int k0, int lane) {
    const int kq = lane >> 3, nq = lane & 7, sc = colfn(nq);
#pragma unroll
    for (int i = 0; i < 8; ++i) t.v[i] = sc >= 0 ? nt_load((const f32x4*)(W + (size_t)(k0 + 8 * i + kq) * ldw + sc)) : (f32x4){0.f, 0.f, 0.f, 0.f};
}
__device__ __forceinline__ void tr_finish(const TrLoad& t, bf16_t* WTrow0  , int K, int k0, LAS float* scr, int lane) {
    const int kq = lane >> 3, nq = lane & 7;
#pragma unroll
    for (int i = 0; i < 8; ++i) { LAS float* d = scr + (8 * i + kq) * 33 + 4 * nq; d[0] = t.v[i][0]; d[1] = t.v[i][1]; d[2] = t.v[i][2]; d[3] = t.v[i][3]; }
    asm volatile("s_waitcnt lgkmcnt(0)" ::: "memory");
    const int c = lane & 7;
#pragma unroll
    for (int j = 0; j < 4; ++j) { const int n = (lane >> 3) + 8 * j; const LAS float* s = scr + (8 * c) * 33 + n;
        u32x4 o; o.x = cvtpk(s[0 * 33], s[1 * 33]); o.y = cvtpk(s[2 * 33], s[3 * 33]); o.z = cvtpk(s[4 * 33], s[5 * 33]); o.w = cvtpk(s[6 * 33], s[7 * 33]);
        *(u32x4*)(WTrow0 + (size_t)n * K + k0 + 8 * c) = o; }
    asm volatile("s_waitcnt lgkmcnt(0)" ::: "memory");
}
struct RowLoad { f32x4 v[8]; };
__device__ __forceinline__ void row_issue(RowLoad& r, const P& p, int row, int lane) {
    const float* src = row < SEQ ? p.x + (size_t)row * DM : p.meta + (size_t)(row - SEQ) * DM;
#pragma unroll
    for (int j = 0; j < 8; ++j) r.v[j] = nt_load((const f32x4*)src + lane + 64 * j);
}
__device__ __forceinline__ void row_finish(const RowLoad& r, const P& p, int row, int lane) {
    uint2* dst = (uint2*)((bf16_t*)(p.ws + OFF_A0) + (size_t)row * DM);
    float ss = 0.f;
#pragma unroll
    for (int j = 0; j < 8; ++j) ss += (r.v[j][0] * r.v[j][0] + r.v[j][1] * r.v[j][1]) + (r.v[j][2] * r.v[j][2] + r.v[j][3] * r.v[j][3]);
    ss = wave_sum(ss);
    const float rs = rsqrtf(ss * (1.f / DM) + EPS);
#pragma unroll
    for (int j = 0; j < 8; ++j) {
        const float4 g = ((const float4*)p.g1)[lane + 64 * j];
        dst[lane + 64 * j] = make_uint2(cvtpk(r.v[j][0] * rs * g.x, r.v[j][1] * rs * g.y), cvtpk(r.v[j][2] * rs * g.z, r.v[j][3] * rs * g.w));
    }
}
constexpr size_t EXP_NG4 = (size_t)32 * DM * 512 / 4;
__device__ __forceinline__ void cast_family(const float* src, unsigned char* dstb, size_t gt, size_t NT, size_t lo, size_t hi) {
    const f32x4* s4 = (const f32x4*)src; uint2* d2 = (uint2*)dstb;
#define CST(i_, v_) d2[i_] = make_uint2(cvtpk(v_[0], v_[1]), cvtpk(v_[2], v_[3]))
    size_t i0 = lo + gt;
    for (; i0 + 7 * NT < hi; i0 += 8 * NT) {
        const f32x4 v0 = s4[i0], v1 = s4[i0 + NT], v2 = s4[i0 + 2 * NT], v3 = s4[i0 + 3 * NT], v4 = s4[i0 + 4 * NT], v5 = s4[i0 + 5 * NT], v6 = s4[i0 + 6 * NT], v7 = s4[i0 + 7 * NT];
        CST(i0, v0); CST(i0 + NT, v1); CST(i0 + 2 * NT, v2); CST(i0 + 3 * NT, v3); CST(i0 + 4 * NT, v4); CST(i0 + 5 * NT, v5); CST(i0 + 6 * NT, v6); CST(i0 + 7 * NT, v7);
    }
    for (; i0 < hi; i0 += NT) { const f32x4 v = s4[i0]; CST(i0, v); }
#undef CST
}
__device__ __forceinline__ void phase_prep(const P& p, LAS unsigned char* lds, int vcu, int G) {
    int tid = threadIdx.x; asm volatile("" : "+v"(tid));
    const int lane = tid & 63, wave = __builtin_amdgcn_readfirstlane(tid >> 6);
    LAS float* scr = (LAS float*)(lds + wave * 16384);
    const int gw = vcu * NWAVES + wave, NGW = G * NWAVES;
    { const int gt = vcu * 512 + tid, NT = G * 512;
      bf16_t* FK = (bf16_t*)(p.ws + OFF_FK); bf16_t* FV = (bf16_t*)(p.ws + OFF_FV);
      bf16_t* GQ = (bf16_t*)(p.ws + OFF_GQ); bf16_t* GK = (bf16_t*)(p.ws + OFF_GK); bf16_t* GV = (bf16_t*)(p.ws + OFF_GV);
      float* FLOG = (float*)(p.ws + OFF_FLOG); float* GZ = (float*)(p.ws + OFF_GZ);
      for (int i = gt; i < 8 * 48 * 128; i += NT) { const int h = i / (48 * 128), r = i % (48 * 128); FK[(size_t)h * LR * 128 + r] = 0; FV[(size_t)h * LR * 128 + r] = 0;
          if (h < 4) { GQ[(size_t)h * LR * 128 + r] = 0; GK[(size_t)h * LR * 128 + r] = 0; } }
      for (int i = gt; i < 4 * 48 * 256; i += NT) { const int h = i / (48 * 256), r = i % (48 * 256); GV[(size_t)h * LR * 256 + r] = 0; }
      for (int i = gt; i < 8 * 48; i += NT) FLOG[i] = 0.f;
      for (int i = gt; i < 48 * 16; i += NT) GZ[i] = 0.f; }
    constexpr int I_IN = 193 * 32, I_OUT = 64 * 32, I_ALL = I_IN + I_OUT;
    auto issue = [&](TrLoad& t, int it, bf16_t*& dst, int& K, int& k0) {
        int r = it;
        if (r < I_IN) { const int nb = r % 193, kb = r / 193, n0 = nb * 32; K = DM; k0 = kb * 64; dst = (bf16_t*)(p.ws + OFF_WINT) + (size_t)n0 * DM;
            tr_issue(t, p.w_in, NPROJ, [&](int g) { const int n = n0 + 4 * g; if (n < 3072) return n; if (n < 6144) return n + 8; if (n < 6152) return n - 3072; if (n < 6168) return n; return -1; }, k0, lane); return; }
        r -= I_IN;
        if (r < I_OUT) { const int nb = r & 63, kb = r >> 6, n0 = nb * 32; K = DM; k0 = kb * 64; dst = (bf16_t*)(p.ws + OFF_WOUTT) + (size_t)n0 * DM;
            tr_issue(t, p.w_out, DM, [&](int g) { return n0 + 4 * g; }, k0, lane); return; }
    };
    { int r = gw, it = gw;
      while (r < SEQ + NMETA || it < I_ALL) {
        RowLoad ra, rb; TrLoad ta, tb; bf16_t* da = nullptr; bf16_t* db = nullptr; int Ka = 0, Kb = 0, k0a = 0, k0b = 0;
        const bool hr0 = r < SEQ + NMETA, hr1 = r + NGW < SEQ + NMETA, ht0 = it < I_ALL, ht1 = it + NGW < I_ALL;
        if (hr0) row_issue(ra, p, r, lane);
        if (hr1) row_issue(rb, p, r + NGW, lane);
        if (ht0) issue(ta, it, da, Ka, k0a);
        if (ht1) issue(tb, it + NGW, db, Kb, k0b);
        __builtin_amdgcn_sched_barrier(0);
        if (hr0) row_finish(ra, p, r, lane);
        if (hr1) row_finish(rb, p, r + NGW, lane);
        if (ht0) tr_finish(ta, da, Ka, k0a, scr, lane);
        if (ht1) tr_finish(tb, db, Kb, k0b, scr, lane);
        r += 2 * NGW; it += 2 * NGW;
      } }
}
__device__ __forceinline__ void phase_inproj(const P& p, LAS unsigned char* lds, int G, int bid) {
    { pg8::DenseSched S; S.init(SEQ, 6144, DM, G, bid, p.ws + OFF_A0, p.ws + OFF_WINT);
      EpiInproj E{p.ws};
      pg8::gemm_phase<EpiInproj, pg8::DenseSched, true, true>(lds, DM, S, E); }
    int tid = threadIdx.x; asm volatile("" : "+v"(tid));
    const int lane = tid & 63, w = __builtin_amdgcn_readfirstlane(tid >> 6), r16 = lane & 15, q = lane >> 4;
    LAS float* part = (LAS float*)lds;
    for (int j = bid; j < 192; j += G) {
        const bf16_t* Ap = (const bf16_t*)(p.ws + OFF_A0) + (size_t)(SEQ + r16) * DM + 256 * w + 8 * q;
        const bf16_t* Bp = (const bf16_t*)(p.ws + OFF_WINT) + (size_t)(32 * j + r16) * DM + 256 * w + 8 * q;
        f32x4 acc0 = (f32x4){0.f, 0.f, 0.f, 0.f}, acc1 = acc0;
#pragma unroll
        for (int ks = 0; ks < 8; ++ks) {
            const bf16x8 af = *(const bf16x8*)(Ap + 32 * ks), b0 = *(const bf16x8*)(Bp + 32 * ks), b1 = *(const bf16x8*)(Bp + (size_t)16 * DM + 32 * ks);
            acc0 = __builtin_amdgcn_mfma_f32_16x16x32_bf16(af, b0, acc0, 0, 0, 0);
            acc1 = __builtin_amdgcn_mfma_f32_16x16x32_bf16(af, b1, acc1, 0, 0, 0);
        }
#pragma unroll
        for (int i = 0; i < 4; ++i) { part[((w * 2 + 0) * 16 + 4 * q + i) * 16 + r16] = acc0[i]; part[((w * 2 + 1) * 16 + 4 * q + i) * 16 + r16] = acc1[i]; }
        __syncthreads();
        { const int m = tid >> 5, cl = tid & 31; float sum = 0.f;
#pragma unroll
          for (int ww = 0; ww < 8; ++ww) sum += part[((ww * 2 + (cl >> 4)) * 16 + m) * 16 + (cl & 15)];
          const int c = 32 * j + cl; size_t off; int stride; bool xonly;
          inproj_dest(c >> 7, off, stride, xonly);
          if (!xonly) ((bf16_t*)(p.ws + off))[(size_t)(48 + m) * stride + (c & 127)] = f2bf(sum); }
        __syncthreads();
    }
    for (int i = bid; i < 257; i += G) {
        const bf16_t* Ap = (const bf16_t*)(p.ws + OFF_A0) + (size_t)(32 * i + r16) * DM + 256 * w + 8 * q;
        const bf16_t* Bp = (const bf16_t*)(p.ws + OFF_WINT) + (size_t)(6144 + r16) * DM + 256 * w + 8 * q;
        f32x4 acc[2][2];
#pragma unroll
        for (int a_ = 0; a_ < 2; ++a_)
#pragma unroll
            for (int b_ = 0; b_ < 2; ++b_) acc[a_][b_] = (f32x4){0.f, 0.f, 0.f, 0.f};
#pragma unroll
        for (int ks = 0; ks < 8; ++ks) {
            const bf16x8 a0 = *(const bf16x8*)(Ap + 32 * ks), a1 = *(const bf16x8*)(Ap + (size_t)16 * DM + 32 * ks);
            const bf16x8 b0 = *(const bf16x8*)(Bp + 32 * ks), b1 = *(const bf16x8*)(Bp + (size_t)16 * DM + 32 * ks);
            acc[0][0] = __builtin_amdgcn_mfma_f32_16x16x32_bf16(a0, b0, acc[0][0], 0, 0, 0); acc[0][1] = __builtin_amdgcn_mfma_f32_16x16x32_bf16(a0, b1, acc[0][1], 0, 0, 0);
            acc[1][0] = __builtin_amdgcn_mfma_f32_16x16x32_bf16(a1, b0, acc[1][0], 0, 0, 0); acc[1][1] = __builtin_amdgcn_mfma_f32_16x16x32_bf16(a1, b1, acc[1][1], 0, 0, 0);
        }
#pragma unroll
        for (int a_ = 0; a_ < 2; ++a_)
#pragma unroll
            for (int b_ = 0; b_ < 2; ++b_)
#pragma unroll
                for (int ii = 0; ii < 4; ++ii) part[((w * 4 + a_ * 2 + b_) * 16 + 4 * q + ii) * 16 + r16] = acc[a_][b_][ii];
        __syncthreads();
#pragma unroll
        for (int o = 0; o < 2; ++o) { const int idx = tid + 512 * o, row = idx >> 5, col = idx & 31; float sum = 0.f;
#pragma unroll
            for (int ww = 0; ww < 8; ++ww) sum += part[((ww * 4 + (row >> 4) * 2 + (col >> 4)) * 16 + (row & 15)) * 16 + (col & 15)];
            const int prow = 32 * i + row;
            if (prow < SEQ + NMETA && col < 24) { const int lrow = prow < SEQ ? 64 + prow : 48 + (prow - SEQ);
                if (col < 8) ((float*)(p.ws + OFF_FLOG))[(size_t)lrow * 8 + col] = sum; else ((float*)(p.ws + OFF_GZ))[(size_t)lrow * 16 + (col - 8)] = sum; } }
        __syncthreads();
    }
}
__device__ __forceinline__ void phase_outproj(const P& p, LAS unsigned char* lds, int G, int bid) {
    pg8::DenseSched S; S.init(SEQ, DM, DM, G, bid, p.ws + OFF_MIX, p.ws + OFF_WOUTT);
    EpiOutproj E{p.x, p.out};
    pg8::gemm_phase<EpiOutproj, pg8::DenseSched, true, true>(lds, DM, S, E);
}
constexpr int MOE_PLAN_OFF = LDSCTL_OFF + 1024;
struct MoeLane { int e, ce, nt, nbig, nsm, hoff, ib4, is4, ib8, is8, tb4, ts4, tb8, ts8; };
__device__ __forceinline__ MoeLane moe_lane(const unsigned* cnt, int tid) {
    MoeLane m; m.e = tid & 31;
    m.ce = (int)cnt[m.e]; m.nt = (m.ce + 255) >> 8; const int lastrows = m.ce - (m.nt - 1) * 256;
    m.nbig = (m.nt > 0 && lastrows < 128) ? m.nt - 1 : m.nt; m.nsm = m.nt - m.nbig;
    int pb = m.nbig, ps = m.nsm, ph = m.nt * 256;
#pragma unroll
    for (int o = 1; o < 32; o <<= 1) { const int tb = shfl_from_i(pb, tid - o), ts = shfl_from_i(ps, tid - o), th = shfl_from_i(ph, tid - o); if (m.e >= o) { pb += tb; ps += ts; ph += th; } }
    const int totb = shfl_from_i(pb, 31), tots = shfl_from_i(ps, 31);
    m.hoff = ph - m.nt * 256; m.ib4 = pb * 4; m.is4 = ps * 4; m.ib8 = pb * 8; m.is8 = ps * 8; m.tb4 = totb * 4; m.ts4 = tots * 4; m.tb8 = totb * 8; m.ts8 = tots * 8;
    return m;
}
__device__ __forceinline__ void moe_rec(LAS unsigned char* lds, int k, const MoeLane& m, int tid, int ncol, bool small, int idx, int type) {
    const int incl = small ? (ncol == 4 ? m.is4 : m.is8) : (ncol == 4 ? m.ib4 : m.ib8);
    const int mine = (small ? m.nsm : m.nbig) * ncol, excl = incl - mine;
    const bool hit = idx >= 0 && idx >= excl && idx < incl && tid < 32;
    const unsigned long long bm = __ballot(hit);
    LAS int* rec = (LAS int*)(lds + MOE_PLAN_OFF) + k * 8;
    if (bm == 0ull) { if (tid == 0) rec[0] = -1; }
    else if (hit) { const int loc = idx - excl, rt = (small ? m.nbig : 0) + loc / ncol; rec[0] = m.e; rec[1] = rt; rec[2] = loc % ncol; rec[3] = m.ce; rec[4] = m.hoff;
                    const int nv = m.ce - rt * 256; rec[5] = nv > 256 ? 256 : nv; rec[6] = type; }
}
template <int PHASE> __device__ __forceinline__ void moe_plan(const unsigned* cnt, int G, int c, LAS unsigned char* lds) {
    int tid = threadIdx.x; asm volatile("" : "+v"(tid));
    if (tid < 64) {
        const MoeLane m = moe_lane(cnt, tid);
#pragma unroll 1
        for (int k = 0; k < 8; ++k) {
            if (PHASE == 0) moe_rec(lds, k, m, tid, 4, false, k * G + c, 0);
            else if (PHASE == 2) moe_rec(lds, k, m, tid, 8, true, k * G + c, 1);
            else {
                const int ns = m.ts4;
                if (ns >= G) {
                    const int nsk = (ns - c + G - 1) / G;
                    if (k < nsk) moe_rec(lds, k, m, tid, 4, true, k * G + c, 0); else moe_rec(lds, k, m, tid, 8, false, (k - nsk) * G + c, 1);
                } else if (c < ns) { if (k == 0) moe_rec(lds, k, m, tid, 4, true, c, 0); else if (k == 1) moe_rec(lds, k, m, tid, 8, false, c, 1); else moe_rec(lds, k, m, tid, 8, false, -1, 1); }
                else moe_rec(lds, k, m, tid, 8, false, ns + (c - ns) + k * (G - ns), 1);
            }
        }
    }
    __syncthreads();
}
__device__ __forceinline__ bool moe_unit_rec(LAS unsigned char* lds, int k, pg8::Unit& u, int& type) {
    if (k >= 8) return false;
    const volatile LAS int* rec = (const volatile LAS int*)(lds + MOE_PLAN_OFF) + k * 8;
    const int e = __builtin_amdgcn_readfirstlane(rec[0]);
    if (e < 0) return false;
    u.e = e; u.rt = __builtin_amdgcn_readfirstlane(rec[1]); u.pn = __builtin_amdgcn_readfirstlane(rec[2]); u.pm = 0;
    u.ce = __builtin_amdgcn_readfirstlane(rec[3]); u.hoff = __builtin_amdgcn_readfirstlane(rec[4]); u.nv = __builtin_amdgcn_readfirstlane(rec[5]);
    type = __builtin_amdgcn_readfirstlane(rec[6]);
    return true;
}
struct MoeDownSched {
    LAS unsigned char* lds; const char* HB; const char* DT; int k0;
    __device__ bool next(int i, pg8::Unit& u) const {
        int type; if (!moe_unit_rec(lds, k0 + i, u, type) || type != 1) return false;
        u.A = HB + (size_t)(u.hoff + u.rt * 256) * 1024; u.B = DT + ((size_t)u.e * 512 * DM + u.pn * 256) * 2; u.ldb = 4096u; u.bhs = 256u; return true;
    }
    __device__ __forceinline__ unsigned arow_off(const pg8::Unit&, int R) const { return (unsigned)(R * 1024); }
};
template <int PHASE> __device__ __forceinline__ void phase_moe(const P& p, LAS unsigned char* lds, int G, int bid) {
    moe_plan<PHASE>((const unsigned*)(p.ws + OFF_CTL), G, bid, lds);
    int k = 0;
    if (PHASE != 2) {
        EpiGateUp E{(bf16_t*)(p.ws + OFF_HBUF)};
        for (;; ++k) {
            pg8::OneUnitSched S; int type; if (!moe_unit_rec(lds, k, S.u, type) || type != 0) break;
            S.u.A = (const char*)(p.ws + OFF_U2); S.u.B = (const char*)(p.ws + OFF_WG16) + ((size_t)S.u.e * DM * 512 + S.u.pn * 128) * 2;
            S.u.ldb = 1024u; S.u.bhs = (unsigned)(OFF_WU16 - OFF_WG16);
            S.idx = (const int*)(p.ws + OFF_INVMAP) + (size_t)S.u.e * SEQ; S.shift = 1; S.rowbytes = DM * 2; S.rowadd = 0;
            pg8::gemm_phase<EpiGateUp, pg8::OneUnitSched, true, true, true, true>(lds, DM, S, E);
        }
    }
    if (PHASE != 0) {
        MoeDownSched S{lds, (const char*)(p.ws + OFF_HBUF), (const char*)(p.ws + OFF_WD16), k};
        EpiDown E{(bf16_t*)(p.ws + OFF_Y), (const int*)(p.ws + OFF_INVMAP), (const float*)(p.ws + OFF_WTS)};
        pg8::gemm_phase<EpiDown, MoeDownSched, true, true, true, true>(lds, 512, S, E);
    }
}

#include <hip/hip_bf16.h>
namespace fx {
using bf16 = __hip_bfloat16;
typedef short s16x4 __attribute__((ext_vector_type(4)));
typedef float f32x16 __attribute__((ext_vector_type(16)));
template <class A, class Bt> struct same_t { static constexpr bool v = false; };
template <class A> struct same_t<A, A> { static constexpr bool v = true; };
constexpr int D = 128; constexpr float THR = 8.f; constexpr bool WSKIP = false;
constexpr float SCALE = 0.08838834764831845f;
constexpr int NW = 8, QBLK = 32, KVBLK = 64, QB = NW * QBLK;
constexpr int SHM_V = KVBLK * D * 2, SHM_K = KVBLK * D * 2;
constexpr int FOX_BIAS_OFF = 2 * SHM_V + 2 * SHM_K + NW * 64 * 4;
#define KSWZ(row, colB) ((row) * 256 + ((colB) ^ (((row) & 7) << 4)))
#define SBAR() __builtin_amdgcn_sched_barrier(0)
__device__ __forceinline__ int v_st(int k, int c) { const int kk = (k & ~0xC) | ((k & 4) << 1) | ((k & 8) >> 1); return ((kk >> 3) * 4 + (c >> 5)) * 512 + ((kk & 7) * 32 + (c & 31)) * 2; }
__device__ __forceinline__ int v_rd_base(int lane) { return ((lane & 3) << 3) | (((lane >> 2) & 3) << 6) | (((lane >> 4) & 1) << 5) | (((lane >> 5) & 1) << 8); }
constexpr int v_rd_off(int d0, int ks, int half) { return d0 * 512 + ks * 4096 + half * 2048; }
__device__ __forceinline__ int crow(int r, int hi) { return (r & 3) + 8 * (r >> 2) + 4 * hi; }

__device__ __forceinline__ bf16x8 pack8(f32x4 a, f32x4 b) {
    u32x4 w = {cvtpk(a[0], a[1]), cvtpk(a[2], a[3]), cvtpk(b[0], b[1]), cvtpk(b[2], b[3])};
    return *reinterpret_cast<bf16x8*>(&w);
}
template <class T> __device__ __forceinline__ bf16x8 load8(const T* p) {
    if constexpr (same_t<T, float>::v) { return pack8(*(const f32x4*)p, *(const f32x4*)(p + 4)); }
    else { return *reinterpret_cast<const bf16x8*>(p); }
}
__device__ __forceinline__ void mask_tile(f32x16& p0, f32x16& p1, int dq, unsigned W) {
    const float NEG = -__builtin_inff();
#pragma unroll
    for (int r = 0; r < 16; ++r) {
        const int c = (r & 3) + 8 * (r >> 2);
        if ((unsigned)(dq - c) >= W) p0[r] = NEG;
        if ((unsigned)(dq - c - 32) >= W) p1[r] = NEG;
    }
}
__device__ __forceinline__ void partialSM(f32x16& p0, f32x16& p1, float& m_reg, float& mn, float& alpha) {
    float pmax = p0[0]; for (int r = 1; r < 16; ++r) pmax = fmaxf(pmax, p0[r]); for (int r = 0; r < 16; ++r) pmax = fmaxf(pmax, p1[r]);
    { auto rr = __builtin_amdgcn_permlane32_swap(__float_as_uint(pmax), __float_as_uint(pmax), false, false);
      pmax = fmaxf(__uint_as_float(rr[0]), __uint_as_float(rr[1])); }
    constexpr float C2 = 1.4426950408889634f * SCALE;
    if (__builtin_expect(__all((pmax - m_reg) * SCALE <= THR), 1)) { mn = m_reg; alpha = 1.f; }
    else { mn = fmaxf(m_reg, pmax); alpha = __builtin_amdgcn_exp2f((m_reg - mn) * C2); m_reg = mn; }
    const float mnL = -mn * C2;
    for (int r = 0; r < 16; ++r) p0[r] = fmaf(p0[r], C2, mnL); for (int r = 0; r < 16; ++r) p1[r] = fmaf(p1[r], C2, mnL);
    for (int r = 0; r < 16; ++r) p0[r] = __builtin_amdgcn_exp2f(p0[r]);
}
__device__ __forceinline__ void finishSM(f32x16& p0, f32x16& p1, float alpha, float& l_reg, bf16x8& pa0, bf16x8& pa1, bf16x8& pa2, bf16x8& pa3) {
    for (int r = 0; r < 16; ++r) p1[r] = __builtin_amdgcn_exp2f(p1[r]);
    float ps = 0; for (int r = 0; r < 16; ++r) ps += p0[r]; for (int r = 0; r < 16; ++r) ps += p1[r];
    { auto rr = __builtin_amdgcn_permlane32_swap(__float_as_uint(ps), __float_as_uint(ps), false, false);
      ps = __uint_as_float(rr[0]) + __uint_as_float(rr[1]); }
    l_reg = l_reg * alpha + ps;
#define PK4(P, B_, OUT) do { unsigned a0 = cvtpk(P[B_+0], P[B_+1]), a1 = cvtpk(P[B_+2], P[B_+3]);                          \
        unsigned b0 = cvtpk(P[B_+4], P[B_+5]), b1 = cvtpk(P[B_+6], P[B_+7]);                                             \
        auto r0 = __builtin_amdgcn_permlane32_swap(a0, b0, false, false); auto r1 = __builtin_amdgcn_permlane32_swap(a1, b1, false, false); \
        u32x4 w = {r0[0], r1[0], r0[1], r1[1]}; OUT = *reinterpret_cast<bf16x8*>(&w); } while (0)
    PK4(p0, 0, pa0); PK4(p0, 8, pa1); PK4(p1, 0, pa2); PK4(p1, 8, pa3);
#undef PK4
}
template <int KB, bool SK>
__device__ __forceinline__ void qkt(f32x16& p0, f32x16& p1, const char* K_lds, int r32, int hi, const bf16x8* qr, bool act, const float* bias) {
    if (SK && !act) { const float NEG = -__builtin_inff();
#pragma unroll
        for (int r = 0; r < 16; ++r) { p0[r] = NEG; p1[r] = NEG; } return; }
    { const f32x4* bp = (const f32x4*)(bias + 4 * hi);
#pragma unroll
      for (int g = 0; g < 4; ++g) { const f32x4 a = bp[2 * g], b = bp[8 + 2 * g];
          p0[4 * g] = a[0]; p0[4 * g + 1] = a[1]; p0[4 * g + 2] = a[2]; p0[4 * g + 3] = a[3];
          p1[4 * g] = b[0]; p1[4 * g + 1] = b[1]; p1[4 * g + 2] = b[2]; p1[4 * g + 3] = b[3]; } }
    const char* kb[4];
#pragma unroll
    for (int dd = 0; dd < 4; ++dd) kb[dd] = K_lds + KB * SHM_K + KSWZ(r32, (dd * 16 + hi * 8) * 2);
#pragma unroll
    for (int d0 = 0; d0 < 8; ++d0) { const char* a = kb[d0 & 3] + (d0 >> 2) * 128;
        bf16x8 b0 = *reinterpret_cast<const bf16x8*>(a);
        bf16x8 b1 = *reinterpret_cast<const bf16x8*>(a + 32 * 256);
        p0 = __builtin_amdgcn_mfma_f32_32x32x16_bf16(b0, qr[d0], p0, 0, 0, 0);
        p1 = __builtin_amdgcn_mfma_f32_32x32x16_bf16(b1, qr[d0], p1, 0, 0, 0); }
}
template <int VB, bool SK>
__device__ __forceinline__ void pv_tile(f32x16* o, int vb0, bf16x8 pa0, bf16x8 pa1, bf16x8 pa2, bf16x8 pa3, bool act) {
    if (SK && !act) return;
#define TRRD(dst, off) asm volatile("ds_read_b64_tr_b16 %0, %1 offset:%2" : "=&v"(dst) : "v"(vb0), "i"(off) : "memory")
#define PV_D0(d0) do { s16x4 l0, l1, l2, l3, h0, h1, h2, h3; constexpr int b_ = VB * SHM_V + v_rd_off(d0, 0, 0);     \
        TRRD(l0, b_); TRRD(h0, b_ + 2048); TRRD(l1, b_ + 4096); TRRD(h1, b_ + 6144); TRRD(l2, b_ + 8192); TRRD(h2, b_ + 10240); TRRD(l3, b_ + 12288); TRRD(h3, b_ + 14336); \
        asm volatile("s_waitcnt lgkmcnt(0)" ::: "memory"); SBAR();                 \
        o[d0] = __builtin_amdgcn_mfma_f32_32x32x16_bf16(pa0, (bf16x8){l0[0], l0[1], l0[2], l0[3], h0[0], h0[1], h0[2], h0[3]}, o[d0], 0, 0, 0);   \
        o[d0] = __builtin_amdgcn_mfma_f32_32x32x16_bf16(pa1, (bf16x8){l1[0], l1[1], l1[2], l1[3], h1[0], h1[1], h1[2], h1[3]}, o[d0], 0, 0, 0);   \
        o[d0] = __builtin_amdgcn_mfma_f32_32x32x16_bf16(pa2, (bf16x8){l2[0], l2[1], l2[2], l2[3], h2[0], h2[1], h2[2], h2[3]}, o[d0], 0, 0, 0);   \
        o[d0] = __builtin_amdgcn_mfma_f32_32x32x16_bf16(pa3, (bf16x8){l3[0], l3[1], l3[2], l3[3], h3[0], h3[1], h3[2], h3[3]}, o[d0], 0, 0, 0); } while (0)
    PV_D0(0); PV_D0(1); PV_D0(2); PV_D0(3);
#undef PV_D0
#undef TRRD
}

template <class TIn, class TOut> struct BlockRef { const TIn* Q; const TIn* K; const TIn* V; TOut* O; int P0; const float* bias; const float* g; int jlo; };
template <class TIn> struct Seam {
    bf16x8 qr[8];
    bf16x8 st_v0, st_v1, st_k0, st_k1; f32x4 sf0, sf1, sf2, sf3;
    f32x4 tq[16];
};
__device__ __forceinline__ int swa_jlo(int P0, int W) { const int lowk = P0 - W + 1; return lowk > 0 ? lowk / KVBLK : 0; }
#define ROW(p, k0, rr) ((p) + (size_t)((k0) + (rr)) * D + sc)
#define VMW() asm volatile("s_waitcnt vmcnt(0)" ::: "memory")
#define VMWN(n) asm volatile("s_waitcnt vmcnt(%0)" :: "i"(n) : "memory")
#define SLOAD_H(Kp, Vp, k0) do { S.st_v0 = load8<TIn>(ROW(Vp, k0, sr)); S.st_v1 = load8<TIn>(ROW(Vp, k0, 32 + sr));              \
                         S.st_k0 = load8<TIn>(ROW(Kp, k0, sr)); S.st_k1 = load8<TIn>(ROW(Kp, k0, 32 + sr)); } while (0)
#define SWRITE_HK(bf) do { *(bf16x8*)(K_lds + (bf) * SHM_K + kws) = S.st_k0; *(bf16x8*)(K_lds + (bf) * SHM_K + kws + 32 * 256) = S.st_k1; } while (0)
#define SWRITE_HV(bf) do { *(bf16x8*)(V_lds + (bf) * SHM_V + vst0) = S.st_v0; *(bf16x8*)(V_lds + (bf) * SHM_V + vst1) = S.st_v1; } while (0)
#define SWRITE_H(bf) do { SWRITE_HV(bf); SWRITE_HK(bf); } while (0)
#define SLOAD_F(p, k0) do { S.sf0 = *(const f32x4*)ROW(p, k0, sr); S.sf1 = *(const f32x4*)(ROW(p, k0, sr) + 4);                \
                            S.sf2 = *(const f32x4*)ROW(p, k0, 32 + sr); S.sf3 = *(const f32x4*)(ROW(p, k0, 32 + sr) + 4); } while (0)
#define SWRITE_KF(bf) do { *(bf16x8*)(K_lds + (bf) * SHM_K + kws) = pack8(S.sf0, S.sf1); *(bf16x8*)(K_lds + (bf) * SHM_K + kws + 32 * 256) = pack8(S.sf2, S.sf3); } while (0)
#define SWRITE_VF(bf) do { *(bf16x8*)(V_lds + (bf) * SHM_V + vst0) = pack8(S.sf0, S.sf1); *(bf16x8*)(V_lds + (bf) * SHM_V + vst1) = pack8(S.sf2, S.sf3); } while (0)
template <class TIn, class TOut>
__device__ __forceinline__ void causal_swa_prime(const BlockRef<TIn, TOut>& cur, int W, char* lds, Seam<TIn>& S) {
    constexpr bool F32 = same_t<TIn, float>::v;
    int tid = threadIdx.x; asm volatile("" : "+v"(tid));
    const int wid = __builtin_amdgcn_readfirstlane(tid >> 6), lane = tid & 63, r32 = lane & 31, hi = lane >> 5;
    const int sr = tid >> 4, sc = (tid & 15) * 8, kws = KSWZ(sr, sc * 2); char* K_lds = lds + 2 * SHM_V;
    const int kb0 = cur.jlo * KVBLK;
    for (int d0 = 0; d0 < 8; ++d0) S.qr[d0] = load8<TIn>(cur.Q + (size_t)(wid * QBLK + r32) * D + d0 * 16 + hi * 8);
    if constexpr (F32) { SLOAD_F((const float*)cur.K, kb0); VMW(); SWRITE_KF(0); SBAR(); SLOAD_F((const float*)cur.V, kb0); }
    else { SLOAD_H(cur.K, cur.V, kb0); VMW(); SWRITE_HK(0); }
    __syncthreads();
}
template <class TIn, class TOut>
__device__ __forceinline__ void causal_swa_block(const BlockRef<TIn, TOut>& cur, const BlockRef<TIn, TOut>& nxt, int skv, int W, char* lds, Seam<TIn>& S) {
    constexpr bool F32 = same_t<TIn, float>::v;
    int tid = threadIdx.x; asm volatile("" : "+v"(tid));
    const int wid = __builtin_amdgcn_readfirstlane(tid >> 6), lane = tid & 63, r32 = lane & 31, hi = lane >> 5;
    const int j_lo = cur.jlo;
    int j_hi = (cur.P0 + QB - 1) / KVBLK + 1; if (j_hi > skv / KVBLK) j_hi = skv / KVBLK;
    const int NT = j_hi - j_lo;
    const int kbn = swa_jlo(nxt.P0, W) * KVBLK;
    const int qlo = cur.P0 + wid * QBLK, qm = qlo + r32 - 4 * hi;
    char* V_lds = lds; char* K_lds = lds + 2 * SHM_V;
    float* ws = (float*)(lds + 2 * SHM_V + 2 * SHM_K) + wid * 64; float* li_l = ws, * al_l = ws + 32;
    float m_reg = -1e30f, l_reg = 0; f32x16 o[4] = {};
    const int sr = tid >> 4, sc = (tid & 15) * 8, vst0 = v_st(sr, sc), vst1 = v_st(32 + sr, sc), kws = KSWZ(sr, sc * 2);
    const int vb0 = (int)(uintptr_t)V_lds + v_rd_base(lane);
    const TIn* Kh = cur.K; const TIn* Vh = cur.V;
#define RESC(a) do { if (__any((a) < 1.f)) { if (hi == 0) al_l[r32] = (a); asm volatile("s_waitcnt lgkmcnt(0)" ::: "memory");              \
                     for (int d_ = 0; d_ < 4; ++d_) for (int r = 0; r < 16; ++r) o[d_][r] *= al_l[crow(r, hi)]; } } while (0)
#define KBASE(t) ((j_lo + (t)) * KVBLK)
#define BIAS(t) (cur.bias + (t) * KVBLK)
#define ACT(t) (KBASE(t) <= qlo + QBLK - 1 && KBASE(t) + KVBLK - 1 >= qlo - W + 1)
#define MASKT(P0_, P1_, t) do { const int kb_ = KBASE(t); if ((!SK || ACT(t)) && (kb_ + KVBLK - 1 > qlo || kb_ <= qlo + QBLK - 1 - W)) mask_tile(P0_, P1_, qm - kb_, (unsigned)W); } while (0)
    constexpr int NQL = F32 ? 16 : 8;
    constexpr bool SK = WSKIP && !F32;
#define SEAM_K0() do { VMWN(NQL); if constexpr (F32) { SWRITE_KF(0); SBAR(); SLOAD_F((const float*)nxt.V, kbn); } else { SWRITE_HK(0); } SBAR(); } while (0)
    f32x16 pA0, pA1, pB0, pB1; float mnA, mnB, alA, alB; bf16x8 pa0, pa1, pa2, pa3;
    if constexpr (F32) { VMW(); SWRITE_VF(0); SBAR(); } else { SWRITE_HV(0); SBAR(); }
    if (NT > 1) { if constexpr (F32) SLOAD_F((const float*)Kh, KBASE(1)); else SLOAD_H(Kh, Vh, KBASE(1)); }
    SBAR(); qkt<0, SK>(pA0, pA1, K_lds, r32, hi, S.qr, ACT(0), BIAS(0));
    if constexpr (F32) { if (NT > 1) { VMW(); SWRITE_KF(1); SBAR(); SLOAD_F((const float*)Vh, KBASE(1)); } }
    MASKT(pA0, pA1, 0); partialSM(pA0, pA1, m_reg, mnA, alA);
    if (NT > 1) { VMW(); if constexpr (F32) { SWRITE_VF(1); SBAR(); if (NT > 2) SLOAD_F((const float*)Kh, KBASE(2)); } else SWRITE_H(1); }
    __syncthreads();
#define HALF_STEP(PX0, PX1, mnX, alX, PY0, PY1, alY, t, KB, VB, SB) do {                                                      \
        SBAR(); qkt<KB, SK>(PX0, PX1, K_lds, r32, hi, S.qr, ACT(t), BIAS(t));                                             \
        finishSM(PY0, PY1, alY, l_reg, pa0, pa1, pa2, pa3); SBAR();                                                           \
        if ((t) + 1 < NT) { if constexpr (F32) { VMW(); SWRITE_KF(SB); SBAR(); SLOAD_F((const float*)Vh, KBASE((t) + 1)); }  \
                            else { SLOAD_H(Kh, Vh, KBASE((t) + 1)); } SBAR(); }                                               \
        pv_tile<VB, SK>(o, vb0, pa0, pa1, pa2, pa3, ACT((t) - 1)); MASKT(PX0, PX1, (t)); partialSM(PX0, PX1, m_reg, mnX, alX);                                        \
        __syncthreads();                                                                                                      \
        if ((t) + 1 < NT) { VMW(); if constexpr (F32) { SWRITE_VF(SB); SBAR(); if ((t) + 2 < NT) SLOAD_F((const float*)Kh, KBASE((t) + 2)); } \
                            else { SWRITE_H(SB); } }                                                                          \
        RESC(alX); __syncthreads(); } while (0)
    for (int t = 1; t + 1 < NT; t += 2) {
        HALF_STEP(pB0, pB1, mnB, alB, pA0, pA1, alA, t, 1, 0, 0);
        HALF_STEP(pA0, pA1, mnA, alA, pB0, pB1, alB, t + 1, 0, 1, 1);
    }
    const bool even = (NT & 1) == 0;
    if (even) { SBAR(); qkt<1, SK>(pB0, pB1, K_lds, r32, hi, S.qr, ACT(NT - 1), BIAS(NT - 1)); SBAR(); }
#define QROW(e) (nxt.Q + (size_t)(wid * QBLK + r32) * D + ((e) >> 1) * 16 + hi * 8 + ((e) & 1) * 4)
    if constexpr (F32) { SLOAD_F((const float*)nxt.K, kbn); SBAR();
#pragma unroll
        for (int e = 0; e < 8; ++e) S.tq[e] = *(const f32x4*)QROW(e); }
    SBAR();
    finishSM(pA0, pA1, alA, l_reg, pa0, pa1, pa2, pa3); SBAR();
    if constexpr (F32) {
#pragma unroll
        for (int e = 8; e < 16; ++e) S.tq[e] = *(const f32x4*)QROW(e); SBAR(); }
#undef QROW
    pv_tile<0, SK>(o, vb0, pa0, pa1, pa2, pa3, ACT(even ? NT - 2 : NT - 1));
    if (even) { MASKT(pB0, pB1, NT - 1); partialSM(pB0, pB1, m_reg, mnB, alB); __syncthreads(); RESC(alB);
        finishSM(pB0, pB1, alB, l_reg, pa0, pa1, pa2, pa3); SBAR(); pv_tile<1, SK>(o, vb0, pa0, pa1, pa2, pa3, ACT(NT - 1)); }
    SBAR();
    if (hi == 0) li_l[r32] = l_reg; asm volatile("s_waitcnt lgkmcnt(0)" ::: "memory");
    float rli[16];
#pragma unroll
    for (int r = 0; r < 16; ++r) rli[r] = __builtin_amdgcn_rcpf(li_l[crow(r, hi)]);
    {
        float rs[16];
#pragma unroll
        for (int r = 0; r < 16; ++r) { float s = 0.f;
#pragma unroll
            for (int d0 = 0; d0 < 4; ++d0) { o[d0][r] *= rli[r]; s += o[d0][r] * o[d0][r]; }
            s += sw_xor<1>(s); s += sw_xor<2>(s); s += sw_xor<4>(s); s += sw_xor<8>(s); s += sw_xor<16>(s);
            rs[r] = rsqrtf(s * (1.f / 128.f) + 1e-6f); }
        float gg[4];
#pragma unroll
        for (int d0 = 0; d0 < 4; ++d0) gg[d0] = cur.g[d0 * 32 + r32];
        TOut* Ow = cur.O + (size_t)(wid * QBLK) * 2048;
#pragma unroll
        for (int r = 0; r < 16; ++r) { const int orow = crow(r, hi);
#pragma unroll
            for (int d0 = 0; d0 < 4; ++d0) { const float v = o[d0][r] * rs[r] * gg[d0]; const float vn = sw_xor<1>(v);
                if ((r32 & 1) == 0) *(unsigned*)(Ow + (size_t)orow * 2048 + d0 * 32 + r32) = cvtpk(v, vn); } }
    }
    if constexpr (F32) {
#pragma unroll
        for (int d0 = 0; d0 < 8; ++d0) S.qr[d0] = pack8(S.tq[2 * d0], S.tq[2 * d0 + 1]); }
    __syncthreads();
#undef RESC
#undef KBASE
#undef BIAS
#undef ACT
#undef MASKT
#undef SEAM_K0
#undef HALF_STEP
}
#undef ROW
#undef VMW
#undef VMWN
#undef SLOAD_H
#undef SWRITE_HK
#undef SWRITE_HV
#undef SWRITE_H
#undef SLOAD_F
#undef SWRITE_KF
#undef SWRITE_VF
}

constexpr size_t OFF_NORMS = 32768;
__device__ __forceinline__ float sumsq8(uint4 v) {
    const float a0 = __uint_as_float(v.x << 16), a1 = __uint_as_float(v.x & 0xffff0000u), a2 = __uint_as_float(v.y << 16), a3 = __uint_as_float(v.y & 0xffff0000u);
    const float a4 = __uint_as_float(v.z << 16), a5 = __uint_as_float(v.z & 0xffff0000u), a6 = __uint_as_float(v.w << 16), a7 = __uint_as_float(v.w & 0xffff0000u);
    return (a0 * a0 + a1 * a1) + (a2 * a2 + a3 * a3) + (a4 * a4 + a5 * a5) + (a6 * a6 + a7 * a7);
}
__device__ __forceinline__ void phase_norms(const P& p, unsigned char* lds, int G, int bid) {
    int tid = threadIdx.x; asm volatile("" : "+v"(tid));
    const int lane = tid & 63, w = tid >> 6, sub = lane >> 4, l16 = lane & 15, gw = bid * NWAVES + w, NGW = G * NWAVES;
    float* red = (float*)lds;
    float mq[8], mk[8];
#pragma unroll
    for (int h = 0; h < 8; ++h) { mq[h] = 0.f; mk[h] = 0.f; }
    for (int g = gw; g < LR / 4; g += NGW) {
        uint4 vq[8], vk[8];
#pragma unroll
        for (int h = 0; h < 8; ++h) {
            vk[h] = *(const uint4*)((const bf16_t*)(p.ws + OFF_FK) + ((size_t)h * LR + g * 4 + sub) * 128 + l16 * 8);
            vq[h] = g < SEQ / 4 ? *(const uint4*)((const bf16_t*)(p.ws + OFF_FQ) + ((size_t)h * SEQ + g * 4 + sub) * 128 + l16 * 8) : make_uint4(0u, 0u, 0u, 0u);
        }
#pragma unroll
        for (int h = 0; h < 8; ++h) {
            float a = sumsq8(vq[h]), b = sumsq8(vk[h]);
            a += sw_xor<1>(a); b += sw_xor<1>(b); a += sw_xor<2>(a); b += sw_xor<2>(b);
            a += sw_xor<4>(a); b += sw_xor<4>(b); a += sw_xor<8>(a); b += sw_xor<8>(b);
            mq[h] = fmaxf(mq[h], a); mk[h] = fmaxf(mk[h], b);
        }
    }
#pragma unroll
    for (int h = 0; h < 8; ++h) { const float a = wave_max(mq[h]), b = wave_max(mk[h]); if (lane == 0) { red[(h * 2) * 8 + w] = a; red[(h * 2 + 1) * 8 + w] = b; } }
    __syncthreads();
    if (tid < 16) { float m = 0.f;
#pragma unroll
        for (int q = 0; q < 8; ++q) m = fmaxf(m, red[tid * 8 + q]);
        ((float*)(p.ws + OFF_NORMS))[(size_t)bid * 16 + tid] = m; }
    __syncthreads();
}

__device__ __forceinline__ void phase_fox(const P& p, unsigned char* lds_g, int G, int bid) {
    using namespace fx;
    for (int it = bid; it < 256; it += G) {
        int tid = threadIdx.x; asm volatile("" : "+v"(tid));
        const int lane = tid & 63, w = tid >> 6;
        const int h = it & 7, qb = 31 - (it >> 3);
        const int P0 = 64 + qb * 256, j_hi = (P0 + QB - 1) / KVBLK + 1;
        const float* CBh = (const float*)(p.ws + OFF_CB) + (size_t)h * LR;
        float* sc = (float*)(lds_g + FOX_BIAS_OFF);
        { float a = 0.f, b = 0.f; const float* NR = (const float*)(p.ws + OFF_NORMS);
          for (int i = tid; i < G; i += 512) { a = fmaxf(a, NR[(size_t)i * 16 + 2 * h]); b = fmaxf(b, NR[(size_t)i * 16 + 2 * h + 1]); }
          a = wave_max(a); b = wave_max(b); if (lane == 0) { sc[w] = a; sc[8 + w] = b; } }
        __syncthreads();
        float qm = 0.f, km = 0.f;
#pragma unroll
        for (int q = 0; q < 8; ++q) { qm = fmaxf(qm, sc[q]); km = fmaxf(km, sc[8 + q]); }
        const float T = 2.f * SCALE * sqrtf(qm * km) + 30.f;
        const float thr = CBh[P0] - T * (1.f / SCALE);
        const int j_lo = !FOX_SKIP ? (__syncthreads(), 0) : __syncthreads_count(tid < j_hi && !(CBh[64 * tid + 63 < LR ? 64 * tid + 63 : LR - 1] >= thr));
        { const f32x4* src = (const f32x4*)(CBh + j_lo * 64);
          f32x4* dst = (f32x4*)(lds_g + FOX_BIAS_OFF);
          for (int i = tid; i < (j_hi - j_lo) * 16; i += 512) dst[i] = src[i]; }
        __syncthreads();
        BlockRef<bf16, bf16> cur;
        cur.Q = (const bf16*)(p.ws + OFF_FQ) + ((size_t)h * SEQ + qb * 256) * 128;
        cur.K = (const bf16*)(p.ws + OFF_FK) + (size_t)h * LR * 128;
        cur.V = (const bf16*)(p.ws + OFF_FV) + (size_t)h * LR * 128;
        cur.O = (bf16*)(p.ws + OFF_MIX) + (size_t)(qb * 256) * DM + 1024 + h * 128;
        cur.P0 = P0; cur.bias = (const float*)(lds_g + FOX_BIAS_OFF); cur.g = p.fox_g; cur.jlo = j_lo;
        Seam<bf16> S;
        causal_swa_prime<bf16, bf16>(cur, 1 << 30, (char*)lds_g, S);
        causal_swa_block<bf16, bf16>(cur, cur, LR, 1 << 30, (char*)lds_g, S);
    }
}

constexpr size_t OFF_UB = OFF_A0;
constexpr size_t OFF_SB = OFF_GLAO;
constexpr size_t OFF_DEC = 65536;
constexpr size_t WS_END_GLA = OFF_DEC + (size_t)128 * 4 * 128 * 4;
static_assert(WS_END_GLA <= OFF_A0, "ws map");
namespace gla {
using fx::s16x4; using fx::f32x16;
constexpr int L_ZS = 0, L_SEG = 4096, L_EX = 6144, L_V = 8192, L_A0 = 40960, L_A1 = 58368, L_A2 = 75776;
constexpr int RS = 272;
constexpr int KTS = 144;
#define GLA_TRRD(dst, base, off) asm volatile("ds_read_b64_tr_b16 %0, %1 offset:%2" : "=&v"(dst) : "v"(base), "i"(off) : "memory")
#define GLA_PK4(P, B_, OUT) do { unsigned a0 = cvtpk(P[B_+0], P[B_+1]), a1 = cvtpk(P[B_+2], P[B_+3]);                          \
        unsigned b0 = cvtpk(P[B_+4], P[B_+5]), b1 = cvtpk(P[B_+6], P[B_+7]);                                             \
        auto r0 = __builtin_amdgcn_permlane32_swap(a0, b0, false, false); auto r1 = __builtin_amdgcn_permlane32_swap(a1, b1, false, false); \
        u32x4 w_ = {r0[0], r1[0], r0[1], r1[1]}; OUT = __builtin_bit_cast(bf16x8, w_); } while (0)

struct CastPlan { const f32x4* s[6]; u32x2* d[6]; };
__device__ __forceinline__ CastPlan cast_plan_p1(const P& p, int it) { CastPlan c;
#pragma unroll
    for (int k = 0; k < 4; ++k) { c.s[k] = (const f32x4*)p.wg + (size_t)it * 16384 + k * 4096; c.d[k] = (u32x2*)(p.ws + OFF_WG16) + (size_t)it * 16384 + k * 4096; }
#pragma unroll
    for (int k = 0; k < 2; ++k) { c.s[4 + k] = (const f32x4*)p.wu + (size_t)it * 16384 + k * 4096; c.d[4 + k] = (u32x2*)(p.ws + OFF_WU16) + (size_t)it * 16384 + k * 4096; }
    return c; }
__device__ __forceinline__ CastPlan cast_plan_p3(const P& p, int it) { CastPlan c;
#pragma unroll
    for (int k = 0; k < 2; ++k) { c.s[k] = (const f32x4*)p.wu + (size_t)it * 16384 + 8192 + k * 4096; c.d[k] = (u32x2*)(p.ws + OFF_WU16) + (size_t)it * 16384 + 8192 + k * 4096; }
#pragma unroll
    for (int k = 0; k < 4; ++k) { c.s[2 + k] = (const f32x4*)p.wd + (size_t)it * 16384 + k * 4096; c.d[2 + k] = (u32x2*)(p.ws + OFF_WD16) + (size_t)it * 16384 + k * 4096; }
    return c; }
#define CAST_ISSUE(k) do { _Pragma("unroll") for (int j_ = 0; j_ < 8; ++j_) cv[j_] = nt_load(&cpl.s[k][j_ * 512 + tid]); } while (0)
#define CAST_FIN(k) do { _Pragma("unroll") for (int j_ = 0; j_ < 8; ++j_) nt_store((u32x2){cvtpk(cv[j_][0], cv[j_][1]), cvtpk(cv[j_][2], cv[j_][3])}, &cpl.d[k][j_ * 512 + tid]); } while (0)

__device__ __forceinline__ void stage_zv(const P& p, unsigned char* lds, int n, int h, int tid, bool with_z = true) {
    if (with_z && tid < 256) ((float4*)(lds + L_ZS))[tid] = ((const float4*)((const float*)(p.ws + OFF_GZ) + (size_t)n * 64 * 16))[tid];
    const bf16_t* GV = (const bf16_t*)(p.ws + OFF_GV) + ((size_t)h * LR + n * 64) * 256;
    const int sr = tid >> 4, sc = (tid & 15) * 8;
#pragma unroll
    for (int half = 0; half < 2; ++half)
#pragma unroll
        for (int kk = 0; kk < 2; ++kk) { const int key = sr + 32 * kk;
            const uint4 v = *(const uint4*)(GV + (size_t)key * 256 + half * 128 + sc);
            *(uint4*)(lds + L_V + half * 16384 + fx::v_st(key, sc)) = v; }
}
__device__ __forceinline__ void gate_compute(unsigned char* lds, int n, int tid, const float (&w2r)[16], float bgd, float (&b)[16], float& blast, float& bref) {
    const int d = tid & 127, rq = tid >> 7;
    const float* zs = (const float*)(lds + L_ZS);
    float run = 0.f;
#pragma unroll
    for (int ii = 0; ii < 16; ++ii) {
        const int i = rq * 16 + ii; const float4* z4 = (const float4*)(zs + i * 16);
        float lg = bgd;
#pragma unroll
        for (int q = 0; q < 4; ++q) { const float4 z = z4[q]; lg = fmaf(z.x, w2r[4 * q], lg); lg = fmaf(z.y, w2r[4 * q + 1], lg); lg = fmaf(z.z, w2r[4 * q + 2], lg); lg = fmaf(z.w, w2r[4 * q + 3], lg); }
        float la = logsigmoidf(lg) * (1.f / 16.f);
        if (n == 0 && i < 48) la = 0.f;
        run += la; b[ii] = run;
    }
    float la32;
    { const float4* z4 = (const float4*)(zs + 32 * 16); float lg = bgd;
#pragma unroll
      for (int q = 0; q < 4; ++q) { const float4 z = z4[q]; lg = fmaf(z.x, w2r[4 * q], lg); lg = fmaf(z.y, w2r[4 * q + 1], lg); lg = fmaf(z.z, w2r[4 * q + 2], lg); lg = fmaf(z.w, w2r[4 * q + 3], lg); }
      la32 = logsigmoidf(lg) * (1.f / 16.f); if (n == 0) la32 = 0.f; }
    float* seg = (float*)(lds + L_SEG);
    seg[rq * 128 + d] = run;
    __syncthreads();
    const float s0 = seg[d], s1 = seg[128 + d], s2 = seg[256 + d], s3 = seg[384 + d];
    const float prefix = (rq > 0 ? s0 : 0.f) + (rq > 1 ? s1 : 0.f) + (rq > 2 ? s2 : 0.f);
#pragma unroll
    for (int ii = 0; ii < 16; ++ii) b[ii] += prefix;
    blast = (s0 + s1) + (s2 + s3); bref = s0 + s1 + la32;
}

__device__ __forceinline__ void p1_item(const P& p, unsigned char* lds, int n, int h) {
    int tid = threadIdx.x; asm volatile("" : "+v"(tid));
    const int lane = tid & 63, w = __builtin_amdgcn_readfirstlane(tid >> 6), r = lane & 31, hh = lane >> 5;
    const int d = tid & 127, rq = tid >> 7;
    stage_zv(p, lds, n, h, tid);
    float kv[16], w2r[16];
    { const bf16_t* GK = (const bf16_t*)(p.ws + OFF_GK) + ((size_t)h * LR + n * 64 + rq * 16) * 128 + d;
#pragma unroll
      for (int ii = 0; ii < 16; ++ii) kv[ii] = bf2f(GK[(size_t)ii * 128]); }
#pragma unroll
    for (int r_ = 0; r_ < 16; ++r_) w2r[r_] = p.w2[r_ * 512 + h * 128 + d];
    const float bgd = p.bg[h * 128 + d];
    const CastPlan cpl = cast_plan_p1(p, n * 4 + h); f32x4 cv[8];
    CAST_ISSUE(0);
    __syncthreads();
    float b[16], blast, bref;
    gate_compute(lds, n, tid, w2r, bgd, b, blast, bref);
    CAST_FIN(0); CAST_ISSUE(1);
    { float* BB = (float*)(p.ws + OFF_BBUF) + (((size_t)n * 4 + h) * 64 + rq * 16) * 128 + d;
#pragma unroll
      for (int ii = 0; ii < 16; ++ii) BB[(size_t)ii * 128] = b[ii]; }
    { u32x4 w0, w1;
      float e[16];
#pragma unroll
      for (int ii = 0; ii < 16; ++ii) e[ii] = kv[ii] * fexp(blast - b[ii]);
      w0.x = cvtpk(e[0], e[1]); w0.y = cvtpk(e[2], e[3]); w0.z = cvtpk(e[4], e[5]); w0.w = cvtpk(e[6], e[7]);
      w1.x = cvtpk(e[8], e[9]); w1.y = cvtpk(e[10], e[11]); w1.z = cvtpk(e[12], e[13]); w1.w = cvtpk(e[14], e[15]);
      *(u32x4*)(lds + L_A0 + d * KTS + rq * 32) = w0; *(u32x4*)(lds + L_A0 + d * KTS + rq * 32 + 16) = w1;
      if (rq == 0) ((float*)(p.ws + OFF_DEC))[((size_t)n * 4 + h) * 128 + d] = fexp(blast); }
    CAST_FIN(1); CAST_ISSUE(2);
    __syncthreads();
    const int vb = (int)(uintptr_t)(lds + L_V) + fx::v_rd_base(lane) + (w >> 2) * 16384 + (w & 3) * 512;
    f32x16 acc[4];
#pragma unroll
    for (int db = 0; db < 4; ++db) acc[db] = f32x16{};
#define GLA_P1_KS(ks) do { s16x4 lo, hi4; GLA_TRRD(lo, vb, (ks) * 4096); GLA_TRRD(hi4, vb, (ks) * 4096 + 2048); \
        asm volatile("s_waitcnt lgkmcnt(0)" ::: "memory"); __builtin_amdgcn_sched_barrier(0); \
        const bf16x8 vf = (bf16x8){lo[0], lo[1], lo[2], lo[3], hi4[0], hi4[1], hi4[2], hi4[3]}; \
        _Pragma("unroll") for (int db = 0; db < 4; ++db) { const bf16x8 kf = *(const bf16x8*)(lds + L_A0 + (32 * db + r) * KTS + (16 * (ks) + 8 * hh) * 2); \
            acc[db] = __builtin_amdgcn_mfma_f32_32x32x16_bf16(vf, kf, acc[db], 0, 0, 0); } } while (0)
    GLA_P1_KS(0); GLA_P1_KS(1);
    CAST_FIN(2); CAST_ISSUE(3);
    GLA_P1_KS(2); GLA_P1_KS(3);
#undef GLA_P1_KS
    { unsigned char* stg = lds + 65536 + w * 8192;
#pragma unroll
      for (int x = 0; x < 16; ++x) { const int vrow = fx::crow(x, hh);
#pragma unroll
          for (int db = 0; db < 4; ++db) { const float v = acc[db][x], vn = sw_xor<1>(v);
              if ((r & 1) == 0) *(unsigned*)(stg + vrow * 256 + (32 * db + r) * 2) = cvtpk(v, vn); } }
      asm volatile("s_waitcnt lgkmcnt(0)" ::: "memory");
      CAST_FIN(3); CAST_ISSUE(4);
      bf16_t* UB = (bf16_t*)(p.ws + OFF_UB) + ((size_t)n * 4 + h) * 256 * 128 + (size_t)(32 * w) * 128;
#pragma unroll
      for (int i = 0; i < 8; ++i) { const int row = i * 4 + (lane >> 4), ch = lane & 15;
          *(u32x4*)(UB + (size_t)row * 128 + ch * 8) = *(const u32x4*)(stg + row * 256 + ch * 16); } }
    CAST_FIN(4); CAST_ISSUE(5);
    __syncthreads();
    CAST_FIN(5);
}

__device__ __forceinline__ void scan_thread(const P& p, int gid) {
    const int d2 = gid & 63, hv = gid >> 6, h = hv >> 8;
    const unsigned* UB = (const unsigned*)(p.ws + OFF_UB) + (size_t)hv * 64 + d2;
    unsigned* SB = (unsigned*)(p.ws + OFF_SB) + (size_t)hv * 64 + d2;
    const float2* DEC = (const float2*)(p.ws + OFF_DEC) + (size_t)h * 64 + d2;
    float s0 = 0.f, s1 = 0.f;
    for (int n0 = 0; n0 < 128; n0 += 32) {
        unsigned u[32]; float2 dc[32];
#pragma unroll
        for (int j = 0; j < 32; ++j) { u[j] = UB[(size_t)(n0 + j) * (4 * 256 * 64)]; dc[j] = DEC[(size_t)(n0 + j) * (4 * 64)]; }
#pragma unroll
        for (int j = 0; j < 32; ++j) {
            s0 = fmaf(dc[j].x, s0, __uint_as_float(u[j] << 16)); s1 = fmaf(dc[j].y, s1, __uint_as_float(u[j] & 0xffff0000u));
            SB[(size_t)(n0 + j) * (4 * 256 * 64)] = cvtpk(s0, s1);
        }
    }
}

__device__ __forceinline__ void p3_item(const P& p, unsigned char* lds, int n, int h) {
    int tid = threadIdx.x; asm volatile("" : "+v"(tid));
    const int lane = tid & 63, w = __builtin_amdgcn_readfirstlane(tid >> 6), r = lane & 31, hh = lane >> 5;
    const int d = tid & 127, rq = tid >> 7, rb = w & 1, cg = w >> 1;
    const bool fast = n < 128;
    float qv[16], kv[16], b[16], bref;
    { const size_t off = ((size_t)h * LR + n * 64 + rq * 16) * 128 + d;
      const bf16_t* GQ = (const bf16_t*)(p.ws + OFF_GQ) + off; const bf16_t* GK = (const bf16_t*)(p.ws + OFF_GK) + off;
#pragma unroll
      for (int ii = 0; ii < 16; ++ii) { qv[ii] = bf2f(GQ[(size_t)ii * 128]) * SCALE128; kv[ii] = bf2f(GK[(size_t)ii * 128]); } }
    if (fast) { const float* BB = (const float*)(p.ws + OFF_BBUF) + (((size_t)n * 4 + h) * 64) * 128 + d;
#pragma unroll
        for (int ii = 0; ii < 16; ++ii) b[ii] = BB[(size_t)(rq * 16 + ii) * 128];
        bref = BB[(size_t)32 * 128]; }
    stage_zv(p, lds, n, h, tid, !fast);
    const CastPlan cpl = cast_plan_p3(p, (n - 1) * 4 + h); f32x4 cv[8];
    CAST_ISSUE(0);
    __syncthreads();
    bf16x8 sfr[2][8];
    { const bf16_t* SB = (const bf16_t*)(p.ws + OFF_SB) + ((size_t)(n - 1) * 4 + h) * 256 * 128 + (size_t)(64 * cg + r) * 128 + 8 * hh;
#pragma unroll
      for (int tl = 0; tl < 2; ++tl)
#pragma unroll
          for (int s_ = 0; s_ < 8; ++s_) sfr[tl][s_] = *(const bf16x8*)(SB + (size_t)tl * 32 * 128 + 16 * s_); }
    if (!fast) { float w2r[16], blast;
#pragma unroll
        for (int r_ = 0; r_ < 16; ++r_) w2r[r_] = p.w2[r_ * 512 + h * 128 + d];
        gate_compute(lds, n, tid, w2r, p.bg[h * 128 + d], b, blast, bref); }
    const float ebref = fexp(bref);
#pragma unroll
    for (int ii = 0; ii < 16; ++ii) {
        const int i = rq * 16 + ii;
        const float eq = fexp(b[ii] - bref);
        *(bf16_t*)(lds + L_A0 + i * RS + d * 2) = f2bf(qv[ii] * eq);
        *(bf16_t*)(lds + L_A1 + i * RS + d * 2) = f2bf(qv[ii] * (eq * ebref));
        *(bf16_t*)(lds + L_A2 + i * RS + d * 2) = f2bf(kv[ii] * __builtin_amdgcn_rcpf(eq));
    }
    CAST_FIN(0); CAST_ISSUE(1);
    __syncthreads();
    f32x16 P0 = f32x16{}, P1v = f32x16{};
#pragma unroll
    for (int s_ = 0; s_ < 8; ++s_) {
        const bf16x8 qf = *(const bf16x8*)(lds + L_A0 + (32 * rb + r) * RS + (16 * s_ + 8 * hh) * 2);
        const bf16x8 k0 = *(const bf16x8*)(lds + L_A2 + r * RS + (16 * s_ + 8 * hh) * 2);
        P0 = __builtin_amdgcn_mfma_f32_32x32x16_bf16(k0, qf, P0, 0, 0, 0);
        if (rb) { const bf16x8 k1 = *(const bf16x8*)(lds + L_A2 + (32 + r) * RS + (16 * s_ + 8 * hh) * 2);
                  P1v = __builtin_amdgcn_mfma_f32_32x32x16_bf16(k1, qf, P1v, 0, 0, 0); }
    }
#pragma unroll
    for (int x = 0; x < 16; ++x) { const bool keep = fx::crow(x, hh) <= r; if (rb) { if (!keep) P1v[x] = 0.f; } else { if (!keep) P0[x] = 0.f; } }
    bf16x8 pa0, pa1, pa2, pa3;
    GLA_PK4(P0, 0, pa0); GLA_PK4(P0, 8, pa1); GLA_PK4(P1v, 0, pa2); GLA_PK4(P1v, 8, pa3);
    CAST_FIN(1); CAST_ISSUE(2);
    f32x16 o[2];
#pragma unroll
    for (int tl = 0; tl < 2; ++tl) {
        const int vblk = 2 * cg + tl;
        const int vb = (int)(uintptr_t)(lds + L_V) + fx::v_rd_base(lane) + (vblk >> 2) * 16384 + (vblk & 3) * 512;
        o[tl] = f32x16{};
#define GLA_PV(ks, PA) do { s16x4 lo, hi4; GLA_TRRD(lo, vb, (ks) * 4096); GLA_TRRD(hi4, vb, (ks) * 4096 + 2048); \
        asm volatile("s_waitcnt lgkmcnt(0)" ::: "memory"); __builtin_amdgcn_sched_barrier(0); \
        o[tl] = __builtin_amdgcn_mfma_f32_32x32x16_bf16(PA, (bf16x8){lo[0], lo[1], lo[2], lo[3], hi4[0], hi4[1], hi4[2], hi4[3]}, o[tl], 0, 0, 0); } while (0)
        GLA_PV(0, pa0); GLA_PV(1, pa1);
        if (rb) { GLA_PV(2, pa2); GLA_PV(3, pa3); }
#undef GLA_PV
#pragma unroll
        for (int s_ = 0; s_ < 8; ++s_) {
            const bf16x8 qh = *(const bf16x8*)(lds + L_A1 + (32 * rb + r) * RS + (16 * s_ + 8 * hh) * 2);
            o[tl] = __builtin_amdgcn_mfma_f32_32x32x16_bf16(qh, sfr[tl][s_], o[tl], 0, 0, 0);
        }
    }
    CAST_FIN(2); CAST_ISSUE(3);
    float* ex = (float*)(lds + L_EX);
#pragma unroll
    for (int x = 0; x < 16; ++x) { float s = o[0][x] * o[0][x] + o[1][x] * o[1][x];
        s += sw_xor<1>(s); s += sw_xor<2>(s); s += sw_xor<4>(s); s += sw_xor<8>(s); s += sw_xor<16>(s);
        if (r == 0) ex[(32 * rb + fx::crow(x, hh)) * 4 + cg] = s; }
    CAST_FIN(3); CAST_ISSUE(4);
    __syncthreads();
    const float g0 = p.gla_g[64 * cg + r], g1 = p.gla_g[64 * cg + 32 + r];
#pragma unroll
    for (int x = 0; x < 16; ++x) {
        const int row = 32 * rb + fx::crow(x, hh); const f32x4 e4 = *(const f32x4*)(ex + row * 4);
        const float rs = rsqrtf(((e4[0] + e4[1]) + (e4[2] + e4[3])) * (1.f / 256.f) + EPS);
        const size_t t = (size_t)(n - 1) * 64 + row;
        const bf16_t* GR = (const bf16_t*)(p.ws + OFF_GR) + t * 1024 + h * 256 + 64 * cg + r;
        bf16_t* MX = (bf16_t*)(p.ws + OFF_MIX) + t * DM + h * 256 + 64 * cg + r;
        const float v0 = o[0][x] * rs * g0 * siluf(bf2f(GR[0])), v1 = o[1][x] * rs * g1 * siluf(bf2f(GR[32]));
        const float v0n = sw_xor<1>(v0), v1n = sw_xor<1>(v1);
        if ((r & 1) == 0) { *(unsigned*)MX = cvtpk(v0, v0n); *(unsigned*)(MX + 32) = cvtpk(v1, v1n); }
    }
    CAST_FIN(4); CAST_ISSUE(5);
    __syncthreads();
    CAST_FIN(5);
}
}
__device__ __forceinline__ void phase_gla_p1(const P& p, unsigned char* lds, int G, int bid) { for (int it = bid; it < 512; it += G) gla::p1_item(p, lds, it >> 2, it & 3); }
__device__ __forceinline__ void phase_gla_scan(const P& p, int G, int bid) {
    int tid = threadIdx.x; asm volatile("" : "+v"(tid));
    const int per = (65536 + G - 1) / G;
    for (int i = tid; i < per; i += 512) { const int g = bid * per + i; if (g < 65536) gla::scan_thread(p, g); }
}
__device__ __forceinline__ void phase_gla_p3(const P& p, unsigned char* lds, int G, int bid) { for (int it = bid; it < 512; it += G) gla::p3_item(p, lds, 1 + (it >> 2), it & 3); }


__device__ __forceinline__ void cscan_head(const P& p, unsigned char* lds, int h) {
    int tid = threadIdx.x; asm volatile("" : "+v"(tid));
    const int lane = tid & 63, w = tid >> 6;
    const float* FLOG = (const float*)(p.ws + OFF_FLOG) + h;
    float* CB = (float*)(p.ws + OFF_CB) + (size_t)h * LR;
    const float bf = p.b_f[h];
    const int l0 = tid * 17;
    float v[17]; float run = 0.f;
#pragma unroll
    for (int k = 0; k < 17; ++k) { const int l = l0 + k; const float x = (l >= 48 && l < LR) ? FLOG[(size_t)l * 8] : 0.f; v[k] = x; }
#pragma unroll
    for (int k = 0; k < 17; ++k) { const int l = l0 + k; const float la = (l >= 48 && l < LR) ? logsigmoidf(v[k] + bf) : 0.f; run += la; v[k] = run; }
    float inc = run;
#pragma unroll
    for (int o = 1; o < 64; o <<= 1) { const float t = shfl_from(inc, lane - o); if (lane >= o) inc += t; }
    float* wt = (float*)lds;
    if (lane == 63) wt[w] = inc;
    __syncthreads();
    float woff = 0.f;
#pragma unroll
    for (int q = 0; q < 8; ++q) woff += (q < w) ? wt[q] : 0.f;
    const float pre = woff + (inc - run);
#pragma unroll
    for (int k = 0; k < 17; ++k) { const int l = l0 + k; if (l < LR) CB[l] = l >= 48 ? -(pre + v[k]) * (1.f / SCALE128) : -1e30f; }
    __syncthreads();
}
__device__ __forceinline__ void phase_cscan(const P& p, unsigned char* lds, int G, int bid) { for (int h = bid; h < 8; h += G) cscan_head(p, lds, h); }

__device__ __forceinline__ void router_row(const P& p, int t, int lane) {
    const float4* hr = (const float4*)(p.out + (size_t)t * DM);
    float4 u[8]; float ss = 0.f;
#pragma unroll
    for (int j = 0; j < 8; ++j) { u[j] = hr[lane + 64 * j]; ss += u[j].x * u[j].x + u[j].y * u[j].y + u[j].z * u[j].z + u[j].w * u[j].w; }
    ss = wave_sum(ss); const float rs = rsqrtf(ss * (1.f / DM) + EPS);
    uint2* U2 = (uint2*)((bf16_t*)(p.ws + OFF_U2) + (size_t)t * DM);
    float gl[4] = {0.f, 0.f, 0.f, 0.f};
#pragma unroll
    for (int j = 0; j < 8; ++j) {
        const float4 g = ((const float4*)p.g2)[lane + 64 * j];
        u[j].x *= rs * g.x; u[j].y *= rs * g.y; u[j].z *= rs * g.z; u[j].w *= rs * g.w;
        U2[lane + 64 * j] = make_uint2(cvtpk(u[j].x, u[j].y), cvtpk(u[j].z, u[j].w));
        const float4* wr = (const float4*)p.w_rg + (size_t)(lane + 64 * j) * 4;
        const float4 a = wr[0], b = wr[1], c = wr[2], d = wr[3];
        gl[0] += u[j].x * a.x + u[j].y * b.x + u[j].z * c.x + u[j].w * d.x;
        gl[1] += u[j].x * a.y + u[j].y * b.y + u[j].z * c.y + u[j].w * d.y;
        gl[2] += u[j].x * a.z + u[j].y * b.z + u[j].z * c.z + u[j].w * d.z;
        gl[3] += u[j].x * a.w + u[j].y * b.w + u[j].z * c.w + u[j].w * d.w;
    }
#pragma unroll
    for (int g = 0; g < 4; ++g) gl[g] = wave_sum(gl[g]) + p.b_rg[g];
    int gi = 0; float gm = gl[0];
#pragma unroll
    for (int g = 1; g < 4; ++g) if (gl[g] > gm) { gm = gl[g]; gi = g; }
    float gs = 0.f;
#pragma unroll
    for (int g = 0; g < 4; ++g) gs += expf(gl[g] - gm);
    const float p_g = 1.f / gs;
    float el[8] = {0.f, 0.f, 0.f, 0.f, 0.f, 0.f, 0.f, 0.f};
    const float4* we = (const float4*)(p.w_re + (size_t)gi * DM * 8);
#pragma unroll
    for (int j = 0; j < 8; ++j) {
        const float uu[4] = {u[j].x, u[j].y, u[j].z, u[j].w};
#pragma unroll
        for (int i = 0; i < 4; ++i) {
            const int k = 4 * (lane + 64 * j) + i;
            const float4 a = we[(size_t)k * 2], b = we[(size_t)k * 2 + 1];
            el[0] += uu[i] * a.x; el[1] += uu[i] * a.y; el[2] += uu[i] * a.z; el[3] += uu[i] * a.w;
            el[4] += uu[i] * b.x; el[5] += uu[i] * b.y; el[6] += uu[i] * b.z; el[7] += uu[i] * b.w;
        }
    }
#pragma unroll
    for (int e = 0; e < 8; ++e) el[e] = wave_sum(el[e]) + p.b_re[gi * 8 + e];
    int i0 = 0; float l0 = el[0];
#pragma unroll
    for (int e = 1; e < 8; ++e) if (el[e] > l0) { l0 = el[e]; i0 = e; }
    int i1 = -1; float l1 = -INFINITY;
#pragma unroll
    for (int e = 0; e < 8; ++e) if (e != i0 && el[e] > l1) { l1 = el[e]; i1 = e; }
    const float e1 = expf(l1 - l0), w0 = p_g / (1.f + e1), w1 = p_g * e1 / (1.f + e1);
    if (lane == 0) {
        unsigned* cnt = (unsigned*)(p.ws + OFF_CTL);
        int* invmap = (int*)(p.ws + OFF_INVMAP); float* wts = (float*)(p.ws + OFF_WTS);
        const int E0 = gi * 8 + i0, E1 = gi * 8 + i1;
        const unsigned p0 = atomicAdd(&cnt[E0], 1u); invmap[E0 * SEQ + p0] = t * 2; wts[t * 2] = w0;
        const unsigned p1 = atomicAdd(&cnt[E1], 1u); invmap[E1 * SEQ + p1] = t * 2 + 1; wts[t * 2 + 1] = w1;
    }
}
__device__ __forceinline__ void phase_router(const P& p, unsigned char* lds, int G, int bid) {
    int tid = threadIdx.x; asm volatile("" : "+v"(tid));
    const int lane = tid & 63, w = __builtin_amdgcn_readfirstlane(tid >> 6), r = lane & 15, q = lane >> 4;
    float* red = (float*)lds; float* rsc = (float*)(lds + 1024); float* part = (float*)(lds + 2048); float* lgt = (float*)(lds + 2048 + 49152);
    for (int rb = bid; rb < SEQ / 32; rb += G) {
        const int row0 = rb * 32;
        const float* pa0 = p.out + (size_t)(row0 + r) * DM + 256 * w + 4 * q;
        const float* pa1 = pa0 + (size_t)16 * DM;
        const float* pg = p.g2 + 256 * w + 4 * q;
        const float* pb0 = p.w_rg + (size_t)(256 * w + 4 * q) * 4 + (r < 4 ? r : 0);
        const float* pb1 = p.w_re + ((size_t)(r >> 3) * DM + 256 * w + 4 * q) * 8 + (r & 7);
        const float* pb2 = pb1 + (size_t)2 * DM * 8;
        const float m0 = r < 4 ? 1.f : 0.f;
        f32x4 acc[2][3];
#pragma unroll
        for (int rbk = 0; rbk < 2; ++rbk)
#pragma unroll
            for (int cb = 0; cb < 3; ++cb) acc[rbk][cb] = (f32x4){0.f, 0.f, 0.f, 0.f};
        float ss0 = 0.f, ss1 = 0.f;
#pragma unroll 2
        for (int t = 0; t < 16; ++t) {
            const f32x4 a0 = *(const f32x4*)(pa0 + 16 * t), a1 = *(const f32x4*)(pa1 + 16 * t), g4 = *(const f32x4*)(pg + 16 * t);
            ss0 += (a0[0] * a0[0] + a0[1] * a0[1]) + (a0[2] * a0[2] + a0[3] * a0[3]);
            ss1 += (a1[0] * a1[0] + a1[1] * a1[1]) + (a1[2] * a1[2] + a1[3] * a1[3]);
#pragma unroll
            for (int s_ = 0; s_ < 4; ++s_) {
                const float b0 = pb0[(16 * t + s_) * 4] * (g4[s_] * m0), b1 = pb1[(16 * t + s_) * 8] * g4[s_], b2 = pb2[(16 * t + s_) * 8] * g4[s_];
                acc[0][0] = __builtin_amdgcn_mfma_f32_16x16x4f32(a0[s_], b0, acc[0][0], 0, 0, 0); acc[1][0] = __builtin_amdgcn_mfma_f32_16x16x4f32(a1[s_], b0, acc[1][0], 0, 0, 0);
                acc[0][1] = __builtin_amdgcn_mfma_f32_16x16x4f32(a0[s_], b1, acc[0][1], 0, 0, 0); acc[1][1] = __builtin_amdgcn_mfma_f32_16x16x4f32(a1[s_], b1, acc[1][1], 0, 0, 0);
                acc[0][2] = __builtin_amdgcn_mfma_f32_16x16x4f32(a0[s_], b2, acc[0][2], 0, 0, 0); acc[1][2] = __builtin_amdgcn_mfma_f32_16x16x4f32(a1[s_], b2, acc[1][2], 0, 0, 0);
            }
        }
        ss0 += sw_xor<16>(ss0); ss0 = x32_sum(ss0); ss1 += sw_xor<16>(ss1); ss1 = x32_sum(ss1);
        if (q == 0) { red[w * 32 + r] = ss0; red[w * 32 + 16 + r] = ss1; }
#pragma unroll
        for (int rbk = 0; rbk < 2; ++rbk)
#pragma unroll
            for (int cb = 0; cb < 3; ++cb)
#pragma unroll
                for (int i = 0; i < 4; ++i) part[((w * 2 + rbk) * 16 + 4 * q + i) * 48 + 16 * cb + r] = acc[rbk][cb][i];
        __syncthreads();
        if (tid < 32) { float ss = 0.f;
#pragma unroll
            for (int ww = 0; ww < 8; ++ww) ss += red[ww * 32 + tid];
            rsc[tid] = rsqrtf(ss * (1.f / DM) + EPS); }
        for (int idx = tid; idx < 32 * 48; idx += 512) { const int row = idx / 48, col = idx - row * 48; float sum = 0.f;
#pragma unroll
            for (int ww = 0; ww < 8; ++ww) sum += part[((ww * 2 + (row >> 4)) * 16 + (row & 15)) * 48 + col];
            lgt[idx] = sum; }
        __syncthreads();
        { const float rs0 = rsc[r], rs1 = rsc[16 + r];
          bf16_t* U2 = (bf16_t*)(p.ws + OFF_U2) + (size_t)(row0 + r) * DM + 256 * w + 4 * q;
#pragma unroll 4
          for (int t = 0; t < 16; ++t) { const f32x4 g4 = *(const f32x4*)(pg + 16 * t);
              const f32x4 v0 = *(const f32x4*)(pa0 + 16 * t) * g4 * rs0, v1 = *(const f32x4*)(pa1 + 16 * t) * g4 * rs1;
              *(uint2*)(U2 + 16 * t) = make_uint2(cvtpk(v0[0], v0[1]), cvtpk(v0[2], v0[3]));
              *(uint2*)(U2 + (size_t)16 * DM + 16 * t) = make_uint2(cvtpk(v1[0], v1[1]), cvtpk(v1[2], v1[3])); } }
        if (tid < 32) {
            const int t = row0 + tid; const float rs = rsc[tid]; const float* L = lgt + tid * 48;
            float gl[4];
#pragma unroll
            for (int g = 0; g < 4; ++g) gl[g] = L[g] * rs + p.b_rg[g];
            int gi = 0; float gm = gl[0];
#pragma unroll
            for (int g = 1; g < 4; ++g) if (gl[g] > gm) { gm = gl[g]; gi = g; }
            float gs = 0.f;
#pragma unroll
            for (int g = 0; g < 4; ++g) gs += expf(gl[g] - gm);
            const float p_g = 1.f / gs;
            float el[8];
#pragma unroll
            for (int e = 0; e < 8; ++e) el[e] = L[16 + gi * 8 + e] * rs + p.b_re[gi * 8 + e];
            int i0 = 0; float l0 = el[0];
#pragma unroll
            for (int e = 1; e < 8; ++e) if (el[e] > l0) { l0 = el[e]; i0 = e; }
            int i1 = -1; float l1 = -INFINITY;
#pragma unroll
            for (int e = 0; e < 8; ++e) if (e != i0 && el[e] > l1) { l1 = el[e]; i1 = e; }
            const float e1 = expf(l1 - l0), w0 = p_g / (1.f + e1), w1 = p_g * e1 / (1.f + e1);
            unsigned* cnt = (unsigned*)(p.ws + OFF_CTL);
            int* invmap = (int*)(p.ws + OFF_INVMAP); float* wts = (float*)(p.ws + OFF_WTS);
            const int E0 = gi * 8 + i0, E1 = gi * 8 + i1;
            const unsigned p0 = atomicAdd(&cnt[E0], 1u); invmap[E0 * SEQ + p0] = t * 2; wts[t * 2] = w0;
            const unsigned p1 = atomicAdd(&cnt[E1], 1u); invmap[E1 * SEQ + p1] = t * 2 + 1; wts[t * 2 + 1] = w1;
        }
        __syncthreads();
    }
}
__device__ __forceinline__ void final_row(const P& p, int t, int lane) {
    float4* hr = (float4*)(p.out + (size_t)t * DM);
    const uint2* y0 = (const uint2*)((const bf16_t*)(p.ws + OFF_Y) + (size_t)t * DM);
    const uint2* y1 = (const uint2*)((const bf16_t*)(p.ws + OFF_Y) + (size_t)SEQ * DM + (size_t)t * DM);
    float4 v[8]; float ss = 0.f;
#pragma unroll
    for (int j = 0; j < 8; ++j) {
        { const f32x4 t_ = nt_load((const f32x4*)hr + lane + 64 * j); v[j] = make_float4(t_[0], t_[1], t_[2], t_[3]); }
        const u32x2 a_ = nt_load((const u32x2*)y0 + lane + 64 * j), b_ = nt_load((const u32x2*)y1 + lane + 64 * j); const uint2 a = make_uint2(a_[0], a_[1]), b = make_uint2(b_[0], b_[1]);
        v[j].x += __uint_as_float(a.x << 16) + __uint_as_float(b.x << 16);
        v[j].y += __uint_as_float(a.x & 0xffff0000u) + __uint_as_float(b.x & 0xffff0000u);
        v[j].z += __uint_as_float(a.y << 16) + __uint_as_float(b.y << 16);
        v[j].w += __uint_as_float(a.y & 0xffff0000u) + __uint_as_float(b.y & 0xffff0000u);
        ss += v[j].x * v[j].x + v[j].y * v[j].y + v[j].z * v[j].z + v[j].w * v[j].w;
    }
    ss = wave_sum(ss); float rs = rsqrtf(ss * (1.f / DM) + EPS);
#pragma unroll
    for (int j = 0; j < 8; ++j) {
        const float4 g = ((const float4*)p.gf)[lane + 64 * j];
        nt_store((f32x4){v[j].x * rs * g.x, v[j].y * rs * g.y, v[j].z * rs * g.z, v[j].w * rs * g.w}, (f32x4*)hr + lane + 64 * j);
    }
}
__device__ __forceinline__ void phase_final(const P& p, int G, int bid) {
    int tid = threadIdx.x; asm volatile("" : "+v"(tid));
    const int lane = tid & 63, gw = bid * NWAVES + (tid >> 6);
    for (int t = gw; t < SEQ; t += G * NWAVES) final_row(p, t, lane);
}

constexpr int CW_BAR = 4096;
constexpr size_t CTL_ZERO_BYTES = 32768;
#define XB_TMO      128
#define XB_XCNT(j)  (256  + 64 * (j))
#define XB_XSUB(j)  (1280 + 64 * (j))
#define XB_XGEN(j)  (2304 + 64 * (j))
#define XB_TOP      3328
#define XB_TOPGEN   3392
#define XCD_BAR_WORDS 3456
#define XB_SPIN_CAP (1u << 22)
static_assert((CW_BAR + XCD_BAR_WORDS) * 4 <= (int)CTL_ZERO_BYTES, "barrier words inside the memset region");
__device__ __forceinline__ unsigned xb_ld(unsigned* p)              { return __hip_atomic_load(p, __ATOMIC_RELAXED, __HIP_MEMORY_SCOPE_AGENT); }
__device__ __forceinline__ unsigned xb_add(unsigned* p, unsigned v) { return __hip_atomic_fetch_add(p, v, __ATOMIC_RELAXED, __HIP_MEMORY_SCOPE_AGENT); }
__device__ __forceinline__ unsigned xb_xcc_id() { return (unsigned)__builtin_amdgcn_s_getreg((3 << 11) | 20) & 0xFu; }
#define XB_SPIN(cond, bar) do { unsigned _sp = 0; while (cond) { __builtin_amdgcn_s_sleep(1); \
    if ((++_sp & 255u) == 0u) { if (xb_ld(&(bar)[XB_TMO])) break; if (_sp > XB_SPIN_CAP) { atomicAdd(&(bar)[XB_TMO], 1u); break; } } } } while (0)
struct XcdBarrier { unsigned* bar; unsigned x; volatile LAS unsigned* st; };
__device__ __forceinline__ XcdBarrier xcd_barrier_post(unsigned* bar, volatile LAS unsigned* st) {
    XcdBarrier b; b.bar = bar; b.x = xb_xcc_id(); b.st = st;
    if (threadIdx.x == 0) (void)xb_add(&bar[XB_XCNT(b.x)], 1u);
    return b;
}
__device__ __forceinline__ void xcd_barrier_complete(unsigned* bar, unsigned x, unsigned& nloc, unsigned& nx) {
    const unsigned G = gridDim.x * gridDim.y * gridDim.z;
    unsigned sum, cnt, mine, sp = 0u;
    for (;;) {
        sum = 0u; cnt = 0u; mine = 0u;
#pragma unroll
        for (unsigned j = 0; j < 16; ++j) { const unsigned c = xb_ld(&bar[XB_XCNT(j)]); sum += c; cnt += (c > 0u) ? 1u : 0u; mine = (j == x) ? c : mine; }
        if (sum == G) break;
        __builtin_amdgcn_s_sleep(1);
        if ((++sp & 255u) == 0u) { if (xb_ld(&bar[XB_TMO])) break; if (sp > XB_SPIN_CAP) { atomicAdd(&bar[XB_TMO], 1u); break; } }
    }
    nloc = mine > 0u ? mine : 1u; nx = cnt > 0u ? cnt : 1u;
}
__device__ __forceinline__ void xcd_barrier(const XcdBarrier& b) {
    asm volatile("s_waitcnt vmcnt(0)" ::: "memory");
    __syncthreads();
    if (threadIdx.x == 0) {
        unsigned* bar = b.bar;
        __builtin_amdgcn_s_waitcnt(0);
        unsigned nloc = b.st[0], nx = b.st[1];
        if (nloc == 0u) { xcd_barrier_complete(bar, b.x, nloc, nx); b.st[0] = nloc; b.st[1] = nx; }
        const unsigned old = xb_add(&bar[XB_XSUB(b.x)], 1u);
        const unsigned gen = old / nloc;
        if (old + 1u == (gen + 1u) * nloc) {
            __builtin_amdgcn_fence(__ATOMIC_RELEASE, "agent");
            asm volatile("s_waitcnt vmcnt(0)" ::: "memory");
            const unsigned og = xb_add(&bar[XB_TOP], 1u);
            const unsigned tg = og / nx;
            if (og + 1u == (tg + 1u) * nx) xb_add(&bar[XB_TOPGEN], 1u);
            else XB_SPIN(xb_ld(&bar[XB_TOPGEN]) == tg, bar);
            __builtin_amdgcn_fence(__ATOMIC_ACQUIRE, "agent");
            xb_add(&bar[XB_XGEN(b.x)], 1u);
            asm volatile("s_waitcnt vmcnt(0)" ::: "memory");
        } else {
            XB_SPIN(xb_ld(&bar[XB_XGEN(b.x)]) == gen, bar);
            __builtin_amdgcn_fence(__ATOMIC_ACQUIRE, "agent");
            asm volatile("s_waitcnt vmcnt(0)" ::: "memory");
        }
    }
    __syncthreads();
}

constexpr int P_OFF = MISC_OFF + 128;
static_assert(P_OFF + 50 * 4 <= LDS_BYTES, "P copy inside the LDS control area");
__device__ __forceinline__ unsigned long long lds_u64_uniform(const volatile LAS unsigned long long* s, int i) {
    const unsigned long long v = s[i];
    return ((unsigned long long)(unsigned)__builtin_amdgcn_readfirstlane((int)(unsigned)(v >> 32)) << 32) | (unsigned long long)(unsigned)__builtin_amdgcn_readfirstlane((int)(unsigned)v);
}
__device__ __forceinline__ P load_P(LAS unsigned char* lds) {
    const volatile LAS unsigned long long* s = (const volatile LAS unsigned long long*)(lds + P_OFF);
    P q;
    q.x = (const float*)(const GAS float*)lds_u64_uniform(s, 0); q.meta = (const float*)(const GAS float*)lds_u64_uniform(s, 1); q.g1 = (const float*)(const GAS float*)lds_u64_uniform(s, 2); q.w_in = (const float*)(const GAS float*)lds_u64_uniform(s, 3);
    q.b_f = (const float*)(const GAS float*)lds_u64_uniform(s, 4); q.w2 = (const float*)(const GAS float*)lds_u64_uniform(s, 5); q.bg = (const float*)(const GAS float*)lds_u64_uniform(s, 6); q.gla_g = (const float*)(const GAS float*)lds_u64_uniform(s, 7);
    q.fox_g = (const float*)(const GAS float*)lds_u64_uniform(s, 8); q.w_out = (const float*)(const GAS float*)lds_u64_uniform(s, 9); q.g2 = (const float*)(const GAS float*)lds_u64_uniform(s, 10); q.w_rg = (const float*)(const GAS float*)lds_u64_uniform(s, 11);
    q.b_rg = (const float*)(const GAS float*)lds_u64_uniform(s, 12); q.w_re = (const float*)(const GAS float*)lds_u64_uniform(s, 13); q.b_re = (const float*)(const GAS float*)lds_u64_uniform(s, 14); q.wg = (const float*)(const GAS float*)lds_u64_uniform(s, 15);
    q.wu = (const float*)(const GAS float*)lds_u64_uniform(s, 16); q.wd = (const float*)(const GAS float*)lds_u64_uniform(s, 17); q.gf = (const float*)(const GAS float*)lds_u64_uniform(s, 18); q.out = (float*)(GAS float*)lds_u64_uniform(s, 19);
    q.ws = (unsigned char*)(GAS unsigned char*)lds_u64_uniform(s, 20);
    return q;
}
__global__ void __launch_bounds__(512, 2) k_mega(P p) {
    extern __shared__ __attribute__((aligned(16))) unsigned char lds_raw[];
    LAS unsigned char* lds = (LAS unsigned char*)lds_raw;
    for (int u = threadIdx.x; u < (LDS_BYTES - LDSCTL_OFF) / 4; u += 512) ((LAS unsigned*)(lds + LDSCTL_OFF))[u] = 0u;
    __syncthreads();
    if (threadIdx.x == 0) { LAS unsigned long long* s = (LAS unsigned long long*)(lds + P_OFF);
        s[0] = (unsigned long long)p.x; s[1] = (unsigned long long)p.meta; s[2] = (unsigned long long)p.g1; s[3] = (unsigned long long)p.w_in; s[4] = (unsigned long long)p.b_f;
        s[5] = (unsigned long long)p.w2; s[6] = (unsigned long long)p.bg; s[7] = (unsigned long long)p.gla_g; s[8] = (unsigned long long)p.fox_g; s[9] = (unsigned long long)p.w_out;
        s[10] = (unsigned long long)p.g2; s[11] = (unsigned long long)p.w_rg; s[12] = (unsigned long long)p.b_rg; s[13] = (unsigned long long)p.w_re; s[14] = (unsigned long long)p.b_re;
        s[15] = (unsigned long long)p.wg; s[16] = (unsigned long long)p.wu; s[17] = (unsigned long long)p.wd; s[18] = (unsigned long long)p.gf; s[19] = (unsigned long long)p.out;
        s[20] = (unsigned long long)p.ws; }
    if (threadIdx.x == 0) ((LAS int*)(lds + P_OFF))[48] = (int)gridDim.x;
    (void)xcd_barrier_post((unsigned*)(p.ws + OFF_CTL) + CW_BAR, (volatile LAS unsigned*)(lds + MISC_OFF) + 8);
    __syncthreads();
#define LOAD_G() __builtin_amdgcn_readfirstlane(((const volatile LAS int*)(lds + P_OFF))[48])
#define BARRIER() do { XcdBarrier b_; b_.bar = (unsigned*)((unsigned char*)(GAS unsigned char*)lds_u64_uniform((const volatile LAS unsigned long long*)(lds + P_OFF), 20) + OFF_CTL) + CW_BAR; b_.x = xb_xcc_id(); \
        b_.st = (volatile LAS unsigned*)(lds + MISC_OFF) + 8; xcd_barrier(b_); } while (0)
#define DUPVAL() ((int)__builtin_amdgcn_readfirstlane(((const volatile unsigned*)((unsigned char*)(GAS unsigned char*)lds_u64_uniform((const volatile LAS unsigned long long*)(lds + P_OFF), 20) + OFF_CTL))[64]))
#define RUN(k, body) do { { const P q = load_P(lds); const int G = LOAD_G(), bid = blockIdx.x; body; } BARRIER(); \
        if (DUP_PHASE < 0 || DUP_PHASE == (k)) { if (DUP_PHASE == (k) || DUPVAL() == (k)) { { const P q = load_P(lds); const int G = LOAD_G(), bid = blockIdx.x; body; } BARRIER(); } } } while (0)
    RUN(1, phase_prep(q, lds, bid, G));
    RUN(2, phase_inproj(q, lds, G, bid));
    RUN(3, { phase_cscan(q, lds_raw, G, bid); phase_norms(q, lds_raw, G, bid); phase_gla_p1(q, lds_raw, G, bid); });
    RUN(5, { phase_gla_scan(q, G, bid); phase_fox(q, lds_raw, G, bid); });
    RUN(9, phase_gla_p3(q, lds_raw, G, bid));
    RUN(6, phase_outproj(q, lds, G, bid));
    RUN(100, phase_router(q, lds_raw, G, bid));
    RUN(7, phase_moe<0>(q, lds, G, bid));
    RUN(8, phase_moe<1>(q, lds, G, bid));
    RUN(10, phase_moe<2>(q, lds, G, bid));
#undef RUN
    { const P q = load_P(lds); const int G = LOAD_G(), bid = blockIdx.x; phase_final(q, G, bid); }
}

extern "C" void kernel_launch(void* const* d_in, const int* in_sizes, int n_in, void* d_out, int out_size, void* d_ws, size_t ws_size, hipStream_t stream) {
    static int grid = 0;
    if (grid == 0) {
        if (n_in != 19 || ws_size < WS_END2) { fprintf(stderr, "kernel_launch: bad args n_in=%d ws=%zu need %zu\n", n_in, ws_size, (size_t)WS_END2); grid = -1; return; }
        int dev = 0, cus = 0, per_cu = 0;
        if (hipGetDevice(&dev) != hipSuccess || hipDeviceGetAttribute(&cus, hipDeviceAttributeMultiprocessorCount, dev) != hipSuccess || cus <= 0) { fprintf(stderr, "kernel_launch: device query failed\n"); grid = -1; return; }
        if (hipFuncSetAttribute((const void*)k_mega, hipFuncAttributeMaxDynamicSharedMemorySize, LDS_BYTES) != hipSuccess) { fprintf(stderr, "kernel_launch: hipFuncSetAttribute failed\n"); grid = -1; return; }
        if (hipOccupancyMaxActiveBlocksPerMultiprocessor(&per_cu, (const void*)k_mega, 512, LDS_BYTES) != hipSuccess || per_cu < 1) { fprintf(stderr, "kernel_launch: occupancy query says %d blocks per CU\n", per_cu); (void)hipGetLastError(); grid = -1; return; }
        grid = cus;
    }
    if (grid < 0) return;
    P p{};
    p.x = (const float*)d_in[0]; p.meta = (const float*)d_in[1]; p.g1 = (const float*)d_in[2]; p.w_in = (const float*)d_in[3]; p.b_f = (const float*)d_in[4];
    p.w2 = (const float*)d_in[5]; p.bg = (const float*)d_in[6]; p.gla_g = (const float*)d_in[7]; p.fox_g = (const float*)d_in[8]; p.w_out = (const float*)d_in[9];
    p.g2 = (const float*)d_in[10]; p.w_rg = (const float*)d_in[11]; p.b_rg = (const float*)d_in[12]; p.w_re = (const float*)d_in[13]; p.b_re = (const float*)d_in[14];
    p.wg = (const float*)d_in[15]; p.wu = (const float*)d_in[16]; p.wd = (const float*)d_in[17]; p.gf = (const float*)d_in[18];
    p.out = (float*)d_out; p.ws = (unsigned char*)d_ws;
    (void)hipMemsetAsync((char*)d_ws + OFF_CTL, 0, CTL_ZERO_BYTES, stream);
    if (DUP_PHASE < 0) (void)hipMemsetAsync((char*)d_ws + OFF_CTL + 256, -DUP_PHASE - 1, 1, stream);
    hipLaunchKernelGGL(k_mega, dim3(grid), dim3(512), LDS_BYTES, stream, p);
}
```

```cpp
#include <hip/hip_runtime.h>
#include <stdint.h>
#include <cstdio>
#ifndef FOX_SKIP
#define FOX_SKIP 1
#endif
#ifndef DUP_PHASE
#define DUP_PHASE 0
#endif

typedef unsigned short bf16_t;
#define DM 2048
#define SEQ 8192
#define NMETA 16
#define LR 8256
#define NR_A0 8448
#define NPROJ 6168
#define EPS 1e-6f
#define SCALE128 0.08838834764831845f

__device__ __forceinline__ float bf2f(bf16_t b) { return __uint_as_float(((unsigned)b) << 16); }
__device__ __forceinline__ bf16_t f2bf(float f) { unsigned u = __float_as_uint(f); return (bf16_t)((u + 0x7fffu + ((u >> 16) & 1u)) >> 16); }
__device__ __forceinline__ unsigned pk2(float lo, float hi) { return (unsigned)f2bf(lo) | ((unsigned)f2bf(hi) << 16); }
template <int M> __device__ __forceinline__ float sw_xor(float v) { return __int_as_float(__builtin_amdgcn_ds_swizzle(__float_as_int(v), (M << 10) | 0x1f)); }
__device__ __forceinline__ float x32_sum(float v) { auto r = __builtin_amdgcn_permlane32_swap(__float_as_uint(v), __float_as_uint(v), false, false); return __uint_as_float(r[0]) + __uint_as_float(r[1]); }
__device__ __forceinline__ float x32_max(float v) { auto r = __builtin_amdgcn_permlane32_swap(__float_as_uint(v), __float_as_uint(v), false, false); return fmaxf(__uint_as_float(r[0]), __uint_as_float(r[1])); }
__device__ __forceinline__ float wave_sum(float v) { v += sw_xor<1>(v); v += sw_xor<2>(v); v += sw_xor<4>(v); v += sw_xor<8>(v); v += sw_xor<16>(v); return x32_sum(v); }
__device__ __forceinline__ float wave_max(float v) { v = fmaxf(v, sw_xor<1>(v)); v = fmaxf(v, sw_xor<2>(v)); v = fmaxf(v, sw_xor<4>(v)); v = fmaxf(v, sw_xor<8>(v)); v = fmaxf(v, sw_xor<16>(v)); return x32_max(v); }
__device__ __forceinline__ float shfl_from(float v, int srclane) { return __int_as_float(__builtin_amdgcn_ds_bpermute(srclane << 2, __float_as_int(v))); }
__device__ __forceinline__ int shfl_from_i(int v, int srclane) { return __builtin_amdgcn_ds_bpermute(srclane << 2, v); }
__device__ __forceinline__ float fexp(float x) { return __builtin_amdgcn_exp2f(x * 1.4426950408889634f); }
__device__ __forceinline__ float logsigmoidf(float x) { return fminf(x, 0.f) - 0.6931471805599453f * __builtin_amdgcn_logf(1.f + fexp(-fabsf(x))); }
__device__ __forceinline__ float siluf(float x) { return x * __builtin_amdgcn_rcpf(1.f + fexp(-x)); }

constexpr size_t MiB = 1u << 20;
constexpr size_t OFF_CTL = 0;
constexpr size_t OFF_A0 = 1 * MiB;
constexpr size_t OFF_FQ = OFF_A0 + (size_t)NR_A0 * DM * 2;
constexpr size_t OFF_FK = OFF_FQ + (size_t)8 * SEQ * 128 * 2;
constexpr size_t OFF_FV = OFF_FK + (size_t)8 * LR * 128 * 2;
constexpr size_t OFF_FLOG = OFF_FV + (size_t)8 * LR * 128 * 2;
constexpr size_t OFF_CB = OFF_FLOG + (size_t)8 * LR * 4;
constexpr size_t OFF_GQ = OFF_CB + (size_t)8 * LR * 4;
constexpr size_t OFF_GK = OFF_GQ + (size_t)4 * LR * 128 * 2;
constexpr size_t OFF_GV = OFF_GK + (size_t)4 * LR * 128 * 2;
constexpr size_t OFF_GR = OFF_GV + (size_t)4 * LR * 256 * 2;
constexpr size_t OFF_GZ = OFF_GR + (size_t)SEQ * 1024 * 2;
constexpr size_t OFF_GLAO = OFF_GZ + (size_t)LR * 16 * 4;
constexpr size_t OFF_MIX = OFF_GLAO + (size_t)SEQ * 1024 * 4;
constexpr size_t OFF_U2 = OFF_GV;
constexpr size_t OFF_INVMAP = OFF_MIX + (size_t)SEQ * DM * 2;
constexpr size_t OFF_WTS = OFF_INVMAP + (size_t)32 * SEQ * 4;
constexpr size_t OFF_HBUF = OFF_GLAO;
constexpr size_t OFF_Y = OFF_A0;
constexpr size_t WS_END = OFF_WTS + (size_t)SEQ * 2 * 4;
static_assert(OFF_Y + (size_t)2 * SEQ * DM * 2 <= OFF_FV && OFF_HBUF + (size_t)24576 * 512 * 2 <= OFF_MIX && OFF_U2 + (size_t)SEQ * DM * 2 <= OFF_GZ, "overlays");

struct P {
    const float *x, *meta, *g1, *w_in, *b_f, *w2, *bg, *gla_g, *fox_g, *w_out, *g2, *w_rg, *b_rg, *w_re, *b_re, *wg, *wu, *wd, *gf;
    float* out; unsigned char* ws;
};

#define LAS __attribute__((address_space(3)))
#define GAS __attribute__((address_space(1)))
typedef short bf16x8 __attribute__((ext_vector_type(8)));
typedef short v4i16_t __attribute__((ext_vector_type(4)));
typedef float f32x4 __attribute__((ext_vector_type(4)));
typedef float f32x2 __attribute__((ext_vector_type(2)));
typedef unsigned u32x4 __attribute__((ext_vector_type(4)));
typedef unsigned u32x2 __attribute__((ext_vector_type(2)));
typedef __bf16 bf16x2_t __attribute__((ext_vector_type(2)));
template <class T> __device__ __forceinline__ T nt_load(const T* p) { return __builtin_nontemporal_load(p); }
template <class T> __device__ __forceinline__ void nt_store(T v, T* p) { __builtin_nontemporal_store(v, p); }
__device__ __forceinline__ unsigned cvtpk(float lo, float hi) { f32x2 v = {lo, hi}; bf16x2_t b = __builtin_convertvector(v, bf16x2_t); return __builtin_bit_cast(unsigned, b); }
constexpr int NWAVES = 8;
constexpr int RING_BYTES = 131072, LDSCTL_OFF = RING_BYTES, MISC_OFF = LDSCTL_OFF + 320, LDS_BYTES = 147456;

constexpr size_t OFF_WINT = WS_END;
constexpr size_t OFF_WOUTT = OFF_WINT + (size_t)6176 * DM * 2;
constexpr size_t OFF_WG16 = OFF_WOUTT + (size_t)DM * DM * 2;
constexpr size_t OFF_WU16 = OFF_WG16 + (size_t)32 * DM * 512 * 2;
constexpr size_t OFF_WD16 = OFF_WU16 + (size_t)32 * DM * 512 * 2;
constexpr size_t OFF_DT = OFF_WD16;
constexpr size_t OFF_BBUF = OFF_DT + (size_t)32 * DM * 512 * 2;
constexpr size_t OFF_CDUMMY = OFF_BBUF + (size_t)128 * 4 * 64 * 128 * 4;
constexpr size_t WS_END2 = OFF_CDUMMY + 8192;

namespace pg8 {
constexpr int BM = 256, BK = 64, HALF = 128, HTB = HALF * BK * 2, STAGE_BYTES = 8 * HTB, NXCD = 8, WGM = 8;
__host__ __device__ __forceinline__ int lds_byte(int r, int c) { const int st = (r >> 4) * 2 + (c >> 5), rr = r & 15, cc = c & 31, ob = rr * 64 + cc * 2; return st * 1024 + (ob ^ (((ob >> 9) & 1) << 5)); }
__host__ __device__ __forceinline__ void stage_rc(int b, int& R, int& C) { const int st = b / 1024, sb = b % 1024, swz = sb ^ (((sb >> 9) & 1) << 5); R = (st >> 1) * 16 + swz / 64; C = (st & 1) * 32 + (swz % 64) / 2; }
__host__ __device__ __forceinline__ int perm32(int rho) { const int n = rho >> 4, i = rho & 15; return 8 * (i >> 2) + 4 * n + (i & 3); }

struct Unit { int pm, pn; const char* A; const char* B; int e, rt, ce, hoff, nv; unsigned ldb, bhs; };

struct DenseSched {
    int nM, nN, nwg, G, c, K; const char* A; const char* Bt;
    __device__ void init(int M, int N, int K_, int G_, int c_, const void* A_, const void* Bt_) { nM = M / BM; nN = N / BM; nwg = nM * nN; G = G_; c = c_; K = K_; A = (const char*)A_; Bt = (const char*)Bt_; }
    __device__ bool next(int i, Unit& u) const {
        const long L = (long)i * G + c; if (L >= nwg) return false;
        int wgid = (int)L; { const int q = nwg / NXCD, r = nwg % NXCD, xcd = wgid % NXCD, off = wgid / NXCD; wgid = (xcd < r ? xcd * (q + 1) : r * (q + 1) + (xcd - r) * q) + off; }
        const int nig = WGM * nN, gid = wgid / nig, fm = gid * WGM, gsz = (nM - fm) < WGM ? (nM - fm) : WGM;
        u.pm = fm + ((wgid % nig) % gsz); u.pn = (wgid % nig) / gsz;
        u.A = A + (size_t)u.pm * BM * K * 2; u.B = Bt + (size_t)u.pn * BM * K * 2; u.e = 0; u.rt = 0; u.ce = 0; u.hoff = 0; u.nv = BM; u.ldb = 0; u.bhs = 0; return true;
    }
    __device__ __forceinline__ unsigned arow_off(const Unit&, int R) const { return (unsigned)(R * K * 2); }
};
struct OneUnitSched {
    Unit u; const int* idx; int shift; unsigned rowbytes; int rowadd;
    __device__ bool next(int i, Unit& o) const { if (i != 0) return false; o = u; return true; }
    __device__ __forceinline__ unsigned arow_off(const Unit& uu, int R) const {
        const int pos = uu.rt * BM + R; int row = 0;
        if (pos < uu.ce) row = idx ? (idx[pos] >> shift) : pos;
        return (unsigned)(row + rowadd) * rowbytes;
    }
};

struct CastArgs { const char* s0; const char* s1; const char* s2; char* d; char* dummy; };
template <class Epi, class Sched, bool ALIGN_EPI, bool SP2, bool ROWSKIP = false, bool BNAT = false, bool CAST = false>
__device__ __forceinline__ void gemm_phase(LAS unsigned char* lds, const int K, const Sched& S, const Epi& E, const CastArgs* CA = nullptr) {
    int tid = threadIdx.x; asm volatile("" : "+v"(tid));
    const int wid = __builtin_amdgcn_readfirstlane(tid >> 6), lane = tid & 63, wr = wid >> 2, wc = wid & 3, fr = lane & 15, fq = lane >> 4;
    const int nt = K / BK;
    Unit cur, nxt; int ui = 0;
    if (!S.next(0, cur)) return;
    unsigned voffA[2][2], voffB[2];
#pragma unroll
    for (int i = 0; i < 2; ++i) { int R, C; stage_rc(tid * 16 + i * 8192, R, C); const int Rb = Epi::PERM ? ((R & ~31) + perm32(R & 31)) : R;
        voffA[0][i] = S.arow_off(cur, R) + (unsigned)(C * 2); voffA[1][i] = S.arow_off(cur, HALF + R) + (unsigned)(C * 2); voffB[i] = (unsigned)(Rb * K + C) * 2u;
        if constexpr (BNAT) {
            const int b_ = tid * 16 + i * 8192, k_ = b_ >> 8, p_ = (b_ >> 4) & 15;
            voffB[i] = (unsigned)k_ * cur.ldb + (unsigned)((p_ ^ ((k_ & 3) << 2)) * 16); } }
    const size_t kstep = (size_t)(BK * 2);
    const size_t hstep = (size_t)HALF * K * 2;
    const size_t kstepB = BNAT ? (size_t)BK * cur.ldb : kstep, hstepB = BNAT ? (size_t)cur.bhs : hstep;
    const int boffT = (8 * fq + ((lane >> 2) & 3)) * 256 + ((4 * (wc ^ ((lane >> 2) & 3)) + (lane & 3)) << 4);
    const unsigned ldsw = (unsigned)wid * 1024u;
    const int aoff = lds_byte(wr * 64 + fr, fq * 8), boff = lds_byte(wc * 32 + fr, fq * 8);
#define PG8_SA(b, h) (((b) * 2 + (h)) * HTB)
#define PG8_SB(b, h) ((4 + (b) * 2 + (h)) * HTB)
#define PG8_STAGE(bufoff, gbase, voff) do { _Pragma("unroll") for (int _i = 0; _i < 2; ++_i) \
        __builtin_amdgcn_global_load_lds((const unsigned*)((const char*)(gbase) + (voff)[_i]), (LAS unsigned*)(lds + (bufoff) + ldsw + _i * 8192), 16, 0, 0); } while (0)
#define PG8_LDA(dst, b, h) do { _Pragma("unroll") for (int m = 0; m < 4; ++m) _Pragma("unroll") for (int k = 0; k < 2; ++k) dst[m][k] = *(const LAS bf16x8*)(lds + PG8_SA(b, h) + aoff + m * 2048 + k * 1024); } while (0)
#define PG8_TR(off_) __builtin_amdgcn_ds_read_tr16_b64_v4i16((LAS v4i16_t*)(lds + (off_)))
#define PG8_LDB(dst, b, h) do { _Pragma("unroll") for (int n = 0; n < 2; ++n) _Pragma("unroll") for (int k = 0; k < 2; ++k) { \
        if constexpr (BNAT) { const v4i16_t lo_ = PG8_TR(PG8_SB(b, h) + boffT + k * 8192 + n * 8), hi_ = PG8_TR(PG8_SB(b, h) + boffT + k * 8192 + 1024 + n * 8); \
                              dst[n][k] = (bf16x8){lo_[0], lo_[1], lo_[2], lo_[3], hi_[0], hi_[1], hi_[2], hi_[3]}; } \
        else dst[n][k] = *(const LAS bf16x8*)(lds + PG8_SB(b, h) + boff + n * 2048 + k * 1024); } } while (0)
#define PG8_MMA(ai, bj, At, Bt) do { __builtin_amdgcn_s_setprio(1); \
        if constexpr (!ROWSKIP) { _Pragma("unroll") for (int k = 0; k < 2; ++k) _Pragma("unroll") for (int m = 0; m < 4; ++m) _Pragma("unroll") for (int n = 0; n < 2; ++n) \
            acc[ai][bj][m][n] = __builtin_amdgcn_mfma_f32_16x16x32_bf16(Bt[n][k], At[m][k], acc[ai][bj][m][n], 0, 0, 0); } \
        else { _Pragma("unroll") for (int m = 0; m < 4; ++m) { if (m < mm[ai]) { _Pragma("unroll") for (int k = 0; k < 2; ++k) _Pragma("unroll") for (int n = 0; n < 2; ++n) \
            acc[ai][bj][m][n] = __builtin_amdgcn_mfma_f32_16x16x32_bf16(Bt[n][k], At[m][k], acc[ai][bj][m][n], 0, 0, 0); } } } __builtin_amdgcn_s_setprio(0); } while (0)
#define PG8_WAIT_V(n) asm volatile("s_waitcnt vmcnt(" #n ")" ::: "memory")
#define PG8_WAIT_VC(reg) do { if constexpr (CAST) asm volatile("s_waitcnt vmcnt(12)" : "+v"(reg) :: "memory"); else PG8_WAIT_V(8); } while (0)
#define PG8_WAIT_L(n) asm volatile("s_waitcnt lgkmcnt(" #n ")" ::: "memory")
#define PG8_BAR __builtin_amdgcn_s_barrier()
#define PG8_SCHED __builtin_amdgcn_sched_barrier(0)
    f32x4 acc[2][2][4][2];
#pragma unroll
    for (int a = 0; a < 2; ++a)
#pragma unroll
        for (int b = 0; b < 2; ++b)
#pragma unroll
            for (int m = 0; m < 4; ++m)
#pragma unroll
                for (int n = 0; n < 2; ++n) acc[a][b][m][n] = (f32x4){0.f, 0.f, 0.f, 0.f};
    bf16x8 At[4][2], B0[2][2], B1[2][2];
    const char* cA = cur.A; const char* cB = cur.B;
    int mm[2];
#define PG8_SETMM(u_) do { _Pragma("unroll") for (int a_ = 0; a_ < 2; ++a_) { int v_ = ((u_).nv - a_ * HALF - wr * 64 + 15) >> 4; mm[a_] = v_ < 0 ? 0 : (v_ > 4 ? 4 : v_); } } while (0)
    PG8_SETMM(cur);
    f32x4 cv0 = (f32x4){0.f, 0.f, 0.f, 0.f}, cv1 = cv0, cv2 = cv0, cv3 = cv0;
    const char* csrc = nullptr; char* cdst = nullptr; char* pdst = nullptr; const char* cs0 = nullptr; const char* cs1 = nullptr; const char* cs2 = nullptr; char* cd0 = nullptr;
    const unsigned ctl = (unsigned)tid * 16u;
#define PG8_CUNIT(ui_) do { if constexpr (CAST) { const int L_ = (ui_) * S.G + S.c; const char* fb_ = L_ < 256 ? cs0 : (L_ < 512 ? cs1 : cs2); \
        csrc = fb_ + (size_t)(L_ & 255) * (64 * 8192); pdst = cdst; cdst = cd0 + (size_t)L_ * (64 * 4096); } } while (0)
#define PG8_CLD(reg, r_) do { if constexpr (CAST) { const GAS char* b_ = (const GAS char*)(csrc + (size_t)(r_) * 8192); \
        asm volatile("global_load_dwordx4 %0, %1, %2 nt" : "=&v"(reg) : "v"(ctl), "s"(b_) : "memory"); } } while (0)
#define PG8_CSTA(reg, addr_) do { unsigned o_; asm volatile("v_lshrrev_b32 %0, 1, %1" : "=v"(o_) : "v"(ctl)); GAS char* sb_ = (GAS char*)(addr_); \
        const u32x2 pk_ = (u32x2){cvtpk(reg[0], reg[1]), cvtpk(reg[2], reg[3])}; asm volatile("global_store_dwordx2 %0, %1, %2 nt" :: "v"(o_), "v"(pk_), "s"(sb_) : "memory"); } while (0)
#define PG8_CST_LO(reg, t_, ph_) do { if constexpr (CAST) { char* da_ = (t_) > 0 ? cdst + (size_t)(2 * (t_) + (ph_) - 2) * 4096 : pdst + (size_t)(62 + (ph_)) * 4096; PG8_CSTA(reg, da_); } } while (0)
#define PG8_CST_HI(reg, t_, ph_) do { if constexpr (CAST) { PG8_CSTA(reg, cdst + (size_t)(2 * (t_) + (ph_) - 2) * 4096); } } while (0)
    if constexpr (CAST) {
        cs0 = CA->s0; cs1 = CA->s1; cs2 = CA->s2; cd0 = CA->d;
        asm volatile("" : "+s"(cs0), "+s"(cs1), "+s"(cs2), "+s"(cd0));
        cdst = CA->dummy - (size_t)62 * 4096;
        PG8_CUNIT(0);
    }
    if constexpr (SP2) {
        PG8_STAGE(PG8_SB(0, 0), cB, voffB); PG8_STAGE(PG8_SB(0, 1), cB + hstepB, voffB); PG8_STAGE(PG8_SA(0, 0), cA, voffA[0]); PG8_STAGE(PG8_SA(0, 1), cA, voffA[1]);
        if (wr == 1) PG8_BAR;
        PG8_WAIT_V(2); PG8_BAR;
        PG8_STAGE(PG8_SB(1, 0), cB + kstepB, voffB); PG8_STAGE(PG8_SA(1, 0), cA + kstep, voffA[0]); PG8_STAGE(PG8_SB(1, 1), cB + hstepB + kstepB, voffB);
        PG8_WAIT_V(6); PG8_BAR;
        if constexpr (CAST) { PG8_CSTA(cv0, pdst + (size_t)62 * 4096); }
    } else {
        PG8_STAGE(PG8_SB(0, 0), cB, voffB); PG8_STAGE(PG8_SA(0, 0), cA, voffA[0]); PG8_STAGE(PG8_SB(0, 1), cB + hstepB, voffB); PG8_STAGE(PG8_SA(0, 1), cA, voffA[1]);
        if (wr == 1) PG8_BAR;
        PG8_WAIT_V(4); PG8_BAR;
        PG8_STAGE(PG8_SB(1, 0), cB + kstepB, voffB); PG8_STAGE(PG8_SA(1, 0), cA + kstep, voffA[0]); PG8_STAGE(PG8_SB(1, 1), cB + hstepB + kstepB, voffB);
        PG8_WAIT_V(6); PG8_BAR;
    }
    for (;;) {
        const bool has_next = S.next(ui + 1, nxt);
        const char* nA = has_next ? nxt.A : cA; const char* nB = has_next ? nxt.B : cB;
        for (int t = 0; t < nt; t += 2) {
            const bool last = (t == nt - 2);
            const char* a1 = cA + (size_t)(t + 1) * kstep;
            const char* a2 = last ? nA : cA + (size_t)(t + 2) * kstep; const char* b2 = last ? nB : cB + (size_t)(t + 2) * kstepB;
            const char* a3 = a2 + kstep; const char* b3 = b2 + kstepB;
            if constexpr (SP2) {
            PG8_LDB(B0, 0, 0); PG8_LDB(B1, 0, 1); PG8_SCHED; PG8_LDA(At, 0, 0); PG8_STAGE(PG8_SA(1, 1), a1, voffA[1]); PG8_CLD(cv0, 2 * t + 0);
            PG8_WAIT_VC(cv2); PG8_WAIT_L(0); PG8_BAR; PG8_CST_LO(cv2, t, 0); PG8_MMA(0, 0, At, B0); PG8_MMA(0, 1, At, B1); PG8_BAR; PG8_SCHED;
            PG8_LDA(At, 0, 1); PG8_STAGE(PG8_SB(0, 0), b2, voffB); PG8_STAGE(PG8_SB(0, 1), b2 + hstepB, voffB); PG8_STAGE(PG8_SA(0, 0), a2, voffA[0]); PG8_CLD(cv1, 2 * t + 1);
            PG8_WAIT_VC(cv3); PG8_WAIT_L(0); PG8_BAR; PG8_CST_LO(cv3, t, 1); PG8_MMA(1, 0, At, B0); PG8_MMA(1, 1, At, B1); PG8_BAR; PG8_SCHED;
            PG8_LDB(B0, 1, 0); PG8_LDB(B1, 1, 1); PG8_SCHED; PG8_LDA(At, 1, 0); PG8_STAGE(PG8_SA(0, 1), a2, voffA[1]); PG8_CLD(cv2, 2 * t + 2);
            PG8_WAIT_VC(cv0); PG8_WAIT_L(0); PG8_BAR; PG8_CST_HI(cv0, t, 2); PG8_MMA(0, 0, At, B0); PG8_MMA(0, 1, At, B1); PG8_BAR; PG8_SCHED;
            PG8_LDA(At, 1, 1); PG8_STAGE(PG8_SB(1, 0), b3, voffB); PG8_STAGE(PG8_SB(1, 1), b3 + hstepB, voffB); PG8_STAGE(PG8_SA(1, 0), a3, voffA[0]); PG8_CLD(cv3, 2 * t + 3);
            PG8_WAIT_VC(cv1); PG8_WAIT_L(0); PG8_BAR; PG8_CST_HI(cv1, t, 3); PG8_MMA(1, 0, At, B0); PG8_MMA(1, 1, At, B1); PG8_BAR; PG8_SCHED;
            } else {
            PG8_LDB(B0, 0, 0); PG8_SCHED; PG8_LDA(At, 0, 0); PG8_STAGE(PG8_SA(1, 1), a1, voffA[1]);
            PG8_WAIT_L(8); PG8_BAR; PG8_WAIT_L(0); PG8_MMA(0, 0, At, B0); PG8_BAR; PG8_SCHED;
            PG8_LDB(B1, 0, 1); PG8_STAGE(PG8_SB(0, 0), b2, voffB);
            PG8_BAR; PG8_WAIT_L(0); PG8_MMA(0, 1, At, B1); PG8_BAR;
            PG8_LDA(At, 0, 1); PG8_STAGE(PG8_SA(0, 0), a2, voffA[0]);
            PG8_BAR; PG8_WAIT_L(0); PG8_MMA(1, 0, At, B0); PG8_BAR; PG8_SCHED;
            PG8_STAGE(PG8_SB(0, 1), b2 + hstepB, voffB);
            PG8_WAIT_V(6); PG8_BAR; PG8_MMA(1, 1, At, B1); PG8_BAR;
            PG8_LDB(B0, 1, 0); PG8_SCHED; PG8_LDA(At, 1, 0); PG8_STAGE(PG8_SA(0, 1), a2, voffA[1]);
            PG8_WAIT_L(8); PG8_BAR; PG8_WAIT_L(0); PG8_MMA(0, 0, At, B0); PG8_BAR; PG8_SCHED;
            PG8_LDB(B1, 1, 1); PG8_STAGE(PG8_SB(1, 0), b3, voffB);
            PG8_BAR; PG8_WAIT_L(0); PG8_MMA(0, 1, At, B1); PG8_BAR;
            PG8_LDA(At, 1, 1); PG8_STAGE(PG8_SA(1, 0), a3, voffA[0]);
            PG8_BAR; PG8_WAIT_L(0); PG8_MMA(1, 0, At, B0); PG8_BAR; PG8_SCHED;
            PG8_STAGE(PG8_SB(1, 1), b3 + hstepB, voffB);
            PG8_WAIT_V(6); PG8_BAR; PG8_MMA(1, 1, At, B1); PG8_BAR;
            }
        }
        if constexpr (ALIGN_EPI) { if (wr == 0) PG8_BAR; }
        E(acc, cur, wr, wc, fr, fq);
        if (!has_next) break;
#pragma unroll
        for (int a = 0; a < 2; ++a)
#pragma unroll
            for (int b = 0; b < 2; ++b)
#pragma unroll
                for (int m = 0; m < 4; ++m)
#pragma unroll
                    for (int n = 0; n < 2; ++n) acc[a][b][m][n] = (f32x4){0.f, 0.f, 0.f, 0.f};
        cur = nxt; cA = nA; cB = nB; ++ui; PG8_SETMM(cur); PG8_CUNIT(ui);
        if constexpr (ALIGN_EPI) { if (wr == 1) PG8_BAR; }
    }
    if constexpr (CAST) { asm volatile("s_waitcnt vmcnt(0)" : "+v"(cv2), "+v"(cv3) :: "memory"); PG8_CSTA(cv2, cdst + (size_t)62 * 4096); PG8_CSTA(cv3, cdst + (size_t)63 * 4096); }
    PG8_WAIT_V(0);
    if constexpr (!ALIGN_EPI) { if (wr == 0) PG8_BAR; }
    PG8_BAR;
#undef PG8_CUNIT
#undef PG8_CLD
#undef PG8_CSTA
#undef PG8_CST_LO
#undef PG8_CST_HI
#undef PG8_WAIT_VC
#undef PG8_SETMM
#undef PG8_SA
#undef PG8_SB
#undef PG8_STAGE
#undef PG8_LDA
#undef PG8_LDB
#undef PG8_TR
#undef PG8_MMA
#undef PG8_WAIT_V
#undef PG8_WAIT_L
#undef PG8_BAR
#undef PG8_SCHED
}
}

__device__ __forceinline__ void inproj_dest(int t, size_t& off, int& stride, bool& xonly) {
    xonly = false;
    if (t < 8) { off = OFF_FQ + (size_t)t * SEQ * 256; stride = 128; xonly = true; }
    else if (t < 16) { off = OFF_FK + (size_t)(t - 8) * LR * 256; stride = 128; }
    else if (t < 24) { off = OFF_FV + (size_t)(t - 16) * LR * 256; stride = 128; }
    else if (t < 28) { off = OFF_GQ + (size_t)(t - 24) * LR * 256; stride = 128; }
    else if (t < 32) { off = OFF_GK + (size_t)(t - 28) * LR * 256; stride = 128; }
    else if (t < 40) { off = OFF_GV + (size_t)((t - 32) >> 1) * LR * 512 + (size_t)((t & 1) * 256); stride = 256; }
    else { off = OFF_GR + (size_t)(t - 40) * 256; stride = 1024; xonly = true; }
}
struct EpiInproj {
    static constexpr bool PERM = true;
    unsigned char* ws;
    __device__ __forceinline__ void operator()(const f32x4 (&acc)[2][2][4][2], const pg8::Unit& u, int wr, int wc, int fr, int fq) const {
        const int rbase = u.pm * 256 + wr * 64 + fr;
#pragma unroll
        for (int bj = 0; bj < 2; ++bj) {
            size_t off; int stride; bool xonly;
            inproj_dest(u.pn * 2 + bj, off, stride, xonly);
            bf16_t* base = (bf16_t*)(ws + off) + wc * 32 + 8 * fq + (size_t)(xonly ? 0 : 64) * stride;
#pragma unroll
            for (int ai = 0; ai < 2; ++ai)
#pragma unroll
                for (int m = 0; m < 4; ++m) {
                    const int prow = rbase + ai * 128 + m * 16;
                    const f32x4 v0 = acc[ai][bj][m][0], v1 = acc[ai][bj][m][1];
                    u32x4 w; w.x = cvtpk(v0[0], v0[1]); w.y = cvtpk(v0[2], v0[3]); w.z = cvtpk(v1[0], v1[1]); w.w = cvtpk(v1[2], v1[3]);
                    *(u32x4*)(base + (size_t)prow * stride) = w;
                }
        }
    }
};
struct EpiOutproj {
    static constexpr bool PERM = false;
    const float* x; float* out;
    __device__ __forceinline__ void operator()(const f32x4 (&acc)[2][2][4][2], const pg8::Unit& u, int wr, int wc, int fr, int fq) const {
        const int col0 = u.pn * 256 + wc * 32 + 4 * fq;
#pragma unroll
        for (int ai = 0; ai < 2; ++ai)
#pragma unroll
            for (int m = 0; m < 4; ++m) {
                const size_t off = (size_t)(u.pm * 256 + ai * 128 + wr * 64 + m * 16 + fr) * DM + col0;
#pragma unroll
                for (int bj = 0; bj < 2; ++bj)
#pragma unroll
                    for (int n = 0; n < 2; ++n) { const f32x4 xv = nt_load((const f32x4*)(x + off + bj * 128 + n * 16)); *(f32x4*)(out + off + bj * 128 + n * 16) = xv + acc[ai][bj][m][n]; }
            }
    }
};
struct EpiGateUp {
    static constexpr bool PERM = true;
    bf16_t* HB;
    __device__ __forceinline__ void operator()(const f32x4 (&acc)[2][2][4][2], const pg8::Unit& u, int wr, int wc, int fr, int fq) const {
        const int col = u.pn * 128 + wc * 32 + 8 * fq;
#pragma unroll
        for (int ai = 0; ai < 2; ++ai)
#pragma unroll
            for (int m = 0; m < 4; ++m) {
                const int pos = u.rt * 256 + ai * 128 + wr * 64 + m * 16 + fr;
                if (pos >= u.ce) continue;
                const f32x4 g0 = acc[ai][0][m][0], g1 = acc[ai][0][m][1], u0 = acc[ai][1][m][0], u1 = acc[ai][1][m][1];
                u32x4 w; w.x = cvtpk(siluf(g0[0]) * u0[0], siluf(g0[1]) * u0[1]); w.y = cvtpk(siluf(g0[2]) * u0[2], siluf(g0[3]) * u0[3]);
                w.z = cvtpk(siluf(g1[0]) * u1[0], siluf(g1[1]) * u1[1]); w.w = cvtpk(siluf(g1[2]) * u1[2], siluf(g1[3]) * u1[3]);
                *(u32x4*)(HB + (size_t)(u.hoff + pos) * 512 + col) = w;
            }
    }
};
struct EpiDown {
    static constexpr bool PERM = true;
    bf16_t* Y; const int* invmap; const float* wts;
    __device__ __forceinline__ void operator()(const f32x4 (&acc)[2][2][4][2], const pg8::Unit& u, int wr, int wc, int fr, int fq) const {
        const int col = u.pn * 256 + wc * 32 + 8 * fq;
#pragma unroll
        for (int ai = 0; ai < 2; ++ai)
#pragma unroll
            for (int m = 0; m < 4; ++m) {
                const int pos = u.rt * 256 + ai * 128 + wr * 64 + m * 16 + fr;
                if (pos >= u.ce) continue;
                const int t2 = invmap[(size_t)u.e * SEQ + pos]; const float wt = wts[t2];
                bf16_t* dst = Y + (size_t)(t2 & 1) * SEQ * DM + (size_t)(t2 >> 1) * DM + col;
#pragma unroll
                for (int bj = 0; bj < 2; ++bj) { const f32x4 v0 = acc[ai][bj][m][0] * wt, v1 = acc[ai][bj][m][1] * wt;
                    u32x4 w; w.x = cvtpk(v0[0], v0[1]); w.y = cvtpk(v0[2], v0[3]); w.z = cvtpk(v1[0], v1[1]); w.w = cvtpk(v1[2], v1[3]);
                    *(u32x4*)(dst + bj * 128) = w; }
            }
    }
};

struct TrLoad { f32x4 v[8]; };
template <class ColFn>
__device__ __forceinline__ void tr_issue(TrLoad& t, const float* W, int ldw, ColFn colfn, int k0, int lane) {
    const int kq = lane >> 3, nq = lane & 7, sc = colfn(nq);
#pragma unroll
    for (int i = 0; i < 8; ++i) t.v[i] = sc >= 0 ? nt_load((const f32x4*)(W + (size_t)(k0 + 8 * i + kq) * ldw + sc)) : (f32x4){0.f, 0.f, 0.f, 0.f};
}
__device__ __forceinline__ void tr_finish(const TrLoad& t, bf16_t* WTrow0  , int K, int k0, LAS float* scr, int lane) {
    const int kq = lane >> 3, nq = lane & 7;
#pragma unroll
    for (int i = 0; i < 8; ++i) { LAS float* d = scr + (8 * i + kq) * 33 + 4 * nq; d[0] = t.v[i][0]; d[1] = t.v[i][1]; d[2] = t.v[i][2]; d[3] = t.v[i][3]; }
    asm volatile("s_waitcnt lgkmcnt(0)" ::: "memory");
    const int c = lane & 7;
#pragma unroll
    for (int j = 0; j < 4; ++j) { const int n = (lane >> 3) + 8 * j; const LAS float* s = scr + (8 * c) * 33 + n;
        u32x4 o; o.x = cvtpk(s[0 * 33], s[1 * 33]); o.y = cvtpk(s[2 * 33], s[3 * 33]); o.z = cvtpk(s[4 * 33], s[5 * 33]); o.w = cvtpk(s[6 * 33], s[7 * 33]);
        *(u32x4*)(WTrow0 + (size_t)n * K + k0 + 8 * c) = o; }
    asm volatile("s_waitcnt lgkmcnt(0)" ::: "memory");
}
struct RowLoad { f32x4 v[8]; };
__device__ __forceinline__ void row_issue(RowLoad& r, const P& p, int row, int lane) {
    const float* src = row < SEQ ? p.x + (size_t)row * DM : p.meta + (size_t)(row - SEQ) * DM;
#pragma unroll
    for (int j = 0; j < 8; ++j) r.v[j] = nt_load((const f32x4*)src + lane + 64 * j);
}
__device__ __forceinline__ void row_finish(const RowLoad& r, const P& p, int row, int lane) {
    uint2* dst = (uint2*)((bf16_t*)(p.ws + OFF_A0) + (size_t)row * DM);
    float ss = 0.f;
#pragma unroll
    for (int j = 0; j < 8; ++j) ss += (r.v[j][0] * r.v[j][0] + r.v[j][1] * r.v[j][1]) + (r.v[j][2] * r.v[j][2] + r.v[j][3] * r.v[j][3]);
    ss = wave_sum(ss);
    const float rs = rsqrtf(ss * (1.f / DM) + EPS);
#pragma unroll
    for (int j = 0; j < 8; ++j) {
        const float4 g = ((const float4*)p.g1)[lane + 64 * j];
        dst[lane + 64 * j] = make_uint2(cvtpk(r.v[j][0] * rs * g.x, r.v[j][1] * rs * g.y), cvtpk(r.v[j][2] * rs * g.z, r.v[j][3] * rs * g.w));
    }
}
constexpr size_t EXP_NG4 = (size_t)32 * DM * 512 / 4;
__device__ __forceinline__ void cast_family(const float* src, unsigned char* dstb, size_t gt, size_t NT, size_t lo, size_t hi) {
    const f32x4* s4 = (const f32x4*)src; uint2* d2 = (uint2*)dstb;
#define CST(i_, v_) d2[i_] = make_uint2(cvtpk(v_[0], v_[1]), cvtpk(v_[2], v_[3]))
    size_t i0 = lo + gt;
    for (; i0 + 7 * NT < hi; i0 += 8 * NT) {
        const f32x4 v0 = s4[i0], v1 = s4[i0 + NT], v2 = s4[i0 + 2 * NT], v3 = s4[i0 + 3 * NT], v4 = s4[i0 + 4 * NT], v5 = s4[i0 + 5 * NT], v6 = s4[i0 + 6 * NT], v7 = s4[i0 + 7 * NT];
        CST(i0, v0); CST(i0 + NT, v1); CST(i0 + 2 * NT, v2); CST(i0 + 3 * NT, v3); CST(i0 + 4 * NT, v4); CST(i0 + 5 * NT, v5); CST(i0 + 6 * NT, v6); CST(i0 + 7 * NT, v7);
    }
    for (; i0 < hi; i0 += NT) { const f32x4 v = s4[i0]; CST(i0, v); }
#undef CST
}
__device__ __forceinline__ void phase_prep(const P& p, LAS unsigned char* lds, int vcu, int G) {
    int tid = threadIdx.x; asm volatile("" : "+v"(tid));
    const int lane = tid & 63, wave = __builtin_amdgcn_readfirstlane(tid >> 6);
    LAS float* scr = (LAS float*)(lds + wave * 16384);
    const int gw = vcu * NWAVES + wave, NGW = G * NWAVES;
    { const int gt = vcu * 512 + tid, NT = G * 512;
      bf16_t* FK = (bf16_t*)(p.ws + OFF_FK); bf16_t* FV = (bf16_t*)(p.ws + OFF_FV);
      bf16_t* GQ = (bf16_t*)(p.ws + OFF_GQ); bf16_t* GK = (bf16_t*)(p.ws + OFF_GK); bf16_t* GV = (bf16_t*)(p.ws + OFF_GV);
      float* FLOG = (float*)(p.ws + OFF_FLOG); float* GZ = (float*)(p.ws + OFF_GZ);
      for (int i = gt; i < 8 * 48 * 128; i += NT) { const int h = i / (48 * 128), r = i % (48 * 128); FK[(size_t)h * LR * 128 + r] = 0; FV[(size_t)h * LR * 128 + r] = 0;
          if (h < 4) { GQ[(size_t)h * LR * 128 + r] = 0; GK[(size_t)h * LR * 128 + r] = 0; } }
      for (int i = gt; i < 4 * 48 * 256; i += NT) { const int h = i / (48 * 256), r = i % (48 * 256); GV[(size_t)h * LR * 256 + r] = 0; }
      for (int i = gt; i < 8 * 48; i += NT) FLOG[i] = 0.f;
      for (int i = gt; i < 48 * 16; i += NT) GZ[i] = 0.f; }
    constexpr int I_IN = 193 * 32, I_OUT = 64 * 32, I_ALL = I_IN + I_OUT;
    auto issue = [&](TrLoad& t, int it, bf16_t*& dst, int& K, int& k0) {
        int r = it;
        if (r < I_IN) { const int nb = r % 193, kb = r / 193, n0 = nb * 32; K = DM; k0 = kb * 64; dst = (bf16_t*)(p.ws + OFF_WINT) + (size_t)n0 * DM;
            tr_issue(t, p.w_in, NPROJ, [&](int g) { const int n = n0 + 4 * g; if (n < 3072) return n; if (n < 6144) return n + 8; if (n < 6152) return n - 3072; if (n < 6168) return n; return -1; }, k0, lane); return; }
        r -= I_IN;
        if (r < I_OUT) { const int nb = r & 63, kb = r >> 6, n0 = nb * 32; K = DM; k0 = kb * 64; dst = (bf16_t*)(p.ws + OFF_WOUTT) + (size_t)n0 * DM;
            tr_issue(t, p.w_out, DM, [&](int g) { return n0 + 4 * g; }, k0, lane); return; }
    };
    { int r = gw, it = gw;
      while (r < SEQ + NMETA || it < I_ALL) {
        RowLoad ra, rb; TrLoad ta, tb; bf16_t* da = nullptr; bf16_t* db = nullptr; int Ka = 0, Kb = 0, k0a = 0, k0b = 0;
        const bool hr0 = r < SEQ + NMETA, hr1 = r + NGW < SEQ + NMETA, ht0 = it < I_ALL, ht1 = it + NGW < I_ALL;
        if (hr0) row_issue(ra, p, r, lane);
        if (hr1) row_issue(rb, p, r + NGW, lane);
        if (ht0) issue(ta, it, da, Ka, k0a);
        if (ht1) issue(tb, it + NGW, db, Kb, k0b);
        __builtin_amdgcn_sched_barrier(0);
        if (hr0) row_finish(ra, p, r, lane);
        if (hr1) row_finish(rb, p, r + NGW, lane);
        if (ht0) tr_finish(ta, da, Ka, k0a, scr, lane);
        if (ht1) tr_finish(tb, db, Kb, k0b, scr, lane);
        r += 2 * NGW; it += 2 * NGW;
      } }
}
__device__ __forceinline__ void phase_inproj(const P& p, LAS unsigned char* lds, int G, int bid) {
    { pg8::DenseSched S; S.init(SEQ, 6144, DM, G, bid, p.ws + OFF_A0, p.ws + OFF_WINT);
      EpiInproj E{p.ws};
      static_assert((SEQ / 256) * (6144 / 256) == 768 && DM / 64 == 32, "cast stream: 768 units x 64 phases x 512 float4 = the three expert weight families");
      const pg8::CastArgs CA{(const char*)p.wg, (const char*)p.wu, (const char*)p.wd, (char*)(p.ws + OFF_WG16), (char*)(p.ws + OFF_CDUMMY)};
      pg8::gemm_phase<EpiInproj, pg8::DenseSched, true, true, false, false, true>(lds, DM, S, E, &CA); }
    int tid = threadIdx.x; asm volatile("" : "+v"(tid));
    const int lane = tid & 63, w = __builtin_amdgcn_readfirstlane(tid >> 6), r16 = lane & 15, q = lane >> 4;
    LAS float* part = (LAS float*)lds;
    for (int j = bid; j < 192; j += G) {
        const bf16_t* Ap = (const bf16_t*)(p.ws + OFF_A0) + (size_t)(SEQ + r16) * DM + 256 * w + 8 * q;
        const bf16_t* Bp = (const bf16_t*)(p.ws + OFF_WINT) + (size_t)(32 * j + r16) * DM + 256 * w + 8 * q;
        f32x4 acc0 = (f32x4){0.f, 0.f, 0.f, 0.f}, acc1 = acc0;
#pragma unroll
        for (int ks = 0; ks < 8; ++ks) {
            const bf16x8 af = *(const bf16x8*)(Ap + 32 * ks), b0 = *(const bf16x8*)(Bp + 32 * ks), b1 = *(const bf16x8*)(Bp + (size_t)16 * DM + 32 * ks);
            acc0 = __builtin_amdgcn_mfma_f32_16x16x32_bf16(af, b0, acc0, 0, 0, 0);
            acc1 = __builtin_amdgcn_mfma_f32_16x16x32_bf16(af, b1, acc1, 0, 0, 0);
        }
#pragma unroll
        for (int i = 0; i < 4; ++i) { part[((w * 2 + 0) * 16 + 4 * q + i) * 16 + r16] = acc0[i]; part[((w * 2 + 1) * 16 + 4 * q + i) * 16 + r16] = acc1[i]; }
        __syncthreads();
        { const int m = tid >> 5, cl = tid & 31; float sum = 0.f;
#pragma unroll
          for (int ww = 0; ww < 8; ++ww) sum += part[((ww * 2 + (cl >> 4)) * 16 + m) * 16 + (cl & 15)];
          const int c = 32 * j + cl; size_t off; int stride; bool xonly;
          inproj_dest(c >> 7, off, stride, xonly);
          if (!xonly) ((bf16_t*)(p.ws + off))[(size_t)(48 + m) * stride + (c & 127)] = f2bf(sum); }
        __syncthreads();
    }
    for (int i = bid; i < 257; i += G) {
        const bf16_t* Ap = (const bf16_t*)(p.ws + OFF_A0) + (size_t)(32 * i + r16) * DM + 256 * w + 8 * q;
        const bf16_t* Bp = (const bf16_t*)(p.ws + OFF_WINT) + (size_t)(6144 + r16) * DM + 256 * w + 8 * q;
        f32x4 acc[2][2];
#pragma unroll
        for (int a_ = 0; a_ < 2; ++a_)
#pragma unroll
            for (int b_ = 0; b_ < 2; ++b_) acc[a_][b_] = (f32x4){0.f, 0.f, 0.f, 0.f};
#pragma unroll
        for (int ks = 0; ks < 8; ++ks) {
            const bf16x8 a0 = *(const bf16x8*)(Ap + 32 * ks), a1 = *(const bf16x8*)(Ap + (size_t)16 * DM + 32 * ks);
            const bf16x8 b0 = *(const bf16x8*)(Bp + 32 * ks), b1 = *(const bf16x8*)(Bp + (size_t)16 * DM + 32 * ks);
            acc[0][0] = __builtin_amdgcn_mfma_f32_16x16x32_bf16(a0, b0, acc[0][0], 0, 0, 0); acc[0][1] = __builtin_amdgcn_mfma_f32_16x16x32_bf16(a0, b1, acc[0][1], 0, 0, 0);
            acc[1][0] = __builtin_amdgcn_mfma_f32_16x16x32_bf16(a1, b0, acc[1][0], 0, 0, 0); acc[1][1] = __builtin_amdgcn_mfma_f32_16x16x32_bf16(a1, b1, acc[1][1], 0, 0, 0);
        }
#pragma unroll
        for (int a_ = 0; a_ < 2; ++a_)
#pragma unroll
            for (int b_ = 0; b_ < 2; ++b_)
#pragma unroll
                for (int ii = 0; ii < 4; ++ii) part[((w * 4 + a_ * 2 + b_) * 16 + 4 * q + ii) * 16 + r16] = acc[a_][b_][ii];
        __syncthreads();
#pragma unroll
        for (int o = 0; o < 2; ++o) { const int idx = tid + 512 * o, row = idx >> 5, col = idx & 31; float sum = 0.f;
#pragma unroll
            for (int ww = 0; ww < 8; ++ww) sum += part[((ww * 4 + (row >> 4) * 2 + (col >> 4)) * 16 + (row & 15)) * 16 + (col & 15)];
            const int prow = 32 * i + row;
            if (prow < SEQ + NMETA && col < 24) { const int lrow = prow < SEQ ? 64 + prow : 48 + (prow - SEQ);
                if (col < 8) ((float*)(p.ws + OFF_FLOG))[(size_t)lrow * 8 + col] = sum; else ((float*)(p.ws + OFF_GZ))[(size_t)lrow * 16 + (col - 8)] = sum; } }
        __syncthreads();
    }
}
__device__ __forceinline__ void phase_outproj(const P& p, LAS unsigned char* lds, int G, int bid) {
    pg8::DenseSched S; S.init(SEQ, DM, DM, G, bid, p.ws + OFF_MIX, p.ws + OFF_WOUTT);
    EpiOutproj E{p.x, p.out};
    pg8::gemm_phase<EpiOutproj, pg8::DenseSched, true, true>(lds, DM, S, E);
}
constexpr int MOE_PLAN_OFF = LDSCTL_OFF + 1024;
struct MoeLane { int e, ce, nt, nbig, nsm, hoff, ib4, is4, ib8, is8, tb4, ts4, tb8, ts8; };
__device__ __forceinline__ MoeLane moe_lane(const unsigned* cnt, int tid) {
    MoeLane m; m.e = tid & 31;
    m.ce = (int)cnt[m.e]; m.nt = (m.ce + 255) >> 8; const int lastrows = m.ce - (m.nt - 1) * 256;
    m.nbig = (m.nt > 0 && lastrows < 128) ? m.nt - 1 : m.nt; m.nsm = m.nt - m.nbig;
    int pb = m.nbig, ps = m.nsm, ph = m.nt * 256;
#pragma unroll
    for (int o = 1; o < 32; o <<= 1) { const int tb = shfl_from_i(pb, tid - o), ts = shfl_from_i(ps, tid - o), th = shfl_from_i(ph, tid - o); if (m.e >= o) { pb += tb; ps += ts; ph += th; } }
    const int totb = shfl_from_i(pb, 31), tots = shfl_from_i(ps, 31);
    m.hoff = ph - m.nt * 256; m.ib4 = pb * 4; m.is4 = ps * 4; m.ib8 = pb * 8; m.is8 = ps * 8; m.tb4 = totb * 4; m.ts4 = tots * 4; m.tb8 = totb * 8; m.ts8 = tots * 8;
    return m;
}
__device__ __forceinline__ void moe_rec(LAS unsigned char* lds, int k, const MoeLane& m, int tid, int ncol, bool small, int idx, int type) {
    const int incl = small ? (ncol == 4 ? m.is4 : m.is8) : (ncol == 4 ? m.ib4 : m.ib8);
    const int mine = (small ? m.nsm : m.nbig) * ncol, excl = incl - mine;
    const bool hit = idx >= 0 && idx >= excl && idx < incl && tid < 32;
    const unsigned long long bm = __ballot(hit);
    LAS int* rec = (LAS int*)(lds + MOE_PLAN_OFF) + k * 8;
    if (bm == 0ull) { if (tid == 0) rec[0] = -1; }
    else if (hit) { const int loc = idx - excl, rt = (small ? m.nbig : 0) + loc / ncol; rec[0] = m.e; rec[1] = rt; rec[2] = loc % ncol; rec[3] = m.ce; rec[4] = m.hoff;
                    const int nv = m.ce - rt * 256; rec[5] = nv > 256 ? 256 : nv; rec[6] = type; }
}
template <int PHASE> __device__ __forceinline__ void moe_plan(const unsigned* cnt, int G, int c, LAS unsigned char* lds) {
    int tid = threadIdx.x; asm volatile("" : "+v"(tid));
    if (tid < 64) {
        const MoeLane m = moe_lane(cnt, tid);
#pragma unroll 1
        for (int k = 0; k < 8; ++k) {
            if (PHASE == 0) moe_rec(lds, k, m, tid, 4, false, k * G + c, 0);
            else if (PHASE == 2) moe_rec(lds, k, m, tid, 8, true, k * G + c, 1);
            else {
                const int ns = m.ts4;
                if (ns >= G) {
                    const int nsk = (ns - c + G - 1) / G;
                    if (k < nsk) moe_rec(lds, k, m, tid, 4, true, k * G + c, 0); else moe_rec(lds, k, m, tid, 8, false, (k - nsk) * G + c, 1);
                } else if (c < ns) { if (k == 0) moe_rec(lds, k, m, tid, 4, true, c, 0); else if (k == 1) moe_rec(lds, k, m, tid, 8, false, c, 1); else moe_rec(lds, k, m, tid, 8, false, -1, 1); }
                else moe_rec(lds, k, m, tid, 8, false, ns + (c - ns) + k * (G - ns), 1);
            }
        }
    }
    __syncthreads();
}
__device__ __forceinline__ bool moe_unit_rec(LAS unsigned char* lds, int k, pg8::Unit& u, int& type) {
    if (k >= 8) return false;
    const volatile LAS int* rec = (const volatile LAS int*)(lds + MOE_PLAN_OFF) + k * 8;
    const int e = __builtin_amdgcn_readfirstlane(rec[0]);
    if (e < 0) return false;
    u.e = e; u.rt = __builtin_amdgcn_readfirstlane(rec[1]); u.pn = __builtin_amdgcn_readfirstlane(rec[2]); u.pm = 0;
    u.ce = __builtin_amdgcn_readfirstlane(rec[3]); u.hoff = __builtin_amdgcn_readfirstlane(rec[4]); u.nv = __builtin_amdgcn_readfirstlane(rec[5]);
    type = __builtin_amdgcn_readfirstlane(rec[6]);
    return true;
}
struct MoeDownSched {
    LAS unsigned char* lds; const char* HB; const char* DT; int k0;
    __device__ bool next(int i, pg8::Unit& u) const {
        int type; if (!moe_unit_rec(lds, k0 + i, u, type) || type != 1) return false;
        u.A = HB + (size_t)(u.hoff + u.rt * 256) * 1024; u.B = DT + ((size_t)u.e * 512 * DM + u.pn * 256) * 2; u.ldb = 4096u; u.bhs = 256u; return true;
    }
    __device__ __forceinline__ unsigned arow_off(const pg8::Unit&, int R) const { return (unsigned)(R * 1024); }
};
template <int PHASE> __device__ __forceinline__ void phase_moe(const P& p, LAS unsigned char* lds, int G, int bid) {
    moe_plan<PHASE>((const unsigned*)(p.ws + OFF_CTL), G, bid, lds);
    int k = 0;
    if (PHASE != 2) {
        EpiGateUp E{(bf16_t*)(p.ws + OFF_HBUF)};
        for (;; ++k) {
            pg8::OneUnitSched S; int type; if (!moe_unit_rec(lds, k, S.u, type) || type != 0) break;
            S.u.A = (const char*)(p.ws + OFF_U2); S.u.B = (const char*)(p.ws + OFF_WG16) + ((size_t)S.u.e * DM * 512 + S.u.pn * 128) * 2;
            S.u.ldb = 1024u; S.u.bhs = (unsigned)(OFF_WU16 - OFF_WG16);
            S.idx = (const int*)(p.ws + OFF_INVMAP) + (size_t)S.u.e * SEQ; S.shift = 1; S.rowbytes = DM * 2; S.rowadd = 0;
            pg8::gemm_phase<EpiGateUp, pg8::OneUnitSched, true, true, true, true>(lds, DM, S, E);
        }
    }
    if (PHASE != 0) {
        MoeDownSched S{lds, (const char*)(p.ws + OFF_HBUF), (const char*)(p.ws + OFF_WD16), k};
        EpiDown E{(bf16_t*)(p.ws + OFF_Y), (const int*)(p.ws + OFF_INVMAP), (const float*)(p.ws + OFF_WTS)};
        pg8::gemm_phase<EpiDown, MoeDownSched, true, true, true, true>(lds, 512, S, E);
    }
}

#include <hip/hip_bf16.h>
namespace fx {
using bf16 = __hip_bfloat16;
typedef short s16x4 __attribute__((ext_vector_type(4)));
typedef float f32x16 __attribute__((ext_vector_type(16)));
template <class A, class Bt> struct same_t { static constexpr bool v = false; };
template <class A> struct same_t<A, A> { static constexpr bool v = true; };
constexpr int D = 128; constexpr float THR = 8.f; constexpr bool WSKIP = false;
constexpr float SCALE = 0.08838834764831845f;
constexpr int NW = 8, QBLK = 32, KVBLK = 64, QB = NW * QBLK;
constexpr int SHM_V = KVBLK * D * 2, SHM_K = KVBLK * D * 2;
constexpr int FOX_BIAS_OFF = 2 * SHM_V + 2 * SHM_K + NW * 64 * 4;
#define KSWZ(row, colB) ((row) * 256 + ((colB) ^ (((row) & 7) << 4)))
#define SBAR() __builtin_amdgcn_sched_barrier(0)
__device__ __forceinline__ int v_st(int k, int c) { const int kk = (k & ~0xC) | ((k & 4) << 1) | ((k & 8) >> 1); return ((kk >> 3) * 4 + (c >> 5)) * 512 + ((kk & 7) * 32 + (c & 31)) * 2; }
__device__ __forceinline__ int v_rd_base(int lane) { return ((lane & 3) << 3) | (((lane >> 2) & 3) << 6) | (((lane >> 4) & 1) << 5) | (((lane >> 5) & 1) << 8); }
constexpr int v_rd_off(int d0, int ks, int half) { return d0 * 512 + ks * 4096 + half * 2048; }
__device__ __forceinline__ int crow(int r, int hi) { return (r & 3) + 8 * (r >> 2) + 4 * hi; }

__device__ __forceinline__ bf16x8 pack8(f32x4 a, f32x4 b) {
    u32x4 w = {cvtpk(a[0], a[1]), cvtpk(a[2], a[3]), cvtpk(b[0], b[1]), cvtpk(b[2], b[3])};
    return *reinterpret_cast<bf16x8*>(&w);
}
template <class T> __device__ __forceinline__ bf16x8 load8(const T* p) {
    if constexpr (same_t<T, float>::v) { return pack8(*(const f32x4*)p, *(const f32x4*)(p + 4)); }
    else { return *reinterpret_cast<const bf16x8*>(p); }
}
__device__ __forceinline__ void mask_tile(f32x16& p0, f32x16& p1, int dq, unsigned W) {
    const float NEG = -__builtin_inff();
#pragma unroll
    for (int r = 0; r < 16; ++r) {
        const int c = (r & 3) + 8 * (r >> 2);
        if ((unsigned)(dq - c) >= W) p0[r] = NEG;
        if ((unsigned)(dq - c - 32) >= W) p1[r] = NEG;
    }
}
__device__ __forceinline__ void partialSM(f32x16& p0, f32x16& p1, float& m_reg, float& mn, float& alpha) {
    float pmax = p0[0]; for (int r = 1; r < 16; ++r) pmax = fmaxf(pmax, p0[r]); for (int r = 0; r < 16; ++r) pmax = fmaxf(pmax, p1[r]);
    { auto rr = __builtin_amdgcn_permlane32_swap(__float_as_uint(pmax), __float_as_uint(pmax), false, false);
      pmax = fmaxf(__uint_as_float(rr[0]), __uint_as_float(rr[1])); }
    constexpr float C2 = 1.4426950408889634f * SCALE;
    if (__builtin_expect(__all((pmax - m_reg) * SCALE <= THR), 1)) { mn = m_reg; alpha = 1.f; }
    else { mn = fmaxf(m_reg, pmax); alpha = __builtin_amdgcn_exp2f((m_reg - mn) * C2); m_reg = mn; }
    const float mnL = -mn * C2;
    for (int r = 0; r < 16; ++r) p0[r] = fmaf(p0[r], C2, mnL); for (int r = 0; r < 16; ++r) p1[r] = fmaf(p1[r], C2, mnL);
    for (int r = 0; r < 16; ++r) p0[r] = __builtin_amdgcn_exp2f(p0[r]);
}
__device__ __forceinline__ void finishSM(f32x16& p0, f32x16& p1, float alpha, float& l_reg, bf16x8& pa0, bf16x8& pa1, bf16x8& pa2, bf16x8& pa3) {
    for (int r = 0; r < 16; ++r) p1[r] = __builtin_amdgcn_exp2f(p1[r]);
    float ps = 0; for (int r = 0; r < 16; ++r) ps += p0[r]; for (int r = 0; r < 16; ++r) ps += p1[r];
    { auto rr = __builtin_amdgcn_permlane32_swap(__float_as_uint(ps), __float_as_uint(ps), false, false);
      ps = __uint_as_float(rr[0]) + __uint_as_float(rr[1]); }
    l_reg = l_reg * alpha + ps;
#define PK4(P, B_, OUT) do { unsigned a0 = cvtpk(P[B_+0], P[B_+1]), a1 = cvtpk(P[B_+2], P[B_+3]);                          \
        unsigned b0 = cvtpk(P[B_+4], P[B_+5]), b1 = cvtpk(P[B_+6], P[B_+7]);                                             \
        auto r0 = __builtin_amdgcn_permlane32_swap(a0, b0, false, false); auto r1 = __builtin_amdgcn_permlane32_swap(a1, b1, false, false); \
        u32x4 w = {r0[0], r1[0], r0[1], r1[1]}; OUT = *reinterpret_cast<bf16x8*>(&w); } while (0)
    PK4(p0, 0, pa0); PK4(p0, 8, pa1); PK4(p1, 0, pa2); PK4(p1, 8, pa3);
#undef PK4
}
template <int KB, bool SK>
__device__ __forceinline__ void qkt(f32x16& p0, f32x16& p1, const char* K_lds, int r32, int hi, const bf16x8* qr, bool act, const float* bias) {
    if (SK && !act) { const float NEG = -__builtin_inff();
#pragma unroll
        for (int r = 0; r < 16; ++r) { p0[r] = NEG; p1[r] = NEG; } return; }
    { const f32x4* bp = (const f32x4*)(bias + 4 * hi);
#pragma unroll
      for (int g = 0; g < 4; ++g) { const f32x4 a = bp[2 * g], b = bp[8 + 2 * g];
          p0[4 * g] = a[0]; p0[4 * g + 1] = a[1]; p0[4 * g + 2] = a[2]; p0[4 * g + 3] = a[3];
          p1[4 * g] = b[0]; p1[4 * g + 1] = b[1]; p1[4 * g + 2] = b[2]; p1[4 * g + 3] = b[3]; } }
    const char* kb[4];
#pragma unroll
    for (int dd = 0; dd < 4; ++dd) kb[dd] = K_lds + KB * SHM_K + KSWZ(r32, (dd * 16 + hi * 8) * 2);
#pragma unroll
    for (int d0 = 0; d0 < 8; ++d0) { const char* a = kb[d0 & 3] + (d0 >> 2) * 128;
        bf16x8 b0 = *reinterpret_cast<const bf16x8*>(a);
        bf16x8 b1 = *reinterpret_cast<const bf16x8*>(a + 32 * 256);
        p0 = __builtin_amdgcn_mfma_f32_32x32x16_bf16(b0, qr[d0], p0, 0, 0, 0);
        p1 = __builtin_amdgcn_mfma_f32_32x32x16_bf16(b1, qr[d0], p1, 0, 0, 0); }
}
template <int VB, bool SK>
__device__ __forceinline__ void pv_tile(f32x16* o, int vb0, bf16x8 pa0, bf16x8 pa1, bf16x8 pa2, bf16x8 pa3, bool act) {
    if (SK && !act) return;
#define TRRD(dst, off) asm volatile("ds_read_b64_tr_b16 %0, %1 offset:%2" : "=&v"(dst) : "v"(vb0), "i"(off) : "memory")
#define PV_D0(d0) do { s16x4 l0, l1, l2, l3, h0, h1, h2, h3; constexpr int b_ = VB * SHM_V + v_rd_off(d0, 0, 0);     \
        TRRD(l0, b_); TRRD(h0, b_ + 2048); TRRD(l1, b_ + 4096); TRRD(h1, b_ + 6144); TRRD(l2, b_ + 8192); TRRD(h2, b_ + 10240); TRRD(l3, b_ + 12288); TRRD(h3, b_ + 14336); \
        asm volatile("s_waitcnt lgkmcnt(0)" ::: "memory"); SBAR();                 \
        o[d0] = __builtin_amdgcn_mfma_f32_32x32x16_bf16(pa0, (bf16x8){l0[0], l0[1], l0[2], l0[3], h0[0], h0[1], h0[2], h0[3]}, o[d0], 0, 0, 0);   \
        o[d0] = __builtin_amdgcn_mfma_f32_32x32x16_bf16(pa1, (bf16x8){l1[0], l1[1], l1[2], l1[3], h1[0], h1[1], h1[2], h1[3]}, o[d0], 0, 0, 0);   \
        o[d0] = __builtin_amdgcn_mfma_f32_32x32x16_bf16(pa2, (bf16x8){l2[0], l2[1], l2[2], l2[3], h2[0], h2[1], h2[2], h2[3]}, o[d0], 0, 0, 0);   \
        o[d0] = __builtin_amdgcn_mfma_f32_32x32x16_bf16(pa3, (bf16x8){l3[0], l3[1], l3[2], l3[3], h3[0], h3[1], h3[2], h3[3]}, o[d0], 0, 0, 0); } while (0)
    PV_D0(0); PV_D0(1); PV_D0(2); PV_D0(3);
#undef PV_D0
#undef TRRD
}

template <class TIn, class TOut> struct BlockRef { const TIn* Q; const TIn* K; const TIn* V; TOut* O; int P0; const float* bias; const float* g; int jlo; };
template <class TIn> struct Seam {
    bf16x8 qr[8];
    bf16x8 st_v0, st_v1, st_k0, st_k1; f32x4 sf0, sf1, sf2, sf3;
    f32x4 tq[16];
};
__device__ __forceinline__ int swa_jlo(int P0, int W) { const int lowk = P0 - W + 1; return lowk > 0 ? lowk / KVBLK : 0; }
#define ROW(p, k0, rr) ((p) + (size_t)((k0) + (rr)) * D + sc)
#define VMW() asm volatile("s_waitcnt vmcnt(0)" ::: "memory")
#define VMWN(n) asm volatile("s_waitcnt vmcnt(%0)" :: "i"(n) : "memory")
#define SLOAD_H(Kp, Vp, k0) do { S.st_v0 = load8<TIn>(ROW(Vp, k0, sr)); S.st_v1 = load8<TIn>(ROW(Vp, k0, 32 + sr));              \
                         S.st_k0 = load8<TIn>(ROW(Kp, k0, sr)); S.st_k1 = load8<TIn>(ROW(Kp, k0, 32 + sr)); } while (0)
#define SWRITE_HK(bf) do { *(bf16x8*)(K_lds + (bf) * SHM_K + kws) = S.st_k0; *(bf16x8*)(K_lds + (bf) * SHM_K + kws + 32 * 256) = S.st_k1; } while (0)
#define SWRITE_HV(bf) do { *(bf16x8*)(V_lds + (bf) * SHM_V + vst0) = S.st_v0; *(bf16x8*)(V_lds + (bf) * SHM_V + vst1) = S.st_v1; } while (0)
#define SWRITE_H(bf) do { SWRITE_HV(bf); SWRITE_HK(bf); } while (0)
#define SLOAD_F(p, k0) do { S.sf0 = *(const f32x4*)ROW(p, k0, sr); S.sf1 = *(const f32x4*)(ROW(p, k0, sr) + 4);                \
                            S.sf2 = *(const f32x4*)ROW(p, k0, 32 + sr); S.sf3 = *(const f32x4*)(ROW(p, k0, 32 + sr) + 4); } while (0)
#define SWRITE_KF(bf) do { *(bf16x8*)(K_lds + (bf) * SHM_K + kws) = pack8(S.sf0, S.sf1); *(bf16x8*)(K_lds + (bf) * SHM_K + kws + 32 * 256) = pack8(S.sf2, S.sf3); } while (0)
#define SWRITE_VF(bf) do { *(bf16x8*)(V_lds + (bf) * SHM_V + vst0) = pack8(S.sf0, S.sf1); *(bf16x8*)(V_lds + (bf) * SHM_V + vst1) = pack8(S.sf2, S.sf3); } while (0)
template <class TIn, class TOut>
__device__ __forceinline__ void causal_swa_prime(const BlockRef<TIn, TOut>& cur, int W, char* lds, Seam<TIn>& S) {
    constexpr bool F32 = same_t<TIn, float>::v;
    int tid = threadIdx.x; asm volatile("" : "+v"(tid));
    const int wid = __builtin_amdgcn_readfirstlane(tid >> 6), lane = tid & 63, r32 = lane & 31, hi = lane >> 5;
    const int sr = tid >> 4, sc = (tid & 15) * 8, kws = KSWZ(sr, sc * 2); char* K_lds = lds + 2 * SHM_V;
    const int kb0 = cur.jlo * KVBLK;
    for (int d0 = 0; d0 < 8; ++d0) S.qr[d0] = load8<TIn>(cur.Q + (size_t)(wid * QBLK + r32) * D + d0 * 16 + hi * 8);
    if constexpr (F32) { SLOAD_F((const float*)cur.K, kb0); VMW(); SWRITE_KF(0); SBAR(); SLOAD_F((const float*)cur.V, kb0); }
    else { SLOAD_H(cur.K, cur.V, kb0); VMW(); SWRITE_HK(0); }
    __syncthreads();
}
template <class TIn, class TOut>
__device__ __forceinline__ void causal_swa_block(const BlockRef<TIn, TOut>& cur, const BlockRef<TIn, TOut>& nxt, int skv, int W, char* lds, Seam<TIn>& S) {
    constexpr bool F32 = same_t<TIn, float>::v;
    int tid = threadIdx.x; asm volatile("" : "+v"(tid));
    const int wid = __builtin_amdgcn_readfirstlane(tid >> 6), lane = tid & 63, r32 = lane & 31, hi = lane >> 5;
    const int j_lo = cur.jlo;
    int j_hi = (cur.P0 + QB - 1) / KVBLK + 1; if (j_hi > skv / KVBLK) j_hi = skv / KVBLK;
    const int NT = j_hi - j_lo;
    const int kbn = swa_jlo(nxt.P0, W) * KVBLK;
    const int qlo = cur.P0 + wid * QBLK, qm = qlo + r32 - 4 * hi;
    char* V_lds = lds; char* K_lds = lds + 2 * SHM_V;
    float* ws = (float*)(lds + 2 * SHM_V + 2 * SHM_K) + wid * 64; float* li_l = ws, * al_l = ws + 32;
    float m_reg = -1e30f, l_reg = 0; f32x16 o[4] = {};
    const int sr = tid >> 4, sc = (tid & 15) * 8, vst0 = v_st(sr, sc), vst1 = v_st(32 + sr, sc), kws = KSWZ(sr, sc * 2);
    const int vb0 = (int)(uintptr_t)V_lds + v_rd_base(lane);
    const TIn* Kh = cur.K; const TIn* Vh = cur.V;
#define RESC(a) do { if (__any((a) < 1.f)) { if (hi == 0) al_l[r32] = (a); asm volatile("s_waitcnt lgkmcnt(0)" ::: "memory");              \
                     for (int d_ = 0; d_ < 4; ++d_) for (int r = 0; r < 16; ++r) o[d_][r] *= al_l[crow(r, hi)]; } } while (0)
#define KBASE(t) ((j_lo + (t)) * KVBLK)
#define BIAS(t) (cur.bias + (t) * KVBLK)
#define ACT(t) (KBASE(t) <= qlo + QBLK - 1 && KBASE(t) + KVBLK - 1 >= qlo - W + 1)
#define MASKT(P0_, P1_, t) do { const int kb_ = KBASE(t); if ((!SK || ACT(t)) && (kb_ + KVBLK - 1 > qlo || kb_ <= qlo + QBLK - 1 - W)) mask_tile(P0_, P1_, qm - kb_, (unsigned)W); } while (0)
    constexpr int NQL = F32 ? 16 : 8;
    constexpr bool SK = WSKIP && !F32;
#define SEAM_K0() do { VMWN(NQL); if constexpr (F32) { SWRITE_KF(0); SBAR(); SLOAD_F((const float*)nxt.V, kbn); } else { SWRITE_HK(0); } SBAR(); } while (0)
    f32x16 pA0, pA1, pB0, pB1; float mnA, mnB, alA, alB; bf16x8 pa0, pa1, pa2, pa3;
    if constexpr (F32) { VMW(); SWRITE_VF(0); SBAR(); } else { SWRITE_HV(0); SBAR(); }
    if (NT > 1) { if constexpr (F32) SLOAD_F((const float*)Kh, KBASE(1)); else SLOAD_H(Kh, Vh, KBASE(1)); }
    SBAR(); qkt<0, SK>(pA0, pA1, K_lds, r32, hi, S.qr, ACT(0), BIAS(0));
    if constexpr (F32) { if (NT > 1) { VMW(); SWRITE_KF(1); SBAR(); SLOAD_F((const float*)Vh, KBASE(1)); } }
    MASKT(pA0, pA1, 0); partialSM(pA0, pA1, m_reg, mnA, alA);
    if (NT > 1) { VMW(); if constexpr (F32) { SWRITE_VF(1); SBAR(); if (NT > 2) SLOAD_F((const float*)Kh, KBASE(2)); } else SWRITE_H(1); }
    __syncthreads();
#define HALF_STEP(PX0, PX1, mnX, alX, PY0, PY1, alY, t, KB, VB, SB) do {                                                      \
        SBAR(); qkt<KB, SK>(PX0, PX1, K_lds, r32, hi, S.qr, ACT(t), BIAS(t));                                             \
        finishSM(PY0, PY1, alY, l_reg, pa0, pa1, pa2, pa3); SBAR();                                                           \
        if ((t) + 1 < NT) { if constexpr (F32) { VMW(); SWRITE_KF(SB); SBAR(); SLOAD_F((const float*)Vh, KBASE((t) + 1)); }  \
                            else { SLOAD_H(Kh, Vh, KBASE((t) + 1)); } SBAR(); }                                               \
        pv_tile<VB, SK>(o, vb0, pa0, pa1, pa2, pa3, ACT((t) - 1)); MASKT(PX0, PX1, (t)); partialSM(PX0, PX1, m_reg, mnX, alX);                                        \
        __syncthreads();                                                                                                      \
        if ((t) + 1 < NT) { VMW(); if constexpr (F32) { SWRITE_VF(SB); SBAR(); if ((t) + 2 < NT) SLOAD_F((const float*)Kh, KBASE((t) + 2)); } \
                            else { SWRITE_H(SB); } }                                                                          \
        RESC(alX); __syncthreads(); } while (0)
    for (int t = 1; t + 1 < NT; t += 2) {
        HALF_STEP(pB0, pB1, mnB, alB, pA0, pA1, alA, t, 1, 0, 0);
        HALF_STEP(pA0, pA1, mnA, alA, pB0, pB1, alB, t + 1, 0, 1, 1);
    }
    const bool even = (NT & 1) == 0;
    if (even) { SBAR(); qkt<1, SK>(pB0, pB1, K_lds, r32, hi, S.qr, ACT(NT - 1), BIAS(NT - 1)); SBAR(); }
#define QROW(e) (nxt.Q + (size_t)(wid * QBLK + r32) * D + ((e) >> 1) * 16 + hi * 8 + ((e) & 1) * 4)
    if constexpr (F32) { SLOAD_F((const float*)nxt.K, kbn); SBAR();
#pragma unroll
        for (int e = 0; e < 8; ++e) S.tq[e] = *(const f32x4*)QROW(e); }
    SBAR();
    finishSM(pA0, pA1, alA, l_reg, pa0, pa1, pa2, pa3); SBAR();
    if constexpr (F32) {
#pragma unroll
        for (int e = 8; e < 16; ++e) S.tq[e] = *(const f32x4*)QROW(e); SBAR(); }
#undef QROW
    pv_tile<0, SK>(o, vb0, pa0, pa1, pa2, pa3, ACT(even ? NT - 2 : NT - 1));
    if (even) { MASKT(pB0, pB1, NT - 1); partialSM(pB0, pB1, m_reg, mnB, alB); __syncthreads(); RESC(alB);
        finishSM(pB0, pB1, alB, l_reg, pa0, pa1, pa2, pa3); SBAR(); pv_tile<1, SK>(o, vb0, pa0, pa1, pa2, pa3, ACT(NT - 1)); }
    SBAR();
    if (hi == 0) li_l[r32] = l_reg; asm volatile("s_waitcnt lgkmcnt(0)" ::: "memory");
    float rli[16];
#pragma unroll
    for (int r = 0; r < 16; ++r) rli[r] = __builtin_amdgcn_rcpf(li_l[crow(r, hi)]);
    {
        float rs[16];
#pragma unroll
        for (int r = 0; r < 16; ++r) { float s = 0.f;
#pragma unroll
            for (int d0 = 0; d0 < 4; ++d0) { o[d0][r] *= rli[r]; s += o[d0][r] * o[d0][r]; }
            s += sw_xor<1>(s); s += sw_xor<2>(s); s += sw_xor<4>(s); s += sw_xor<8>(s); s += sw_xor<16>(s);
            rs[r] = rsqrtf(s * (1.f / 128.f) + 1e-6f); }
        float gg[4];
#pragma unroll
        for (int d0 = 0; d0 < 4; ++d0) gg[d0] = cur.g[d0 * 32 + r32];
        TOut* Ow = cur.O + (size_t)(wid * QBLK) * 2048;
#pragma unroll
        for (int r = 0; r < 16; ++r) { const int orow = crow(r, hi);
#pragma unroll
            for (int d0 = 0; d0 < 4; ++d0) { const float v = o[d0][r] * rs[r] * gg[d0]; const float vn = sw_xor<1>(v);
                if ((r32 & 1) == 0) *(unsigned*)(Ow + (size_t)orow * 2048 + d0 * 32 + r32) = cvtpk(v, vn); } }
    }
    if constexpr (F32) {
#pragma unroll
        for (int d0 = 0; d0 < 8; ++d0) S.qr[d0] = pack8(S.tq[2 * d0], S.tq[2 * d0 + 1]); }
    __syncthreads();
#undef RESC
#undef KBASE
#undef BIAS
#undef ACT
#undef MASKT
#undef SEAM_K0
#undef HALF_STEP
}
#undef ROW
#undef VMW
#undef VMWN
#undef SLOAD_H
#undef SWRITE_HK
#undef SWRITE_HV
#undef SWRITE_H
#undef SLOAD_F
#undef SWRITE_KF
#undef SWRITE_VF
}

constexpr size_t OFF_NORMS = 32768;
__device__ __forceinline__ float sumsq8(uint4 v) {
    const float a0 = __uint_as_float(v.x << 16), a1 = __uint_as_float(v.x & 0xffff0000u), a2 = __uint_as_float(v.y << 16), a3 = __uint_as_float(v.y & 0xffff0000u);
    const float a4 = __uint_as_float(v.z << 16), a5 = __uint_as_float(v.z & 0xffff0000u), a6 = __uint_as_float(v.w << 16), a7 = __uint_as_float(v.w & 0xffff0000u);
    return (a0 * a0 + a1 * a1) + (a2 * a2 + a3 * a3) + (a4 * a4 + a5 * a5) + (a6 * a6 + a7 * a7);
}
__device__ __forceinline__ void phase_norms(const P& p, unsigned char* lds, int G, int bid) {
    int tid = threadIdx.x; asm volatile("" : "+v"(tid));
    const int lane = tid & 63, w = tid >> 6, sub = lane >> 4, l16 = lane & 15, gw = bid * NWAVES + w, NGW = G * NWAVES;
    float* red = (float*)lds;
    float mq[8], mk[8];
#pragma unroll
    for (int h = 0; h < 8; ++h) { mq[h] = 0.f; mk[h] = 0.f; }
    for (int g = gw; g < LR / 4; g += NGW) {
        uint4 vq[8], vk[8];
#pragma unroll
        for (int h = 0; h < 8; ++h) {
            vk[h] = *(const uint4*)((const bf16_t*)(p.ws + OFF_FK) + ((size_t)h * LR + g * 4 + sub) * 128 + l16 * 8);
            vq[h] = g < SEQ / 4 ? *(const uint4*)((const bf16_t*)(p.ws + OFF_FQ) + ((size_t)h * SEQ + g * 4 + sub) * 128 + l16 * 8) : make_uint4(0u, 0u, 0u, 0u);
        }
#pragma unroll
        for (int h = 0; h < 8; ++h) {
            float a = sumsq8(vq[h]), b = sumsq8(vk[h]);
            a += sw_xor<1>(a); b += sw_xor<1>(b); a += sw_xor<2>(a); b += sw_xor<2>(b);
            a += sw_xor<4>(a); b += sw_xor<4>(b); a += sw_xor<8>(a); b += sw_xor<8>(b);
            mq[h] = fmaxf(mq[h], a); mk[h] = fmaxf(mk[h], b);
        }
    }
#pragma unroll
    for (int h = 0; h < 8; ++h) { const float a = wave_max(mq[h]), b = wave_max(mk[h]); if (lane == 0) { red[(h * 2) * 8 + w] = a; red[(h * 2 + 1) * 8 + w] = b; } }
    __syncthreads();
    if (tid < 16) { float m = 0.f;
#pragma unroll
        for (int q = 0; q < 8; ++q) m = fmaxf(m, red[tid * 8 + q]);
        ((float*)(p.ws + OFF_NORMS))[(size_t)bid * 16 + tid] = m; }
    __syncthreads();
}

__device__ __forceinline__ void phase_fox(const P& p, unsigned char* lds_g, int G, int bid) {
    using namespace fx;
    for (int it = bid; it < 256; it += G) {
        int tid = threadIdx.x; asm volatile("" : "+v"(tid));
        const int lane = tid & 63, w = tid >> 6;
        const int h = it & 7, qb = 31 - (it >> 3);
        const int P0 = 64 + qb * 256, j_hi = (P0 + QB - 1) / KVBLK + 1;
        const float* CBh = (const float*)(p.ws + OFF_CB) + (size_t)h * LR;
        float* sc = (float*)(lds_g + FOX_BIAS_OFF);
        { float a = 0.f, b = 0.f; const float* NR = (const float*)(p.ws + OFF_NORMS);
          for (int i = tid; i < G; i += 512) { a = fmaxf(a, NR[(size_t)i * 16 + 2 * h]); b = fmaxf(b, NR[(size_t)i * 16 + 2 * h + 1]); }
          a = wave_max(a); b = wave_max(b); if (lane == 0) { sc[w] = a; sc[8 + w] = b; } }
        __syncthreads();
        float qm = 0.f, km = 0.f;
#pragma unroll
        for (int q = 0; q < 8; ++q) { qm = fmaxf(qm, sc[q]); km = fmaxf(km, sc[8 + q]); }
        const float T = 2.f * SCALE * sqrtf(qm * km) + 30.f;
        const float thr = CBh[P0] - T * (1.f / SCALE);
        const int j_lo = !FOX_SKIP ? (__syncthreads(), 0) : __syncthreads_count(tid < j_hi && !(CBh[64 * tid + 63 < LR ? 64 * tid + 63 : LR - 1] >= thr));
        { const f32x4* src = (const f32x4*)(CBh + j_lo * 64);
          f32x4* dst = (f32x4*)(lds_g + FOX_BIAS_OFF);
          for (int i = tid; i < (j_hi - j_lo) * 16; i += 512) dst[i] = src[i]; }
        __syncthreads();
        BlockRef<bf16, bf16> cur;
        cur.Q = (const bf16*)(p.ws + OFF_FQ) + ((size_t)h * SEQ + qb * 256) * 128;
        cur.K = (const bf16*)(p.ws + OFF_FK) + (size_t)h * LR * 128;
        cur.V = (const bf16*)(p.ws + OFF_FV) + (size_t)h * LR * 128;
        cur.O = (bf16*)(p.ws + OFF_MIX) + (size_t)(qb * 256) * DM + 1024 + h * 128;
        cur.P0 = P0; cur.bias = (const float*)(lds_g + FOX_BIAS_OFF); cur.g = p.fox_g; cur.jlo = j_lo;
        Seam<bf16> S;
        causal_swa_prime<bf16, bf16>(cur, 1 << 30, (char*)lds_g, S);
        causal_swa_block<bf16, bf16>(cur, cur, LR, 1 << 30, (char*)lds_g, S);
    }
}

constexpr size_t OFF_UB = OFF_A0;
constexpr size_t OFF_SB = OFF_GLAO;
constexpr size_t OFF_DEC = 65536;
constexpr size_t WS_END_GLA = OFF_DEC + (size_t)128 * 4 * 128 * 4;
static_assert(WS_END_GLA <= OFF_A0, "ws map");
namespace gla {
using fx::s16x4; using fx::f32x16;
constexpr int L_ZS = 0, L_SEG = 4096, L_EX = 6144, L_V = 8192, L_A0 = 40960, L_A1 = 58368, L_A2 = 75776;
constexpr int RS = 272;
constexpr int KTS = 144;
#define GLA_TRRD(dst, base, off) asm volatile("ds_read_b64_tr_b16 %0, %1 offset:%2" : "=&v"(dst) : "v"(base), "i"(off) : "memory")
#define GLA_PK4(P, B_, OUT) do { unsigned a0 = cvtpk(P[B_+0], P[B_+1]), a1 = cvtpk(P[B_+2], P[B_+3]);                          \
        unsigned b0 = cvtpk(P[B_+4], P[B_+5]), b1 = cvtpk(P[B_+6], P[B_+7]);                                             \
        auto r0 = __builtin_amdgcn_permlane32_swap(a0, b0, false, false); auto r1 = __builtin_amdgcn_permlane32_swap(a1, b1, false, false); \
        u32x4 w_ = {r0[0], r1[0], r0[1], r1[1]}; OUT = __builtin_bit_cast(bf16x8, w_); } while (0)

struct CastPlan { const f32x4* s[6]; u32x2* d[6]; };
__device__ __forceinline__ CastPlan cast_plan_p1(const P& p, int it) { CastPlan c;
#pragma unroll
    for (int k = 0; k < 4; ++k) { c.s[k] = (const f32x4*)p.wg + (size_t)it * 16384 + k * 4096; c.d[k] = (u32x2*)(p.ws + OFF_WG16) + (size_t)it * 16384 + k * 4096; }
#pragma unroll
    for (int k = 0; k < 2; ++k) { c.s[4 + k] = (const f32x4*)p.wu + (size_t)it * 16384 + k * 4096; c.d[4 + k] = (u32x2*)(p.ws + OFF_WU16) + (size_t)it * 16384 + k * 4096; }
    return c; }
__device__ __forceinline__ CastPlan cast_plan_p3(const P& p, int it) { CastPlan c;
#pragma unroll
    for (int k = 0; k < 2; ++k) { c.s[k] = (const f32x4*)p.wu + (size_t)it * 16384 + 8192 + k * 4096; c.d[k] = (u32x2*)(p.ws + OFF_WU16) + (size_t)it * 16384 + 8192 + k * 4096; }
#pragma unroll
    for (int k = 0; k < 4; ++k) { c.s[2 + k] = (const f32x4*)p.wd + (size_t)it * 16384 + k * 4096; c.d[2 + k] = (u32x2*)(p.ws + OFF_WD16) + (size_t)it * 16384 + k * 4096; }
    return c; }
#define CAST_IN_GEMM 1
#if CAST_IN_GEMM
#define CAST_ISSUE(k) do { (void)cpl; (void)cv; } while (0)
#define CAST_FIN(k) do { } while (0)
#else
#define CAST_ISSUE(k) do { _Pragma("unroll") for (int j_ = 0; j_ < 8; ++j_) cv[j_] = nt_load(&cpl.s[k][j_ * 512 + tid]); } while (0)
#define CAST_FIN(k) do { _Pragma("unroll") for (int j_ = 0; j_ < 8; ++j_) nt_store((u32x2){cvtpk(cv[j_][0], cv[j_][1]), cvtpk(cv[j_][2], cv[j_][3])}, &cpl.d[k][j_ * 512 + tid]); } while (0)
#endif

__device__ __forceinline__ void stage_zv(const P& p, unsigned char* lds, int n, int h, int tid, bool with_z = true) {
    if (with_z && tid < 256) ((float4*)(lds + L_ZS))[tid] = ((const float4*)((const float*)(p.ws + OFF_GZ) + (size_t)n * 64 * 16))[tid];
    const bf16_t* GV = (const bf16_t*)(p.ws + OFF_GV) + ((size_t)h * LR + n * 64) * 256;
    const int sr = tid >> 4, sc = (tid & 15) * 8;
#pragma unroll
    for (int half = 0; half < 2; ++half)
#pragma unroll
        for (int kk = 0; kk < 2; ++kk) { const int key = sr + 32 * kk;
            const uint4 v = *(const uint4*)(GV + (size_t)key * 256 + half * 128 + sc);
            *(uint4*)(lds + L_V + half * 16384 + fx::v_st(key, sc)) = v; }
}
__device__ __forceinline__ void gate_compute(unsigned char* lds, int n, int tid, const float (&w2r)[16], float bgd, float (&b)[16], float& blast, float& bref) {
    const int d = tid & 127, rq = tid >> 7;
    const float* zs = (const float*)(lds + L_ZS);
    float run = 0.f;
#pragma unroll
    for (int ii = 0; ii < 16; ++ii) {
        const int i = rq * 16 + ii; const float4* z4 = (const float4*)(zs + i * 16);
        float lg = bgd;
#pragma unroll
        for (int q = 0; q < 4; ++q) { const float4 z = z4[q]; lg = fmaf(z.x, w2r[4 * q], lg); lg = fmaf(z.y, w2r[4 * q + 1], lg); lg = fmaf(z.z, w2r[4 * q + 2], lg); lg = fmaf(z.w, w2r[4 * q + 3], lg); }
        float la = logsigmoidf(lg) * (1.f / 16.f);
        if (n == 0 && i < 48) la = 0.f;
        run += la; b[ii] = run;
    }
    float la32;
    { const float4* z4 = (const float4*)(zs + 32 * 16); float lg = bgd;
#pragma unroll
      for (int q = 0; q < 4; ++q) { const float4 z = z4[q]; lg = fmaf(z.x, w2r[4 * q], lg); lg = fmaf(z.y, w2r[4 * q + 1], lg); lg = fmaf(z.z, w2r[4 * q + 2], lg); lg = fmaf(z.w, w2r[4 * q + 3], lg); }
      la32 = logsigmoidf(lg) * (1.f / 16.f); if (n == 0) la32 = 0.f; }
    float* seg = (float*)(lds + L_SEG);
    seg[rq * 128 + d] = run;
    __syncthreads();
    const float s0 = seg[d], s1 = seg[128 + d], s2 = seg[256 + d], s3 = seg[384 + d];
    const float prefix = (rq > 0 ? s0 : 0.f) + (rq > 1 ? s1 : 0.f) + (rq > 2 ? s2 : 0.f);
#pragma unroll
    for (int ii = 0; ii < 16; ++ii) b[ii] += prefix;
    blast = (s0 + s1) + (s2 + s3); bref = s0 + s1 + la32;
}

__device__ __forceinline__ void p1_item(const P& p, unsigned char* lds, int n, int h) {
    int tid = threadIdx.x; asm volatile("" : "+v"(tid));
    const int lane = tid & 63, w = __builtin_amdgcn_readfirstlane(tid >> 6), r = lane & 31, hh = lane >> 5;
    const int d = tid & 127, rq = tid >> 7;
    stage_zv(p, lds, n, h, tid);
    float kv[16], w2r[16];
    { const bf16_t* GK = (const bf16_t*)(p.ws + OFF_GK) + ((size_t)h * LR + n * 64 + rq * 16) * 128 + d;
#pragma unroll
      for (int ii = 0; ii < 16; ++ii) kv[ii] = bf2f(GK[(size_t)ii * 128]); }
#pragma unroll
    for (int r_ = 0; r_ < 16; ++r_) w2r[r_] = p.w2[r_ * 512 + h * 128 + d];
    const float bgd = p.bg[h * 128 + d];
    const CastPlan cpl = cast_plan_p1(p, n * 4 + h); f32x4 cv[8];
    CAST_ISSUE(0);
    __syncthreads();
    float b[16], blast, bref;
    gate_compute(lds, n, tid, w2r, bgd, b, blast, bref);
    CAST_FIN(0); CAST_ISSUE(1);
    { float* BB = (float*)(p.ws + OFF_BBUF) + (((size_t)n * 4 + h) * 64 + rq * 16) * 128 + d;
#pragma unroll
      for (int ii = 0; ii < 16; ++ii) BB[(size_t)ii * 128] = b[ii]; }
    { u32x4 w0, w1;
      float e[16];
#pragma unroll
      for (int ii = 0; ii < 16; ++ii) e[ii] = kv[ii] * fexp(blast - b[ii]);
      w0.x = cvtpk(e[0], e[1]); w0.y = cvtpk(e[2], e[3]); w0.z = cvtpk(e[4], e[5]); w0.w = cvtpk(e[6], e[7]);
      w1.x = cvtpk(e[8], e[9]); w1.y = cvtpk(e[10], e[11]); w1.z = cvtpk(e[12], e[13]); w1.w = cvtpk(e[14], e[15]);
      *(u32x4*)(lds + L_A0 + d * KTS + rq * 32) = w0; *(u32x4*)(lds + L_A0 + d * KTS + rq * 32 + 16) = w1;
      if (rq == 0) ((float*)(p.ws + OFF_DEC))[((size_t)n * 4 + h) * 128 + d] = fexp(blast); }
    CAST_FIN(1); CAST_ISSUE(2);
    __syncthreads();
    const int vb = (int)(uintptr_t)(lds + L_V) + fx::v_rd_base(lane) + (w >> 2) * 16384 + (w & 3) * 512;
    f32x16 acc[4];
#pragma unroll
    for (int db = 0; db < 4; ++db) acc[db] = f32x16{};
#define GLA_P1_KS(ks) do { s16x4 lo, hi4; GLA_TRRD(lo, vb, (ks) * 4096); GLA_TRRD(hi4, vb, (ks) * 4096 + 2048); \
        asm volatile("s_waitcnt lgkmcnt(0)" ::: "memory"); __builtin_amdgcn_sched_barrier(0); \
        const bf16x8 vf = (bf16x8){lo[0], lo[1], lo[2], lo[3], hi4[0], hi4[1], hi4[2], hi4[3]}; \
        _Pragma("unroll") for (int db = 0; db < 4; ++db) { const bf16x8 kf = *(const bf16x8*)(lds + L_A0 + (32 * db + r) * KTS + (16 * (ks) + 8 * hh) * 2); \
            acc[db] = __builtin_amdgcn_mfma_f32_32x32x16_bf16(vf, kf, acc[db], 0, 0, 0); } } while (0)
    GLA_P1_KS(0); GLA_P1_KS(1);
    CAST_FIN(2); CAST_ISSUE(3);
    GLA_P1_KS(2); GLA_P1_KS(3);
#undef GLA_P1_KS
    { unsigned char* stg = lds + 65536 + w * 8192;
#pragma unroll
      for (int x = 0; x < 16; ++x) { const int vrow = fx::crow(x, hh);
#pragma unroll
          for (int db = 0; db < 4; ++db) { const float v = acc[db][x], vn = sw_xor<1>(v);
              if ((r & 1) == 0) *(unsigned*)(stg + vrow * 256 + (32 * db + r) * 2) = cvtpk(v, vn); } }
      asm volatile("s_waitcnt lgkmcnt(0)" ::: "memory");
      CAST_FIN(3); CAST_ISSUE(4);
      bf16_t* UB = (bf16_t*)(p.ws + OFF_UB) + ((size_t)n * 4 + h) * 256 * 128 + (size_t)(32 * w) * 128;
#pragma unroll
      for (int i = 0; i < 8; ++i) { const int row = i * 4 + (lane >> 4), ch = lane & 15;
          *(u32x4*)(UB + (size_t)row * 128 + ch * 8) = *(const u32x4*)(stg + row * 256 + ch * 16); } }
    CAST_FIN(4); CAST_ISSUE(5);
    __syncthreads();
    CAST_FIN(5);
}

__device__ __forceinline__ void scan_thread(const P& p, int gid) {
    const int d2 = gid & 63, hv = gid >> 6, h = hv >> 8;
    const unsigned* UB = (const unsigned*)(p.ws + OFF_UB) + (size_t)hv * 64 + d2;
    unsigned* SB = (unsigned*)(p.ws + OFF_SB) + (size_t)hv * 64 + d2;
    const float2* DEC = (const float2*)(p.ws + OFF_DEC) + (size_t)h * 64 + d2;
    float s0 = 0.f, s1 = 0.f;
    for (int n0 = 0; n0 < 128; n0 += 32) {
        unsigned u[32]; float2 dc[32];
#pragma unroll
        for (int j = 0; j < 32; ++j) { u[j] = UB[(size_t)(n0 + j) * (4 * 256 * 64)]; dc[j] = DEC[(size_t)(n0 + j) * (4 * 64)]; }
#pragma unroll
        for (int j = 0; j < 32; ++j) {
            s0 = fmaf(dc[j].x, s0, __uint_as_float(u[j] << 16)); s1 = fmaf(dc[j].y, s1, __uint_as_float(u[j] & 0xffff0000u));
            SB[(size_t)(n0 + j) * (4 * 256 * 64)] = cvtpk(s0, s1);
        }
    }
}

__device__ __forceinline__ void p3_item(const P& p, unsigned char* lds, int n, int h) {
    int tid = threadIdx.x; asm volatile("" : "+v"(tid));
    const int lane = tid & 63, w = __builtin_amdgcn_readfirstlane(tid >> 6), r = lane & 31, hh = lane >> 5;
    const int d = tid & 127, rq = tid >> 7, rb = w & 1, cg = w >> 1;
    const bool fast = n < 128;
    float qv[16], kv[16], b[16], bref;
    { const size_t off = ((size_t)h * LR + n * 64 + rq * 16) * 128 + d;
      const bf16_t* GQ = (const bf16_t*)(p.ws + OFF_GQ) + off; const bf16_t* GK = (const bf16_t*)(p.ws + OFF_GK) + off;
#pragma unroll
      for (int ii = 0; ii < 16; ++ii) { qv[ii] = bf2f(GQ[(size_t)ii * 128]) * SCALE128; kv[ii] = bf2f(GK[(size_t)ii * 128]); } }
    if (fast) { const float* BB = (const float*)(p.ws + OFF_BBUF) + (((size_t)n * 4 + h) * 64) * 128 + d;
#pragma unroll
        for (int ii = 0; ii < 16; ++ii) b[ii] = BB[(size_t)(rq * 16 + ii) * 128];
        bref = BB[(size_t)32 * 128]; }
    stage_zv(p, lds, n, h, tid, !fast);
    const CastPlan cpl = cast_plan_p3(p, (n - 1) * 4 + h); f32x4 cv[8];
    CAST_ISSUE(0);
    __syncthreads();
    bf16x8 sfr[2][8];
    { const bf16_t* SB = (const bf16_t*)(p.ws + OFF_SB) + ((size_t)(n - 1) * 4 + h) * 256 * 128 + (size_t)(64 * cg + r) * 128 + 8 * hh;
#pragma unroll
      for (int tl = 0; tl < 2; ++tl)
#pragma unroll
          for (int s_ = 0; s_ < 8; ++s_) sfr[tl][s_] = *(const bf16x8*)(SB + (size_t)tl * 32 * 128 + 16 * s_); }
    if (!fast) { float w2r[16], blast;
#pragma unroll
        for (int r_ = 0; r_ < 16; ++r_) w2r[r_] = p.w2[r_ * 512 + h * 128 + d];
        gate_compute(lds, n, tid, w2r, p.bg[h * 128 + d], b, blast, bref); }
    const float ebref = fexp(bref);
#pragma unroll
    for (int ii = 0; ii < 16; ++ii) {
        const int i = rq * 16 + ii;
        const float eq = fexp(b[ii] - bref);
        *(bf16_t*)(lds + L_A0 + i * RS + d * 2) = f2bf(qv[ii] * eq);
        *(bf16_t*)(lds + L_A1 + i * RS + d * 2) = f2bf(qv[ii] * (eq * ebref));
        *(bf16_t*)(lds + L_A2 + i * RS + d * 2) = f2bf(kv[ii] * __builtin_amdgcn_rcpf(eq));
    }
    CAST_FIN(0); CAST_ISSUE(1);
    __syncthreads();
    f32x16 P0 = f32x16{}, P1v = f32x16{};
#pragma unroll
    for (int s_ = 0; s_ < 8; ++s_) {
        const bf16x8 qf = *(const bf16x8*)(lds + L_A0 + (32 * rb + r) * RS + (16 * s_ + 8 * hh) * 2);
        const bf16x8 k0 = *(const bf16x8*)(lds + L_A2 + r * RS + (16 * s_ + 8 * hh) * 2);
        P0 = __builtin_amdgcn_mfma_f32_32x32x16_bf16(k0, qf, P0, 0, 0, 0);
        if (rb) { const bf16x8 k1 = *(const bf16x8*)(lds + L_A2 + (32 + r) * RS + (16 * s_ + 8 * hh) * 2);
                  P1v = __builtin_amdgcn_mfma_f32_32x32x16_bf16(k1, qf, P1v, 0, 0, 0); }
    }
#pragma unroll
    for (int x = 0; x < 16; ++x) { const bool keep = fx::crow(x, hh) <= r; if (rb) { if (!keep) P1v[x] = 0.f; } else { if (!keep) P0[x] = 0.f; } }
    bf16x8 pa0, pa1, pa2, pa3;
    GLA_PK4(P0, 0, pa0); GLA_PK4(P0, 8, pa1); GLA_PK4(P1v, 0, pa2); GLA_PK4(P1v, 8, pa3);
    CAST_FIN(1); CAST_ISSUE(2);
    f32x16 o[2];
#pragma unroll
    for (int tl = 0; tl < 2; ++tl) {
        const int vblk = 2 * cg + tl;
        const int vb = (int)(uintptr_t)(lds + L_V) + fx::v_rd_base(lane) + (vblk >> 2) * 16384 + (vblk & 3) * 512;
        o[tl] = f32x16{};
#define GLA_PV(ks, PA) do { s16x4 lo, hi4; GLA_TRRD(lo, vb, (ks) * 4096); GLA_TRRD(hi4, vb, (ks) * 4096 + 2048); \
        asm volatile("s_waitcnt lgkmcnt(0)" ::: "memory"); __builtin_amdgcn_sched_barrier(0); \
        o[tl] = __builtin_amdgcn_mfma_f32_32x32x16_bf16(PA, (bf16x8){lo[0], lo[1], lo[2], lo[3], hi4[0], hi4[1], hi4[2], hi4[3]}, o[tl], 0, 0, 0); } while (0)
        GLA_PV(0, pa0); GLA_PV(1, pa1);
        if (rb) { GLA_PV(2, pa2); GLA_PV(3, pa3); }
#undef GLA_PV
#pragma unroll
        for (int s_ = 0; s_ < 8; ++s_) {
            const bf16x8 qh = *(const bf16x8*)(lds + L_A1 + (32 * rb + r) * RS + (16 * s_ + 8 * hh) * 2);
            o[tl] = __builtin_amdgcn_mfma_f32_32x32x16_bf16(qh, sfr[tl][s_], o[tl], 0, 0, 0);
        }
    }
    CAST_FIN(2); CAST_ISSUE(3);
    float* ex = (float*)(lds + L_EX);
#pragma unroll
    for (int x = 0; x < 16; ++x) { float s = o[0][x] * o[0][x] + o[1][x] * o[1][x];
        s += sw_xor<1>(s); s += sw_xor<2>(s); s += sw_xor<4>(s); s += sw_xor<8>(s); s += sw_xor<16>(s);
        if (r == 0) ex[(32 * rb + fx::crow(x, hh)) * 4 + cg] = s; }
    CAST_FIN(3); CAST_ISSUE(4);
    __syncthreads();
    const float g0 = p.gla_g[64 * cg + r], g1 = p.gla_g[64 * cg + 32 + r];
#pragma unroll
    for (int x = 0; x < 16; ++x) {
        const int row = 32 * rb + fx::crow(x, hh); const f32x4 e4 = *(const f32x4*)(ex + row * 4);
        const float rs = rsqrtf(((e4[0] + e4[1]) + (e4[2] + e4[3])) * (1.f / 256.f) + EPS);
        const size_t t = (size_t)(n - 1) * 64 + row;
        const bf16_t* GR = (const bf16_t*)(p.ws + OFF_GR) + t * 1024 + h * 256 + 64 * cg + r;
        bf16_t* MX = (bf16_t*)(p.ws + OFF_MIX) + t * DM + h * 256 + 64 * cg + r;
        const float v0 = o[0][x] * rs * g0 * siluf(bf2f(GR[0])), v1 = o[1][x] * rs * g1 * siluf(bf2f(GR[32]));
        const float v0n = sw_xor<1>(v0), v1n = sw_xor<1>(v1);
        if ((r & 1) == 0) { *(unsigned*)MX = cvtpk(v0, v0n); *(unsigned*)(MX + 32) = cvtpk(v1, v1n); }
    }
    CAST_FIN(4); CAST_ISSUE(5);
    __syncthreads();
    CAST_FIN(5);
}
}
__device__ __forceinline__ void phase_gla_p1(const P& p, unsigned char* lds, int G, int bid) { for (int it = bid; it < 512; it += G) gla::p1_item(p, lds, it >> 2, it & 3); }
__device__ __forceinline__ void phase_gla_scan(const P& p, int G, int bid) {
    int tid = threadIdx.x; asm volatile("" : "+v"(tid));
    const int per = (65536 + G - 1) / G;
    for (int i = tid; i < per; i += 512) { const int g = bid * per + i; if (g < 65536) gla::scan_thread(p, g); }
}
__device__ __forceinline__ void phase_gla_p3(const P& p, unsigned char* lds, int G, int bid) { for (int it = bid; it < 512; it += G) gla::p3_item(p, lds, 1 + (it >> 2), it & 3); }


__device__ __forceinline__ void cscan_head(const P& p, unsigned char* lds, int h) {
    int tid = threadIdx.x; asm volatile("" : "+v"(tid));
    const int lane = tid & 63, w = tid >> 6;
    const float* FLOG = (const float*)(p.ws + OFF_FLOG) + h;
    float* CB = (float*)(p.ws + OFF_CB) + (size_t)h * LR;
    const float bf = p.b_f[h];
    const int l0 = tid * 17;
    float v[17]; float run = 0.f;
#pragma unroll
    for (int k = 0; k < 17; ++k) { const int l = l0 + k; const float x = (l >= 48 && l < LR) ? FLOG[(size_t)l * 8] : 0.f; v[k] = x; }
#pragma unroll
    for (int k = 0; k < 17; ++k) { const int l = l0 + k; const float la = (l >= 48 && l < LR) ? logsigmoidf(v[k] + bf) : 0.f; run += la; v[k] = run; }
    float inc = run;
#pragma unroll
    for (int o = 1; o < 64; o <<= 1) { const float t = shfl_from(inc, lane - o); if (lane >= o) inc += t; }
    float* wt = (float*)lds;
    if (lane == 63) wt[w] = inc;
    __syncthreads();
    float woff = 0.f;
#pragma unroll
    for (int q = 0; q < 8; ++q) woff += (q < w) ? wt[q] : 0.f;
    const float pre = woff + (inc - run);
#pragma unroll
    for (int k = 0; k < 17; ++k) { const int l = l0 + k; if (l < LR) CB[l] = l >= 48 ? -(pre + v[k]) * (1.f / SCALE128) : -1e30f; }
    __syncthreads();
}
__device__ __forceinline__ void phase_cscan(const P& p, unsigned char* lds, int G, int bid) { for (int h = bid; h < 8; h += G) cscan_head(p, lds, h); }

__device__ __forceinline__ void router_row(const P& p, int t, int lane) {
    const float4* hr = (const float4*)(p.out + (size_t)t * DM);
    float4 u[8]; float ss = 0.f;
#pragma unroll
    for (int j = 0; j < 8; ++j) { u[j] = hr[lane + 64 * j]; ss += u[j].x * u[j].x + u[j].y * u[j].y + u[j].z * u[j].z + u[j].w * u[j].w; }
    ss = wave_sum(ss); const float rs = rsqrtf(ss * (1.f / DM) + EPS);
    uint2* U2 = (uint2*)((bf16_t*)(p.ws + OFF_U2) + (size_t)t * DM);
    float gl[4] = {0.f, 0.f, 0.f, 0.f};
#pragma unroll
    for (int j = 0; j < 8; ++j) {
        const float4 g = ((const float4*)p.g2)[lane + 64 * j];
        u[j].x *= rs * g.x; u[j].y *= rs * g.y; u[j].z *= rs * g.z; u[j].w *= rs * g.w;
        U2[lane + 64 * j] = make_uint2(cvtpk(u[j].x, u[j].y), cvtpk(u[j].z, u[j].w));
        const float4* wr = (const float4*)p.w_rg + (size_t)(lane + 64 * j) * 4;
        const float4 a = wr[0], b = wr[1], c = wr[2], d = wr[3];
        gl[0] += u[j].x * a.x + u[j].y * b.x + u[j].z * c.x + u[j].w * d.x;
        gl[1] += u[j].x * a.y + u[j].y * b.y + u[j].z * c.y + u[j].w * d.y;
        gl[2] += u[j].x * a.z + u[j].y * b.z + u[j].z * c.z + u[j].w * d.z;
        gl[3] += u[j].x * a.w + u[j].y * b.w + u[j].z * c.w + u[j].w * d.w;
    }
#pragma unroll
    for (int g = 0; g < 4; ++g) gl[g] = wave_sum(gl[g]) + p.b_rg[g];
    int gi = 0; float gm = gl[0];
#pragma unroll
    for (int g = 1; g < 4; ++g) if (gl[g] > gm) { gm = gl[g]; gi = g; }
    float gs = 0.f;
#pragma unroll
    for (int g = 0; g < 4; ++g) gs += expf(gl[g] - gm);
    const float p_g = 1.f / gs;
    float el[8] = {0.f, 0.f, 0.f, 0.f, 0.f, 0.f, 0.f, 0.f};
    const float4* we = (const float4*)(p.w_re + (size_t)gi * DM * 8);
#pragma unroll
    for (int j = 0; j < 8; ++j) {
        const float uu[4] = {u[j].x, u[j].y, u[j].z, u[j].w};
#pragma unroll
        for (int i = 0; i < 4; ++i) {
            const int k = 4 * (lane + 64 * j) + i;
            const float4 a = we[(size_t)k * 2], b = we[(size_t)k * 2 + 1];
            el[0] += uu[i] * a.x; el[1] += uu[i] * a.y; el[2] += uu[i] * a.z; el[3] += uu[i] * a.w;
            el[4] += uu[i] * b.x; el[5] += uu[i] * b.y; el[6] += uu[i] * b.z; el[7] += uu[i] * b.w;
        }
    }
#pragma unroll
    for (int e = 0; e < 8; ++e) el[e] = wave_sum(el[e]) + p.b_re[gi * 8 + e];
    int i0 = 0; float l0 = el[0];
#pragma unroll
    for (int e = 1; e < 8; ++e) if (el[e] > l0) { l0 = el[e]; i0 = e; }
    int i1 = -1; float l1 = -INFINITY;
#pragma unroll
    for (int e = 0; e < 8; ++e) if (e != i0 && el[e] > l1) { l1 = el[e]; i1 = e; }
    const float e1 = expf(l1 - l0), w0 = p_g / (1.f + e1), w1 = p_g * e1 / (1.f + e1);
    if (lane == 0) {
        unsigned* cnt = (unsigned*)(p.ws + OFF_CTL);
        int* invmap = (int*)(p.ws + OFF_INVMAP); float* wts = (float*)(p.ws + OFF_WTS);
        const int E0 = gi * 8 + i0, E1 = gi * 8 + i1;
        const unsigned p0 = atomicAdd(&cnt[E0], 1u); invmap[E0 * SEQ + p0] = t * 2; wts[t * 2] = w0;
        const unsigned p1 = atomicAdd(&cnt[E1], 1u); invmap[E1 * SEQ + p1] = t * 2 + 1; wts[t * 2 + 1] = w1;
    }
}
__device__ __forceinline__ void phase_router(const P& p, unsigned char* lds, int G, int bid) {
    int tid = threadIdx.x; asm volatile("" : "+v"(tid));
    const int lane = tid & 63, w = __builtin_amdgcn_readfirstlane(tid >> 6), r = lane & 15, q = lane >> 4;
    float* red = (float*)lds; float* rsc = (float*)(lds + 1024); float* part = (float*)(lds + 2048); float* lgt = (float*)(lds + 2048 + 49152);
    for (int rb = bid; rb < SEQ / 32; rb += G) {
        const int row0 = rb * 32;
        const float* pa0 = p.out + (size_t)(row0 + r) * DM + 256 * w + 4 * q;
        const float* pa1 = pa0 + (size_t)16 * DM;
        const float* pg = p.g2 + 256 * w + 4 * q;
        const float* pb0 = p.w_rg + (size_t)(256 * w + 4 * q) * 4 + (r < 4 ? r : 0);
        const float* pb1 = p.w_re + ((size_t)(r >> 3) * DM + 256 * w + 4 * q) * 8 + (r & 7);
        const float* pb2 = pb1 + (size_t)2 * DM * 8;
        const float m0 = r < 4 ? 1.f : 0.f;
        f32x4 acc[2][3];
#pragma unroll
        for (int rbk = 0; rbk < 2; ++rbk)
#pragma unroll
            for (int cb = 0; cb < 3; ++cb) acc[rbk][cb] = (f32x4){0.f, 0.f, 0.f, 0.f};
        float ss0 = 0.f, ss1 = 0.f;
#pragma unroll 2
        for (int t = 0; t < 16; ++t) {
            const f32x4 a0 = *(const f32x4*)(pa0 + 16 * t), a1 = *(const f32x4*)(pa1 + 16 * t), g4 = *(const f32x4*)(pg + 16 * t);
            ss0 += (a0[0] * a0[0] + a0[1] * a0[1]) + (a0[2] * a0[2] + a0[3] * a0[3]);
            ss1 += (a1[0] * a1[0] + a1[1] * a1[1]) + (a1[2] * a1[2] + a1[3] * a1[3]);
#pragma unroll
            for (int s_ = 0; s_ < 4; ++s_) {
                const float b0 = pb0[(16 * t + s_) * 4] * (g4[s_] * m0), b1 = pb1[(16 * t + s_) * 8] * g4[s_], b2 = pb2[(16 * t + s_) * 8] * g4[s_];
                acc[0][0] = __builtin_amdgcn_mfma_f32_16x16x4f32(a0[s_], b0, acc[0][0], 0, 0, 0); acc[1][0] = __builtin_amdgcn_mfma_f32_16x16x4f32(a1[s_], b0, acc[1][0], 0, 0, 0);
                acc[0][1] = __builtin_amdgcn_mfma_f32_16x16x4f32(a0[s_], b1, acc[0][1], 0, 0, 0); acc[1][1] = __builtin_amdgcn_mfma_f32_16x16x4f32(a1[s_], b1, acc[1][1], 0, 0, 0);
                acc[0][2] = __builtin_amdgcn_mfma_f32_16x16x4f32(a0[s_], b2, acc[0][2], 0, 0, 0); acc[1][2] = __builtin_amdgcn_mfma_f32_16x16x4f32(a1[s_], b2, acc[1][2], 0, 0, 0);
            }
        }
        ss0 += sw_xor<16>(ss0); ss0 = x32_sum(ss0); ss1 += sw_xor<16>(ss1); ss1 = x32_sum(ss1);
        if (q == 0) { red[w * 32 + r] = ss0; red[w * 32 + 16 + r] = ss1; }
#pragma unroll
        for (int rbk = 0; rbk < 2; ++rbk)
#pragma unroll
            for (int cb = 0; cb < 3; ++cb)
#pragma unroll
                for (int i = 0; i < 4; ++i) part[((w * 2 + rbk) * 16 + 4 * q + i) * 48 + 16 * cb + r] = acc[rbk][cb][i];
        __syncthreads();
        if (tid < 32) { float ss = 0.f;
#pragma unroll
            for (int ww = 0; ww < 8; ++ww) ss += red[ww * 32 + tid];
            rsc[tid] = rsqrtf(ss * (1.f / DM) + EPS); }
        for (int idx = tid; idx < 32 * 48; idx += 512) { const int row = idx / 48, col = idx - row * 48; float sum = 0.f;
#pragma unroll
            for (int ww = 0; ww < 8; ++ww) sum += part[((ww * 2 + (row >> 4)) * 16 + (row & 15)) * 48 + col];
            lgt[idx] = sum; }
        __syncthreads();
        { const float rs0 = rsc[r], rs1 = rsc[16 + r];
          bf16_t* U2 = (bf16_t*)(p.ws + OFF_U2) + (size_t)(row0 + r) * DM + 256 * w + 4 * q;
#pragma unroll 4
          for (int t = 0; t < 16; ++t) { const f32x4 g4 = *(const f32x4*)(pg + 16 * t);
              const f32x4 v0 = *(const f32x4*)(pa0 + 16 * t) * g4 * rs0, v1 = *(const f32x4*)(pa1 + 16 * t) * g4 * rs1;
              *(uint2*)(U2 + 16 * t) = make_uint2(cvtpk(v0[0], v0[1]), cvtpk(v0[2], v0[3]));
              *(uint2*)(U2 + (size_t)16 * DM + 16 * t) = make_uint2(cvtpk(v1[0], v1[1]), cvtpk(v1[2], v1[3])); } }
        if (tid < 32) {
            const int t = row0 + tid; const float rs = rsc[tid]; const float* L = lgt + tid * 48;
            float gl[4];
#pragma unroll
            for (int g = 0; g < 4; ++g) gl[g] = L[g] * rs + p.b_rg[g];
            int gi = 0; float gm = gl[0];
#pragma unroll
            for (int g = 1; g < 4; ++g) if (gl[g] > gm) { gm = gl[g]; gi = g; }
            float gs = 0.f;
#pragma unroll
            for (int g = 0; g < 4; ++g) gs += expf(gl[g] - gm);
            const float p_g = 1.f / gs;
            float el[8];
#pragma unroll
            for (int e = 0; e < 8; ++e) el[e] = L[16 + gi * 8 + e] * rs + p.b_re[gi * 8 + e];
            int i0 = 0; float l0 = el[0];
#pragma unroll
            for (int e = 1; e < 8; ++e) if (el[e] > l0) { l0 = el[e]; i0 = e; }
            int i1 = -1; float l1 = -INFINITY;
#pragma unroll
            for (int e = 0; e < 8; ++e) if (e != i0 && el[e] > l1) { l1 = el[e]; i1 = e; }
            const float e1 = expf(l1 - l0), w0 = p_g / (1.f + e1), w1 = p_g * e1 / (1.f + e1);
            unsigned* cnt = (unsigned*)(p.ws + OFF_CTL);
            int* invmap = (int*)(p.ws + OFF_INVMAP); float* wts = (float*)(p.ws + OFF_WTS);
            const int E0 = gi * 8 + i0, E1 = gi * 8 + i1;
            const unsigned p0 = atomicAdd(&cnt[E0], 1u); invmap[E0 * SEQ + p0] = t * 2; wts[t * 2] = w0;
            const unsigned p1 = atomicAdd(&cnt[E1], 1u); invmap[E1 * SEQ + p1] = t * 2 + 1; wts[t * 2 + 1] = w1;
        }
        __syncthreads();
    }
}
__device__ __forceinline__ void final_row(const P& p, int t, int lane) {
    float4* hr = (float4*)(p.out + (size_t)t * DM);
    const uint2* y0 = (const uint2*)((const bf16_t*)(p.ws + OFF_Y) + (size_t)t * DM);
    const uint2* y1 = (const uint2*)((const bf16_t*)(p.ws + OFF_Y) + (size_t)SEQ * DM + (size_t)t * DM);
    float4 v[8]; float ss = 0.f;
#pragma unroll
    for (int j = 0; j < 8; ++j) {
        { const f32x4 t_ = nt_load((const f32x4*)hr + lane + 64 * j); v[j] = make_float4(t_[0], t_[1], t_[2], t_[3]); }
        const u32x2 a_ = nt_load((const u32x2*)y0 + lane + 64 * j), b_ = nt_load((const u32x2*)y1 + lane + 64 * j); const uint2 a = make_uint2(a_[0], a_[1]), b = make_uint2(b_[0], b_[1]);
        v[j].x += __uint_as_float(a.x << 16) + __uint_as_float(b.x << 16);
        v[j].y += __uint_as_float(a.x & 0xffff0000u) + __uint_as_float(b.x & 0xffff0000u);
        v[j].z += __uint_as_float(a.y << 16) + __uint_as_float(b.y << 16);
        v[j].w += __uint_as_float(a.y & 0xffff0000u) + __uint_as_float(b.y & 0xffff0000u);
        ss += v[j].x * v[j].x + v[j].y * v[j].y + v[j].z * v[j].z + v[j].w * v[j].w;
    }
    ss = wave_sum(ss); float rs = rsqrtf(ss * (1.f / DM) + EPS);
#pragma unroll
    for (int j = 0; j < 8; ++j) {
        const float4 g = ((const float4*)p.gf)[lane + 64 * j];
        nt_store((f32x4){v[j].x * rs * g.x, v[j].y * rs * g.y, v[j].z * rs * g.z, v[j].w * rs * g.w}, (f32x4*)hr + lane + 64 * j);
    }
}
__device__ __forceinline__ void phase_final(const P& p, int G, int bid) {
    int tid = threadIdx.x; asm volatile("" : "+v"(tid));
    const int lane = tid & 63, gw = bid * NWAVES + (tid >> 6);
    for (int t = gw; t < SEQ; t += G * NWAVES) final_row(p, t, lane);
}

constexpr int CW_BAR = 4096;
constexpr size_t CTL_ZERO_BYTES = 32768;
#define XB_TMO      128
#define XB_XCNT(j)  (256  + 64 * (j))
#define XB_XSUB(j)  (1280 + 64 * (j))
#define XB_XGEN(j)  (2304 + 64 * (j))
#define XB_TOP      3328
#define XB_TOPGEN   3392
#define XCD_BAR_WORDS 3456
#define XB_SPIN_CAP (1u << 22)
static_assert((CW_BAR + XCD_BAR_WORDS) * 4 <= (int)CTL_ZERO_BYTES, "barrier words inside the memset region");
__device__ __forceinline__ unsigned xb_ld(unsigned* p)              { return __hip_atomic_load(p, __ATOMIC_RELAXED, __HIP_MEMORY_SCOPE_AGENT); }
__device__ __forceinline__ unsigned xb_add(unsigned* p, unsigned v) { return __hip_atomic_fetch_add(p, v, __ATOMIC_RELAXED, __HIP_MEMORY_SCOPE_AGENT); }
__device__ __forceinline__ unsigned xb_xcc_id() { return (unsigned)__builtin_amdgcn_s_getreg((3 << 11) | 20) & 0xFu; }
#define XB_SPIN(cond, bar) do { unsigned _sp = 0; while (cond) { __builtin_amdgcn_s_sleep(1); \
    if ((++_sp & 255u) == 0u) { if (xb_ld(&(bar)[XB_TMO])) break; if (_sp > XB_SPIN_CAP) { atomicAdd(&(bar)[XB_TMO], 1u); break; } } } } while (0)
struct XcdBarrier { unsigned* bar; unsigned x; volatile LAS unsigned* st; };
__device__ __forceinline__ XcdBarrier xcd_barrier_post(unsigned* bar, volatile LAS unsigned* st) {
    XcdBarrier b; b.bar = bar; b.x = xb_xcc_id(); b.st = st;
    if (threadIdx.x == 0) (void)xb_add(&bar[XB_XCNT(b.x)], 1u);
    return b;
}
__device__ __forceinline__ void xcd_barrier_complete(unsigned* bar, unsigned x, unsigned& nloc, unsigned& nx) {
    const unsigned G = gridDim.x * gridDim.y * gridDim.z;
    unsigned sum, cnt, mine, sp = 0u;
    for (;;) {
        sum = 0u; cnt = 0u; mine = 0u;
#pragma unroll
        for (unsigned j = 0; j < 16; ++j) { const unsigned c = xb_ld(&bar[XB_XCNT(j)]); sum += c; cnt += (c > 0u) ? 1u : 0u; mine = (j == x) ? c : mine; }
        if (sum == G) break;
        __builtin_amdgcn_s_sleep(1);
        if ((++sp & 255u) == 0u) { if (xb_ld(&bar[XB_TMO])) break; if (sp > XB_SPIN_CAP) { atomicAdd(&bar[XB_TMO], 1u); break; } }
    }
    nloc = mine > 0u ? mine : 1u; nx = cnt > 0u ? cnt : 1u;
}
__device__ __forceinline__ void xcd_barrier(const XcdBarrier& b) {
    asm volatile("s_waitcnt vmcnt(0)" ::: "memory");
    __syncthreads();
    if (threadIdx.x == 0) {
        unsigned* bar = b.bar;
        __builtin_amdgcn_s_waitcnt(0);
        unsigned nloc = b.st[0], nx = b.st[1];
        if (nloc == 0u) { xcd_barrier_complete(bar, b.x, nloc, nx); b.st[0] = nloc; b.st[1] = nx; }
        const unsigned old = xb_add(&bar[XB_XSUB(b.x)], 1u);
        const unsigned gen = old / nloc;
        if (old + 1u == (gen + 1u) * nloc) {
            __builtin_amdgcn_fence(__ATOMIC_RELEASE, "agent");
            asm volatile("s_waitcnt vmcnt(0)" ::: "memory");
            const unsigned og = xb_add(&bar[XB_TOP], 1u);
            const unsigned tg = og / nx;
            if (og + 1u == (tg + 1u) * nx) xb_add(&bar[XB_TOPGEN], 1u);
            else XB_SPIN(xb_ld(&bar[XB_TOPGEN]) == tg, bar);
            __builtin_amdgcn_fence(__ATOMIC_ACQUIRE, "agent");
            xb_add(&bar[XB_XGEN(b.x)], 1u);
            asm volatile("s_waitcnt vmcnt(0)" ::: "memory");
        } else {
            XB_SPIN(xb_ld(&bar[XB_XGEN(b.x)]) == gen, bar);
            __builtin_amdgcn_fence(__ATOMIC_ACQUIRE, "agent");
            asm volatile("s_waitcnt vmcnt(0)" ::: "memory");
        }
    }
    __syncthreads();
}

constexpr int P_OFF = MISC_OFF + 128;
static_assert(P_OFF + 50 * 4 <= LDS_BYTES, "P copy inside the LDS control area");
__device__ __forceinline__ unsigned long long lds_u64_uniform(const volatile LAS unsigned long long* s, int i) {
    const unsigned long long v = s[i];
    return ((unsigned long long)(unsigned)__builtin_amdgcn_readfirstlane((int)(unsigned)(v >> 32)) << 32) | (unsigned long long)(unsigned)__builtin_amdgcn_readfirstlane((int)(unsigned)v);
}
__device__ __forceinline__ P load_P(LAS unsigned char* lds) {
    const volatile LAS unsigned long long* s = (const volatile LAS unsigned long long*)(lds + P_OFF);
    P q;
    q.x = (const float*)(const GAS float*)lds_u64_uniform(s, 0); q.meta = (const float*)(const GAS float*)lds_u64_uniform(s, 1); q.g1 = (const float*)(const GAS float*)lds_u64_uniform(s, 2); q.w_in = (const float*)(const GAS float*)lds_u64_uniform(s, 3);
    q.b_f = (const float*)(const GAS float*)lds_u64_uniform(s, 4); q.w2 = (const float*)(const GAS float*)lds_u64_uniform(s, 5); q.bg = (const float*)(const GAS float*)lds_u64_uniform(s, 6); q.gla_g = (const float*)(const GAS float*)lds_u64_uniform(s, 7);
    q.fox_g = (const float*)(const GAS float*)lds_u64_uniform(s, 8); q.w_out = (const float*)(const GAS float*)lds_u64_uniform(s, 9); q.g2 = (const float*)(const GAS float*)lds_u64_uniform(s, 10); q.w_rg = (const float*)(const GAS float*)lds_u64_uniform(s, 11);
    q.b_rg = (const float*)(const GAS float*)lds_u64_uniform(s, 12); q.w_re = (const float*)(const GAS float*)lds_u64_uniform(s, 13); q.b_re = (const float*)(const GAS float*)lds_u64_uniform(s, 14); q.wg = (const float*)(const GAS float*)lds_u64_uniform(s, 15);
    q.wu = (const float*)(const GAS float*)lds_u64_uniform(s, 16); q.wd = (const float*)(const GAS float*)lds_u64_uniform(s, 17); q.gf = (const float*)(const GAS float*)lds_u64_uniform(s, 18); q.out = (float*)(GAS float*)lds_u64_uniform(s, 19);
    q.ws = (unsigned char*)(GAS unsigned char*)lds_u64_uniform(s, 20);
    return q;
}
__global__ void __launch_bounds__(512, 2) k_mega(P p) {
    extern __shared__ __attribute__((aligned(16))) unsigned char lds_raw[];
    LAS unsigned char* lds = (LAS unsigned char*)lds_raw;
    for (int u = threadIdx.x; u < (LDS_BYTES - LDSCTL_OFF) / 4; u += 512) ((LAS unsigned*)(lds + LDSCTL_OFF))[u] = 0u;
    __syncthreads();
    if (threadIdx.x == 0) { LAS unsigned long long* s = (LAS unsigned long long*)(lds + P_OFF);
        s[0] = (unsigned long long)p.x; s[1] = (unsigned long long)p.meta; s[2] = (unsigned long long)p.g1; s[3] = (unsigned long long)p.w_in; s[4] = (unsigned long long)p.b_f;
        s[5] = (unsigned long long)p.w2; s[6] = (unsigned long long)p.bg; s[7] = (unsigned long long)p.gla_g; s[8] = (unsigned long long)p.fox_g; s[9] = (unsigned long long)p.w_out;
        s[10] = (unsigned long long)p.g2; s[11] = (unsigned long long)p.w_rg; s[12] = (unsigned long long)p.b_rg; s[13] = (unsigned long long)p.w_re; s[14] = (unsigned long long)p.b_re;
        s[15] = (unsigned long long)p.wg; s[16] = (unsigned long long)p.wu; s[17] = (unsigned long long)p.wd; s[18] = (unsigned long long)p.gf; s[19] = (unsigned long long)p.out;
        s[20] = (unsigned long long)p.ws; }
    if (threadIdx.x == 0) ((LAS int*)(lds + P_OFF))[48] = (int)gridDim.x;
    (void)xcd_barrier_post((unsigned*)(p.ws + OFF_CTL) + CW_BAR, (volatile LAS unsigned*)(lds + MISC_OFF) + 8);
    __syncthreads();
#define LOAD_G() __builtin_amdgcn_readfirstlane(((const volatile LAS int*)(lds + P_OFF))[48])
#define BARRIER() do { XcdBarrier b_; b_.bar = (unsigned*)((unsigned char*)(GAS unsigned char*)lds_u64_uniform((const volatile LAS unsigned long long*)(lds + P_OFF), 20) + OFF_CTL) + CW_BAR; b_.x = xb_xcc_id(); \
        b_.st = (volatile LAS unsigned*)(lds + MISC_OFF) + 8; xcd_barrier(b_); } while (0)
#define DUPVAL() ((int)__builtin_amdgcn_readfirstlane(((const volatile unsigned*)((unsigned char*)(GAS unsigned char*)lds_u64_uniform((const volatile LAS unsigned long long*)(lds + P_OFF), 20) + OFF_CTL))[64]))
#define RUN(k, body) do { { const P q = load_P(lds); const int G = LOAD_G(), bid = blockIdx.x; body; } BARRIER(); \
        if (DUP_PHASE < 0 || DUP_PHASE == (k)) { if (DUP_PHASE == (k) || DUPVAL() == (k)) { { const P q = load_P(lds); const int G = LOAD_G(), bid = blockIdx.x; body; } BARRIER(); } } } while (0)
    RUN(1, phase_prep(q, lds, bid, G));
    RUN(2, phase_inproj(q, lds, G, bid));
    RUN(3, { phase_cscan(q, lds_raw, G, bid); phase_norms(q, lds_raw, G, bid); phase_gla_p1(q, lds_raw, G, bid); });
    RUN(5, { phase_gla_scan(q, G, bid); phase_fox(q, lds_raw, G, bid); });
    RUN(9, phase_gla_p3(q, lds_raw, G, bid));
    RUN(6, phase_outproj(q, lds, G, bid));
    RUN(100, phase_router(q, lds_raw, G, bid));
    RUN(7, phase_moe<0>(q, lds, G, bid));
    RUN(8, phase_moe<1>(q, lds, G, bid));
    RUN(10, phase_moe<2>(q, lds, G, bid));
#undef RUN
    { const P q = load_P(lds); const int G = LOAD_G(), bid = blockIdx.x; phase_final(q, G, bid); }
}

extern "C" void kernel_launch(void* const* d_in, const int* in_sizes, int n_in, void* d_out, int out_size, void* d_ws, size_t ws_size, hipStream_t stream) {
    static int grid = 0;
    if (grid == 0) {
        if (n_in != 19 || ws_size < WS_END2) { fprintf(stderr, "kernel_launch: bad args n_in=%d ws=%zu need %zu\n", n_in, ws_size, (size_t)WS_END2); grid = -1; return; }
        int dev = 0, cus = 0, per_cu = 0;
        if (hipGetDevice(&dev) != hipSuccess || hipDeviceGetAttribute(&cus, hipDeviceAttributeMultiprocessorCount, dev) != hipSuccess || cus <= 0) { fprintf(stderr, "kernel_launch: device query failed\n"); grid = -1; return; }
        if (hipFuncSetAttribute((const void*)k_mega, hipFuncAttributeMaxDynamicSharedMemorySize, LDS_BYTES) != hipSuccess) { fprintf(stderr, "kernel_launch: hipFuncSetAttribute failed\n"); grid = -1; return; }
        if (hipOccupancyMaxActiveBlocksPerMultiprocessor(&per_cu, (const void*)k_mega, 512, LDS_BYTES) != hipSuccess || per_cu < 1) { fprintf(stderr, "kernel_launch: occupancy query says %d blocks per CU\n", per_cu); (void)hipGetLastError(); grid = -1; return; }
        grid = cus;
    }
    if (grid < 0) return;
    P p{};
    p.x = (const float*)d_in[0]; p.meta = (const float*)d_in[1]; p.g1 = (const float*)d_in[2]; p.w_in = (const float*)d_in[3]; p.b_f = (const float*)d_in[4];
    p.w2 = (const float*)d_in[5]; p.bg = (const float*)d_in[6]; p.gla_g = (const float*)d_in[7]; p.fox_g = (const float*)d_in[8]; p.w_out = (const float*)d_in[9];
    p.g2 = (const float*)d_in[10]; p.w_rg = (const float*)d_in[11]; p.b_rg = (const float*)d_in[12]; p.w_re = (const float*)d_in[13]; p.b_re = (const float*)d_in[14];
    p.wg = (const float*)d_in[15]; p.wu = (const float*)d_in[16]; p.wd = (const float*)d_in[17]; p.gf = (const float*)d_in[18];
    p.out = (float*)d_out; p.ws = (unsigned char*)d_ws;
    (void)hipMemsetAsync((char*)d_ws + OFF_CTL, 0, CTL_ZERO_BYTES, stream);
    if (DUP_PHASE < 0) (void)hipMemsetAsync((char*)d_ws + OFF_CTL + 256, -DUP_PHASE - 1, 1, stream);
    hipLaunchKernelGGL(k_mega, dim3(grid), dim3(512), LDS_BYTES, stream, p);
}
```

```cpp
#include <hip/hip_runtime.h>
#include <stdint.h>
#include <cstdio>
#ifndef FOX_SKIP
#define FOX_SKIP 1
#endif
#define CAST_IN_GEMM 2
#ifndef DUP_PHASE
#define DUP_PHASE 0
#endif

typedef unsigned short bf16_t;
#define DM 2048
#define SEQ 8192
#define NMETA 16
#define LR 8256
#define NR_A0 8448
#define NPROJ 6168
#define EPS 1e-6f
#define SCALE128 0.08838834764831845f

__device__ __forceinline__ float bf2f(bf16_t b) { return __uint_as_float(((unsigned)b) << 16); }
__device__ __forceinline__ bf16_t f2bf(float f) { unsigned u = __float_as_uint(f); return (bf16_t)((u + 0x7fffu + ((u >> 16) & 1u)) >> 16); }
__device__ __forceinline__ unsigned pk2(float lo, float hi) { return (unsigned)f2bf(lo) | ((unsigned)f2bf(hi) << 16); }
template <int M> __device__ __forceinline__ float sw_xor(float v) { return __int_as_float(__builtin_amdgcn_ds_swizzle(__float_as_int(v), (M << 10) | 0x1f)); }
__device__ __forceinline__ float x32_sum(float v) { auto r = __builtin_amdgcn_permlane32_swap(__float_as_uint(v), __float_as_uint(v), false, false); return __uint_as_float(r[0]) + __uint_as_float(r[1]); }
__device__ __forceinline__ float x32_max(float v) { auto r = __builtin_amdgcn_permlane32_swap(__float_as_uint(v), __float_as_uint(v), false, false); return fmaxf(__uint_as_float(r[0]), __uint_as_float(r[1])); }
__device__ __forceinline__ float wave_sum(float v) { v += sw_xor<1>(v); v += sw_xor<2>(v); v += sw_xor<4>(v); v += sw_xor<8>(v); v += sw_xor<16>(v); return x32_sum(v); }
__device__ __forceinline__ float wave_max(float v) { v = fmaxf(v, sw_xor<1>(v)); v = fmaxf(v, sw_xor<2>(v)); v = fmaxf(v, sw_xor<4>(v)); v = fmaxf(v, sw_xor<8>(v)); v = fmaxf(v, sw_xor<16>(v)); return x32_max(v); }
__device__ __forceinline__ float shfl_from(float v, int srclane) { return __int_as_float(__builtin_amdgcn_ds_bpermute(srclane << 2, __float_as_int(v))); }
__device__ __forceinline__ int shfl_from_i(int v, int srclane) { return __builtin_amdgcn_ds_bpermute(srclane << 2, v); }
__device__ __forceinline__ float fexp(float x) { return __builtin_amdgcn_exp2f(x * 1.4426950408889634f); }
__device__ __forceinline__ float logsigmoidf(float x) { return fminf(x, 0.f) - 0.6931471805599453f * __builtin_amdgcn_logf(1.f + fexp(-fabsf(x))); }
__device__ __forceinline__ float siluf(float x) { return x * __builtin_amdgcn_rcpf(1.f + fexp(-x)); }

constexpr size_t MiB = 1u << 20;
constexpr size_t OFF_CTL = 0;
constexpr size_t OFF_A0 = 1 * MiB;
constexpr size_t OFF_FQ = OFF_A0 + (size_t)NR_A0 * DM * 2;
constexpr size_t OFF_FK = OFF_FQ + (size_t)8 * SEQ * 128 * 2;
constexpr size_t OFF_FV = OFF_FK + (size_t)8 * LR * 128 * 2;
constexpr size_t OFF_FLOG = OFF_FV + (size_t)8 * LR * 128 * 2;
constexpr size_t OFF_CB = OFF_FLOG + (size_t)8 * LR * 4;
constexpr size_t OFF_GQ = OFF_CB + (size_t)8 * LR * 4;
constexpr size_t OFF_GK = OFF_GQ + (size_t)4 * LR * 128 * 2;
constexpr size_t OFF_GV = OFF_GK + (size_t)4 * LR * 128 * 2;
constexpr size_t OFF_GR = OFF_GV + (size_t)4 * LR * 256 * 2;
constexpr size_t OFF_GZ = OFF_GR + (size_t)SEQ * 1024 * 2;
constexpr size_t OFF_GLAO = OFF_GZ + (size_t)LR * 16 * 4;
constexpr size_t OFF_MIX = OFF_GLAO + (size_t)SEQ * 1024 * 4;
constexpr size_t OFF_U2 = OFF_GV;
constexpr size_t OFF_INVMAP = OFF_MIX + (size_t)SEQ * DM * 2;
constexpr size_t OFF_WTS = OFF_INVMAP + (size_t)32 * SEQ * 4;
constexpr size_t OFF_HBUF = OFF_GLAO;
constexpr size_t OFF_Y = OFF_A0;
constexpr size_t WS_END = OFF_WTS + (size_t)SEQ * 2 * 4;
static_assert(OFF_Y + (size_t)2 * SEQ * DM * 2 <= OFF_FV && OFF_HBUF + (size_t)24576 * 512 * 2 <= OFF_MIX && OFF_U2 + (size_t)SEQ * DM * 2 <= OFF_GZ, "overlays");

struct P {
    const float *x, *meta, *g1, *w_in, *b_f, *w2, *bg, *gla_g, *fox_g, *w_out, *g2, *w_rg, *b_rg, *w_re, *b_re, *wg, *wu, *wd, *gf;
    float* out; unsigned char* ws;
};

#define LAS __attribute__((address_space(3)))
#define GAS __attribute__((address_space(1)))
typedef short bf16x8 __attribute__((ext_vector_type(8)));
typedef short v4i16_t __attribute__((ext_vector_type(4)));
typedef float f32x4 __attribute__((ext_vector_type(4)));
typedef float f32x2 __attribute__((ext_vector_type(2)));
typedef unsigned u32x4 __attribute__((ext_vector_type(4)));
typedef unsigned u32x2 __attribute__((ext_vector_type(2)));
typedef __bf16 bf16x2_t __attribute__((ext_vector_type(2)));
template <class T> __device__ __forceinline__ T nt_load(const T* p) { return __builtin_nontemporal_load(p); }
template <class T> __device__ __forceinline__ void nt_store(T v, T* p) { __builtin_nontemporal_store(v, p); }
__device__ __forceinline__ unsigned cvtpk(float lo, float hi) { f32x2 v = {lo, hi}; bf16x2_t b = __builtin_convertvector(v, bf16x2_t); return __builtin_bit_cast(unsigned, b); }
constexpr int NWAVES = 8;
constexpr int RING_BYTES = 131072, LDSCTL_OFF = RING_BYTES, MISC_OFF = LDSCTL_OFF + 320, LDS_BYTES = 147456;

constexpr size_t OFF_WINT = WS_END;
constexpr size_t OFF_WOUTT = OFF_WINT + (size_t)6176 * DM * 2;
constexpr size_t OFF_WG16 = OFF_WOUTT + (size_t)DM * DM * 2;
constexpr size_t OFF_WU16 = OFF_WG16 + (size_t)32 * DM * 512 * 2;
constexpr size_t OFF_WD16 = OFF_WU16 + (size_t)32 * DM * 512 * 2;
constexpr size_t OFF_DT = OFF_WD16;
constexpr size_t OFF_BBUF = OFF_DT + (size_t)32 * DM * 512 * 2;
constexpr size_t OFF_CDUMMY = OFF_BBUF + (size_t)128 * 4 * 64 * 128 * 4;
constexpr size_t WS_END2 = OFF_CDUMMY + 8192;

namespace pg8 {
constexpr int BM = 256, BK = 64, HALF = 128, HTB = HALF * BK * 2, STAGE_BYTES = 8 * HTB, NXCD = 8, WGM = 8;
__host__ __device__ __forceinline__ int lds_byte(int r, int c) { const int st = (r >> 4) * 2 + (c >> 5), rr = r & 15, cc = c & 31, ob = rr * 64 + cc * 2; return st * 1024 + (ob ^ (((ob >> 9) & 1) << 5)); }
__host__ __device__ __forceinline__ void stage_rc(int b, int& R, int& C) { const int st = b / 1024, sb = b % 1024, swz = sb ^ (((sb >> 9) & 1) << 5); R = (st >> 1) * 16 + swz / 64; C = (st & 1) * 32 + (swz % 64) / 2; }
__host__ __device__ __forceinline__ int perm32(int rho) { const int n = rho >> 4, i = rho & 15; return 8 * (i >> 2) + 4 * n + (i & 3); }

struct Unit { int pm, pn; const char* A; const char* B; int e, rt, ce, hoff, nv; unsigned ldb, bhs; };

struct DenseSched {
    int nM, nN, nwg, G, c, K; const char* A; const char* Bt;
    __device__ void init(int M, int N, int K_, int G_, int c_, const void* A_, const void* Bt_) { nM = M / BM; nN = N / BM; nwg = nM * nN; G = G_; c = c_; K = K_; A = (const char*)A_; Bt = (const char*)Bt_; }
    __device__ bool next(int i, Unit& u) const {
        const long L = (long)i * G + c; if (L >= nwg) return false;
        int wgid = (int)L; { const int q = nwg / NXCD, r = nwg % NXCD, xcd = wgid % NXCD, off = wgid / NXCD; wgid = (xcd < r ? xcd * (q + 1) : r * (q + 1) + (xcd - r) * q) + off; }
        const int nig = WGM * nN, gid = wgid / nig, fm = gid * WGM, gsz = (nM - fm) < WGM ? (nM - fm) : WGM;
        u.pm = fm + ((wgid % nig) % gsz); u.pn = (wgid % nig) / gsz;
        u.A = A + (size_t)u.pm * BM * K * 2; u.B = Bt + (size_t)u.pn * BM * K * 2; u.e = 0; u.rt = 0; u.ce = 0; u.hoff = 0; u.nv = BM; u.ldb = 0; u.bhs = 0; return true;
    }
    __device__ __forceinline__ unsigned arow_off(const Unit&, int R) const { return (unsigned)(R * K * 2); }
};
struct OneUnitSched {
    Unit u; const int* idx; int shift; unsigned rowbytes; int rowadd;
    __device__ bool next(int i, Unit& o) const { if (i != 0) return false; o = u; return true; }
    __device__ __forceinline__ unsigned arow_off(const Unit& uu, int R) const {
        const int pos = uu.rt * BM + R; int row = 0;
        if (pos < uu.ce) row = idx ? (idx[pos] >> shift) : pos;
        return (unsigned)(row + rowadd) * rowbytes;
    }
};

struct CastArgs { const char* s0; const char* s1; const char* s2; char* d; char* dummy; };
template <class Epi, class Sched, bool ALIGN_EPI, bool SP2, bool ROWSKIP = false, bool BNAT = false, int CAST = 0>
__device__ __forceinline__ void gemm_phase(LAS unsigned char* lds, const int K, const Sched& S, const Epi& E, const CastArgs* CA = nullptr) {
    int tid = threadIdx.x; asm volatile("" : "+v"(tid));
    const int wid = __builtin_amdgcn_readfirstlane(tid >> 6), lane = tid & 63, wr = wid >> 2, wc = wid & 3, fr = lane & 15, fq = lane >> 4;
    const int nt = K / BK;
    Unit cur, nxt; int ui = 0;
    if (!S.next(0, cur)) return;
    unsigned voffA[2][2], voffB[2];
#pragma unroll
    for (int i = 0; i < 2; ++i) { int R, C; stage_rc(tid * 16 + i * 8192, R, C); const int Rb = Epi::PERM ? ((R & ~31) + perm32(R & 31)) : R;
        voffA[0][i] = S.arow_off(cur, R) + (unsigned)(C * 2); voffA[1][i] = S.arow_off(cur, HALF + R) + (unsigned)(C * 2); voffB[i] = (unsigned)(Rb * K + C) * 2u;
        if constexpr (BNAT) {
            const int b_ = tid * 16 + i * 8192, k_ = b_ >> 8, p_ = (b_ >> 4) & 15;
            voffB[i] = (unsigned)k_ * cur.ldb + (unsigned)((p_ ^ ((k_ & 3) << 2)) * 16); } }
    const size_t kstep = (size_t)(BK * 2);
    const size_t hstep = (size_t)HALF * K * 2;
    const size_t kstepB = BNAT ? (size_t)BK * cur.ldb : kstep, hstepB = BNAT ? (size_t)cur.bhs : hstep;
    const int boffT = (8 * fq + ((lane >> 2) & 3)) * 256 + ((4 * (wc ^ ((lane >> 2) & 3)) + (lane & 3)) << 4);
    const unsigned ldsw = (unsigned)wid * 1024u;
    const int aoff = lds_byte(wr * 64 + fr, fq * 8), boff = lds_byte(wc * 32 + fr, fq * 8);
#define PG8_SA(b, h) (((b) * 2 + (h)) * HTB)
#define PG8_SB(b, h) ((4 + (b) * 2 + (h)) * HTB)
#define PG8_STAGE(bufoff, gbase, voff) do { _Pragma("unroll") for (int _i = 0; _i < 2; ++_i) \
        __builtin_amdgcn_global_load_lds((const unsigned*)((const char*)(gbase) + (voff)[_i]), (LAS unsigned*)(lds + (bufoff) + ldsw + _i * 8192), 16, 0, 0); } while (0)
#define PG8_LDA(dst, b, h) do { _Pragma("unroll") for (int m = 0; m < 4; ++m) _Pragma("unroll") for (int k = 0; k < 2; ++k) dst[m][k] = *(const LAS bf16x8*)(lds + PG8_SA(b, h) + aoff + m * 2048 + k * 1024); } while (0)
#define PG8_TR(off_) __builtin_amdgcn_ds_read_tr16_b64_v4i16((LAS v4i16_t*)(lds + (off_)))
#define PG8_LDB(dst, b, h) do { _Pragma("unroll") for (int n = 0; n < 2; ++n) _Pragma("unroll") for (int k = 0; k < 2; ++k) { \
        if constexpr (BNAT) { const v4i16_t lo_ = PG8_TR(PG8_SB(b, h) + boffT + k * 8192 + n * 8), hi_ = PG8_TR(PG8_SB(b, h) + boffT + k * 8192 + 1024 + n * 8); \
                              dst[n][k] = (bf16x8){lo_[0], lo_[1], lo_[2], lo_[3], hi_[0], hi_[1], hi_[2], hi_[3]}; } \
        else dst[n][k] = *(const LAS bf16x8*)(lds + PG8_SB(b, h) + boff + n * 2048 + k * 1024); } } while (0)
#define PG8_MMA(ai, bj, At, Bt) do { __builtin_amdgcn_s_setprio(1); \
        if constexpr (!ROWSKIP) { _Pragma("unroll") for (int k = 0; k < 2; ++k) _Pragma("unroll") for (int m = 0; m < 4; ++m) _Pragma("unroll") for (int n = 0; n < 2; ++n) \
            acc[ai][bj][m][n] = __builtin_amdgcn_mfma_f32_16x16x32_bf16(Bt[n][k], At[m][k], acc[ai][bj][m][n], 0, 0, 0); } \
        else { _Pragma("unroll") for (int m = 0; m < 4; ++m) { if (m < mm[ai]) { _Pragma("unroll") for (int k = 0; k < 2; ++k) _Pragma("unroll") for (int n = 0; n < 2; ++n) \
            acc[ai][bj][m][n] = __builtin_amdgcn_mfma_f32_16x16x32_bf16(Bt[n][k], At[m][k], acc[ai][bj][m][n], 0, 0, 0); } } } __builtin_amdgcn_s_setprio(0); } while (0)
#define PG8_WAIT_V(n) asm volatile("s_waitcnt vmcnt(" #n ")" ::: "memory")
#define PG8_WAIT_VC(reg) do { if constexpr (CAST == 1) asm volatile("s_waitcnt vmcnt(12)" : "+v"(reg) :: "memory"); else if constexpr (CAST == 2) asm volatile("s_waitcnt vmcnt(10)" : "+v"(reg) :: "memory"); else PG8_WAIT_V(8); } while (0)
#define PG8_WAIT_L(n) asm volatile("s_waitcnt lgkmcnt(" #n ")" ::: "memory")
#define PG8_BAR __builtin_amdgcn_s_barrier()
#define PG8_SCHED __builtin_amdgcn_sched_barrier(0)
    f32x4 acc[2][2][4][2];
#pragma unroll
    for (int a = 0; a < 2; ++a)
#pragma unroll
        for (int b = 0; b < 2; ++b)
#pragma unroll
            for (int m = 0; m < 4; ++m)
#pragma unroll
                for (int n = 0; n < 2; ++n) acc[a][b][m][n] = (f32x4){0.f, 0.f, 0.f, 0.f};
    bf16x8 At[4][2], B0[2][2], B1[2][2];
    const char* cA = cur.A; const char* cB = cur.B;
    int mm[2];
#define PG8_SETMM(u_) do { _Pragma("unroll") for (int a_ = 0; a_ < 2; ++a_) { int v_ = ((u_).nv - a_ * HALF - wr * 64 + 15) >> 4; mm[a_] = v_ < 0 ? 0 : (v_ > 4 ? 4 : v_); } } while (0)
    PG8_SETMM(cur);
    f32x4 cv0 = (f32x4){0.f, 0.f, 0.f, 0.f}, cv1 = cv0, cv2 = cv0, cv3 = cv0;
    const char* cs0 = nullptr; const char* cs1 = nullptr; const char* cs2 = nullptr; char* cd0 = nullptr;
    const unsigned ctl = (unsigned)tid * 16u;
    constexpr int SPU = CAST == 2 ? 32 : 64;
#define PG8_CSLOT(q_) (CAST == 2 && (q_) >= 16384 ? 16384 + ((((q_) - 16384) >> 4) << 5) + ((q_) & 15) : (q_))
#define PG8_CSRC(s_) ((const GAS char*)((s_) < 16384 ? cs0 : ((s_) < 32768 ? cs1 : cs2)) + (size_t)((s_) & 16383) * 8192)
#define PG8_CLD(reg, k_) do { if constexpr (CAST != 0) { const int sl_ = PG8_CSLOT(cq0 + (k_)); const GAS char* b_ = PG8_CSRC(sl_); \
        asm volatile("global_load_dwordx4 %0, %1, %2 nt" : "=&v"(reg) : "v"(ctl), "s"(b_) : "memory"); } } while (0)
#define PG8_CSTA(reg, addr_) do { unsigned o_; asm volatile("v_lshrrev_b32 %0, 1, %1" : "=v"(o_) : "v"(ctl)); GAS char* sb_ = (GAS char*)(addr_); \
        const u32x2 pk_ = (u32x2){cvtpk(reg[0], reg[1]), cvtpk(reg[2], reg[3])}; asm volatile("global_store_dwordx2 %0, %1, %2 nt" :: "v"(o_), "v"(pk_), "s"(sb_) : "memory"); } while (0)
#define PG8_CST(reg, k_) do { if constexpr (CAST != 0) { const int kk_ = (k_); char* da_; \
        if (kk_ >= 0) da_ = cd0 + (size_t)PG8_CSLOT(cq0 + kk_) * 4096; else if (ui > 0) da_ = cd0 + (size_t)PG8_CSLOT(cq0 - S.G * SPU + SPU + kk_) * 4096; else da_ = cdummy; PG8_CSTA(reg, da_); } } while (0)
    int cq0 = 0; char* cdummy = nullptr;
    if constexpr (CAST != 0) {
        cs0 = CA->s0; cs1 = CA->s1; cs2 = CA->s2; cd0 = CA->d; cdummy = CA->dummy;
        asm volatile("" : "+s"(cs0), "+s"(cs1), "+s"(cs2), "+s"(cd0), "+s"(cdummy));
        cq0 = S.c * SPU;
    }
    if constexpr (SP2) {
        PG8_STAGE(PG8_SB(0, 0), cB, voffB); PG8_STAGE(PG8_SB(0, 1), cB + hstepB, voffB); PG8_STAGE(PG8_SA(0, 0), cA, voffA[0]); PG8_STAGE(PG8_SA(0, 1), cA, voffA[1]);
        if (wr == 1) PG8_BAR;
        PG8_WAIT_V(2); PG8_BAR;
        PG8_STAGE(PG8_SB(1, 0), cB + kstepB, voffB); PG8_STAGE(PG8_SA(1, 0), cA + kstep, voffA[0]); PG8_STAGE(PG8_SB(1, 1), cB + hstepB + kstepB, voffB);
        PG8_WAIT_V(6); PG8_BAR;
        if constexpr (CAST != 0) { PG8_CSTA(cv0, cdummy); }
    } else {
        PG8_STAGE(PG8_SB(0, 0), cB, voffB); PG8_STAGE(PG8_SA(0, 0), cA, voffA[0]); PG8_STAGE(PG8_SB(0, 1), cB + hstepB, voffB); PG8_STAGE(PG8_SA(0, 1), cA, voffA[1]);
        if (wr == 1) PG8_BAR;
        PG8_WAIT_V(4); PG8_BAR;
        PG8_STAGE(PG8_SB(1, 0), cB + kstepB, voffB); PG8_STAGE(PG8_SA(1, 0), cA + kstep, voffA[0]); PG8_STAGE(PG8_SB(1, 1), cB + hstepB + kstepB, voffB);
        PG8_WAIT_V(6); PG8_BAR;
    }
    for (;;) {
        const bool has_next = S.next(ui + 1, nxt);
        const char* nA = has_next ? nxt.A : cA; const char* nB = has_next ? nxt.B : cB;
        for (int t = 0; t < nt; t += 2) {
            const bool last = (t == nt - 2);
            const char* a1 = cA + (size_t)(t + 1) * kstep;
            const char* a2 = last ? nA : cA + (size_t)(t + 2) * kstep; const char* b2 = last ? nB : cB + (size_t)(t + 2) * kstepB;
            const char* a3 = a2 + kstep; const char* b3 = b2 + kstepB;
            if constexpr (SP2) {
            if constexpr (CAST == 2) {
            PG8_LDB(B0, 0, 0); PG8_LDB(B1, 0, 1); PG8_SCHED; PG8_LDA(At, 0, 0); PG8_STAGE(PG8_SA(1, 1), a1, voffA[1]); PG8_CLD(cv0, t);
            PG8_WAIT_VC(cv2); PG8_WAIT_L(0); PG8_BAR; PG8_CST(cv2, t - 1); PG8_MMA(0, 0, At, B0); PG8_MMA(0, 1, At, B1); PG8_BAR; PG8_SCHED;
            PG8_LDA(At, 0, 1); PG8_STAGE(PG8_SB(0, 0), b2, voffB); PG8_STAGE(PG8_SB(0, 1), b2 + hstepB, voffB); PG8_STAGE(PG8_SA(0, 0), a2, voffA[0]);
            PG8_WAIT_V(10); PG8_WAIT_L(0); PG8_BAR; PG8_MMA(1, 0, At, B0); PG8_MMA(1, 1, At, B1); PG8_BAR; PG8_SCHED;
            PG8_LDB(B0, 1, 0); PG8_LDB(B1, 1, 1); PG8_SCHED; PG8_LDA(At, 1, 0); PG8_STAGE(PG8_SA(0, 1), a2, voffA[1]); PG8_CLD(cv2, t + 1);
            PG8_WAIT_VC(cv0); PG8_WAIT_L(0); PG8_BAR; PG8_CST(cv0, t); PG8_MMA(0, 0, At, B0); PG8_MMA(0, 1, At, B1); PG8_BAR; PG8_SCHED;
            PG8_LDA(At, 1, 1); PG8_STAGE(PG8_SB(1, 0), b3, voffB); PG8_STAGE(PG8_SB(1, 1), b3 + hstepB, voffB); PG8_STAGE(PG8_SA(1, 0), a3, voffA[0]);
            PG8_WAIT_V(10); PG8_WAIT_L(0); PG8_BAR; PG8_MMA(1, 0, At, B0); PG8_MMA(1, 1, At, B1); PG8_BAR; PG8_SCHED;
            } else {
            PG8_LDB(B0, 0, 0); PG8_LDB(B1, 0, 1); PG8_SCHED; PG8_LDA(At, 0, 0); PG8_STAGE(PG8_SA(1, 1), a1, voffA[1]); PG8_CLD(cv0, 2 * t + 0);
            PG8_WAIT_VC(cv2); PG8_WAIT_L(0); PG8_BAR; PG8_CST(cv2, 2 * t - 2); PG8_MMA(0, 0, At, B0); PG8_MMA(0, 1, At, B1); PG8_BAR; PG8_SCHED;
            PG8_LDA(At, 0, 1); PG8_STAGE(PG8_SB(0, 0), b2, voffB); PG8_STAGE(PG8_SB(0, 1), b2 + hstepB, voffB); PG8_STAGE(PG8_SA(0, 0), a2, voffA[0]); PG8_CLD(cv1, 2 * t + 1);
            PG8_WAIT_VC(cv3); PG8_WAIT_L(0); PG8_BAR; PG8_CST(cv3, 2 * t - 1); PG8_MMA(1, 0, At, B0); PG8_MMA(1, 1, At, B1); PG8_BAR; PG8_SCHED;
            PG8_LDB(B0, 1, 0); PG8_LDB(B1, 1, 1); PG8_SCHED; PG8_LDA(At, 1, 0); PG8_STAGE(PG8_SA(0, 1), a2, voffA[1]); PG8_CLD(cv2, 2 * t + 2);
            PG8_WAIT_VC(cv0); PG8_WAIT_L(0); PG8_BAR; PG8_CST(cv0, 2 * t); PG8_MMA(0, 0, At, B0); PG8_MMA(0, 1, At, B1); PG8_BAR; PG8_SCHED;
            PG8_LDA(At, 1, 1); PG8_STAGE(PG8_SB(1, 0), b3, voffB); PG8_STAGE(PG8_SB(1, 1), b3 + hstepB, voffB); PG8_STAGE(PG8_SA(1, 0), a3, voffA[0]); PG8_CLD(cv3, 2 * t + 3);
            PG8_WAIT_VC(cv1); PG8_WAIT_L(0); PG8_BAR; PG8_CST(cv1, 2 * t + 1); PG8_MMA(1, 0, At, B0); PG8_MMA(1, 1, At, B1); PG8_BAR; PG8_SCHED;
            }
            } else {
            PG8_LDB(B0, 0, 0); PG8_SCHED; PG8_LDA(At, 0, 0); PG8_STAGE(PG8_SA(1, 1), a1, voffA[1]);
            PG8_WAIT_L(8); PG8_BAR; PG8_WAIT_L(0); PG8_MMA(0, 0, At, B0); PG8_BAR; PG8_SCHED;
            PG8_LDB(B1, 0, 1); PG8_STAGE(PG8_SB(0, 0), b2, voffB);
            PG8_BAR; PG8_WAIT_L(0); PG8_MMA(0, 1, At, B1); PG8_BAR;
            PG8_LDA(At, 0, 1); PG8_STAGE(PG8_SA(0, 0), a2, voffA[0]);
            PG8_BAR; PG8_WAIT_L(0); PG8_MMA(1, 0, At, B0); PG8_BAR; PG8_SCHED;
            PG8_STAGE(PG8_SB(0, 1), b2 + hstepB, voffB);
            PG8_WAIT_V(6); PG8_BAR; PG8_MMA(1, 1, At, B1); PG8_BAR;
            PG8_LDB(B0, 1, 0); PG8_SCHED; PG8_LDA(At, 1, 0); PG8_STAGE(PG8_SA(0, 1), a2, voffA[1]);
            PG8_WAIT_L(8); PG8_BAR; PG8_WAIT_L(0); PG8_MMA(0, 0, At, B0); PG8_BAR; PG8_SCHED;
            PG8_LDB(B1, 1, 1); PG8_STAGE(PG8_SB(1, 0), b3, voffB);
            PG8_BAR; PG8_WAIT_L(0); PG8_MMA(0, 1, At, B1); PG8_BAR;
            PG8_LDA(At, 1, 1); PG8_STAGE(PG8_SA(1, 0), a3, voffA[0]);
            PG8_BAR; PG8_WAIT_L(0); PG8_MMA(1, 0, At, B0); PG8_BAR; PG8_SCHED;
            PG8_STAGE(PG8_SB(1, 1), b3 + hstepB, voffB);
            PG8_WAIT_V(6); PG8_BAR; PG8_MMA(1, 1, At, B1); PG8_BAR;
            }
        }
        if constexpr (ALIGN_EPI) { if (wr == 0) PG8_BAR; }
        E(acc, cur, wr, wc, fr, fq);
        if (!has_next) break;
#pragma unroll
        for (int a = 0; a < 2; ++a)
#pragma unroll
            for (int b = 0; b < 2; ++b)
#pragma unroll
                for (int m = 0; m < 4; ++m)
#pragma unroll
                    for (int n = 0; n < 2; ++n) acc[a][b][m][n] = (f32x4){0.f, 0.f, 0.f, 0.f};
        cur = nxt; cA = nA; cB = nB; ++ui; PG8_SETMM(cur); if constexpr (CAST != 0) cq0 = (ui * S.G + S.c) * SPU;
        if constexpr (ALIGN_EPI) { if (wr == 1) PG8_BAR; }
    }
    if constexpr (CAST == 1) { asm volatile("s_waitcnt vmcnt(0)" : "+v"(cv2), "+v"(cv3) :: "memory"); PG8_CST(cv2, 62); PG8_CST(cv3, 63); }
    if constexpr (CAST == 2) { asm volatile("s_waitcnt vmcnt(0)" : "+v"(cv2) :: "memory"); PG8_CST(cv2, 31); }
    PG8_WAIT_V(0);
    if constexpr (!ALIGN_EPI) { if (wr == 0) PG8_BAR; }
    PG8_BAR;
#undef PG8_CSLOT
#undef PG8_CSRC
#undef PG8_CLD
#undef PG8_CSTA
#undef PG8_CST
#undef PG8_WAIT_VC
#undef PG8_SETMM
#undef PG8_SA
#undef PG8_SB
#undef PG8_STAGE
#undef PG8_LDA
#undef PG8_LDB
#undef PG8_TR
#undef PG8_MMA
#undef PG8_WAIT_V
#undef PG8_WAIT_L
#undef PG8_BAR
#undef PG8_SCHED
}
}

__device__ __forceinline__ void inproj_dest(int t, size_t& off, int& stride, bool& xonly) {
    xonly = false;
    if (t < 8) { off = OFF_FQ + (size_t)t * SEQ * 256; stride = 128; xonly = true; }
    else if (t < 16) { off = OFF_FK + (size_t)(t - 8) * LR * 256; stride = 128; }
    else if (t < 24) { off = OFF_FV + (size_t)(t - 16) * LR * 256; stride = 128; }
    else if (t < 28) { off = OFF_GQ + (size_t)(t - 24) * LR * 256; stride = 128; }
    else if (t < 32) { off = OFF_GK + (size_t)(t - 28) * LR * 256; stride = 128; }
    else if (t < 40) { off = OFF_GV + (size_t)((t - 32) >> 1) * LR * 512 + (size_t)((t & 1) * 256); stride = 256; }
    else { off = OFF_GR + (size_t)(t - 40) * 256; stride = 1024; xonly = true; }
}
struct EpiInproj {
    static constexpr bool PERM = true;
    unsigned char* ws;
    __device__ __forceinline__ void operator()(const f32x4 (&acc)[2][2][4][2], const pg8::Unit& u, int wr, int wc, int fr, int fq) const {
        const int rbase = u.pm * 256 + wr * 64 + fr;
#pragma unroll
        for (int bj = 0; bj < 2; ++bj) {
            size_t off; int stride; bool xonly;
            inproj_dest(u.pn * 2 + bj, off, stride, xonly);
            bf16_t* base = (bf16_t*)(ws + off) + wc * 32 + 8 * fq + (size_t)(xonly ? 0 : 64) * stride;
#pragma unroll
            for (int ai = 0; ai < 2; ++ai)
#pragma unroll
                for (int m = 0; m < 4; ++m) {
                    const int prow = rbase + ai * 128 + m * 16;
                    const f32x4 v0 = acc[ai][bj][m][0], v1 = acc[ai][bj][m][1];
                    u32x4 w; w.x = cvtpk(v0[0], v0[1]); w.y = cvtpk(v0[2], v0[3]); w.z = cvtpk(v1[0], v1[1]); w.w = cvtpk(v1[2], v1[3]);
                    *(u32x4*)(base + (size_t)prow * stride) = w;
                }
        }
    }
};
struct EpiOutproj {
    static constexpr bool PERM = false;
    const float* x; float* out;
    __device__ __forceinline__ void operator()(const f32x4 (&acc)[2][2][4][2], const pg8::Unit& u, int wr, int wc, int fr, int fq) const {
        const int col0 = u.pn * 256 + wc * 32 + 4 * fq;
#pragma unroll
        for (int ai = 0; ai < 2; ++ai)
#pragma unroll
            for (int m = 0; m < 4; ++m) {
                const size_t off = (size_t)(u.pm * 256 + ai * 128 + wr * 64 + m * 16 + fr) * DM + col0;
#pragma unroll
                for (int bj = 0; bj < 2; ++bj)
#pragma unroll
                    for (int n = 0; n < 2; ++n) { const f32x4 xv = nt_load((const f32x4*)(x + off + bj * 128 + n * 16)); *(f32x4*)(out + off + bj * 128 + n * 16) = xv + acc[ai][bj][m][n]; }
            }
    }
};
struct EpiGateUp {
    static constexpr bool PERM = true;
    bf16_t* HB;
    __device__ __forceinline__ void operator()(const f32x4 (&acc)[2][2][4][2], const pg8::Unit& u, int wr, int wc, int fr, int fq) const {
        const int col = u.pn * 128 + wc * 32 + 8 * fq;
#pragma unroll
        for (int ai = 0; ai < 2; ++ai)
#pragma unroll
            for (int m = 0; m < 4; ++m) {
                const int pos = u.rt * 256 + ai * 128 + wr * 64 + m * 16 + fr;
                if (pos >= u.ce) continue;
                const f32x4 g0 = acc[ai][0][m][0], g1 = acc[ai][0][m][1], u0 = acc[ai][1][m][0], u1 = acc[ai][1][m][1];
                u32x4 w; w.x = cvtpk(siluf(g0[0]) * u0[0], siluf(g0[1]) * u0[1]); w.y = cvtpk(siluf(g0[2]) * u0[2], siluf(g0[3]) * u0[3]);
                w.z = cvtpk(siluf(g1[0]) * u1[0], siluf(g1[1]) * u1[1]); w.w = cvtpk(siluf(g1[2]) * u1[2], siluf(g1[3]) * u1[3]);
                *(u32x4*)(HB + (size_t)(u.hoff + pos) * 512 + col) = w;
            }
    }
};
struct EpiDown {
    static constexpr bool PERM = true;
    bf16_t* Y; const int* invmap; const float* wts;
    __device__ __forceinline__ void operator()(const f32x4 (&acc)[2][2][4][2], const pg8::Unit& u, int wr, int wc, int fr, int fq) const {
        const int col = u.pn * 256 + wc * 32 + 8 * fq;
#pragma unroll
        for (int ai = 0; ai < 2; ++ai)
#pragma unroll
            for (int m = 0; m < 4; ++m) {
                const int pos = u.rt * 256 + ai * 128 + wr * 64 + m * 16 + fr;
                if (pos >= u.ce) continue;
                const int t2 = invmap[(size_t)u.e * SEQ + pos]; const float wt = wts[t2];
                bf16_t* dst = Y + (size_t)(t2 & 1) * SEQ * DM + (size_t)(t2 >> 1) * DM + col;
#pragma unroll
                for (int bj = 0; bj < 2; ++bj) { const f32x4 v0 = acc[ai][bj][m][0] * wt, v1 = acc[ai][bj][m][1] * wt;
                    u32x4 w; w.x = cvtpk(v0[0], v0[1]); w.y = cvtpk(v0[2], v0[3]); w.z = cvtpk(v1[0], v1[1]); w.w = cvtpk(v1[2], v1[3]);
                    *(u32x4*)(dst + bj * 128) = w; }
            }
    }
};

struct TrLoad { f32x4 v[8]; };
template <class ColFn>
__device__ __forceinline__ void tr_issue(TrLoad& t, const float* W, int ldw, ColFn colfn, int k0, int lane) {
    const int kq = lane >> 3, nq = lane & 7, sc = colfn(nq);
#pragma unroll
    for (int i = 0; i < 8; ++i) t.v[i] = sc >= 0 ? nt_load((const f32x4*)(W + (size_t)(k0 + 8 * i + kq) * ldw + sc)) : (f32x4){0.f, 0.f, 0.f, 0.f};
}
__device__ __forceinline__ void tr_finish(const TrLoad& t, bf16_t* WTrow0  , int K, int k0, LAS float* scr, int lane) {
    const int kq = lane >> 3, nq = lane & 7;
#pragma unroll
    for (int i = 0; i < 8; ++i) { LAS float* d = scr + (8 * i + kq) * 33 + 4 * nq; d[0] = t.v[i][0]; d[1] = t.v[i][1]; d[2] = t.v[i][2]; d[3] = t.v[i][3]; }
    asm volatile("s_waitcnt lgkmcnt(0)" ::: "memory");
    const int c = lane & 7;
#pragma unroll
    for (int j = 0; j < 4; ++j) { const int n = (lane >> 3) + 8 * j; const LAS float* s = scr + (8 * c) * 33 + n;
        u32x4 o; o.x = cvtpk(s[0 * 33], s[1 * 33]); o.y = cvtpk(s[2 * 33], s[3 * 33]); o.z = cvtpk(s[4 * 33], s[5 * 33]); o.w = cvtpk(s[6 * 33], s[7 * 33]);
        *(u32x4*)(WTrow0 + (size_t)n * K + k0 + 8 * c) = o; }
    asm volatile("s_waitcnt lgkmcnt(0)" ::: "memory");
}
struct RowLoad { f32x4 v[8]; };
__device__ __forceinline__ void row_issue(RowLoad& r, const P& p, int row, int lane) {
    const float* src = row < SEQ ? p.x + (size_t)row * DM : p.meta + (size_t)(row - SEQ) * DM;
#pragma unroll
    for (int j = 0; j < 8; ++j) r.v[j] = nt_load((const f32x4*)src + lane + 64 * j);
}
__device__ __forceinline__ void row_finish(const RowLoad& r, const P& p, int row, int lane) {
    uint2* dst = (uint2*)((bf16_t*)(p.ws + OFF_A0) + (size_t)row * DM);
    float ss = 0.f;
#pragma unroll
    for (int j = 0; j < 8; ++j) ss += (r.v[j][0] * r.v[j][0] + r.v[j][1] * r.v[j][1]) + (r.v[j][2] * r.v[j][2] + r.v[j][3] * r.v[j][3]);
    ss = wave_sum(ss);
    const float rs = rsqrtf(ss * (1.f / DM) + EPS);
#pragma unroll
    for (int j = 0; j < 8; ++j) {
        const float4 g = ((const float4*)p.g1)[lane + 64 * j];
        dst[lane + 64 * j] = make_uint2(cvtpk(r.v[j][0] * rs * g.x, r.v[j][1] * rs * g.y), cvtpk(r.v[j][2] * rs * g.z, r.v[j][3] * rs * g.w));
    }
}
constexpr size_t EXP_NG4 = (size_t)32 * DM * 512 / 4;
__device__ __forceinline__ void cast_family(const float* src, unsigned char* dstb, size_t gt, size_t NT, size_t lo, size_t hi) {
    const f32x4* s4 = (const f32x4*)src; uint2* d2 = (uint2*)dstb;
#define CST(i_, v_) d2[i_] = make_uint2(cvtpk(v_[0], v_[1]), cvtpk(v_[2], v_[3]))
    size_t i0 = lo + gt;
    for (; i0 + 7 * NT < hi; i0 += 8 * NT) {
        const f32x4 v0 = s4[i0], v1 = s4[i0 + NT], v2 = s4[i0 + 2 * NT], v3 = s4[i0 + 3 * NT], v4 = s4[i0 + 4 * NT], v5 = s4[i0 + 5 * NT], v6 = s4[i0 + 6 * NT], v7 = s4[i0 + 7 * NT];
        CST(i0, v0); CST(i0 + NT, v1); CST(i0 + 2 * NT, v2); CST(i0 + 3 * NT, v3); CST(i0 + 4 * NT, v4); CST(i0 + 5 * NT, v5); CST(i0 + 6 * NT, v6); CST(i0 + 7 * NT, v7);
    }
    for (; i0 < hi; i0 += NT) { const f32x4 v = s4[i0]; CST(i0, v); }
#undef CST
}
__device__ __forceinline__ void phase_prep(const P& p, LAS unsigned char* lds, int vcu, int G) {
    int tid = threadIdx.x; asm volatile("" : "+v"(tid));
    const int lane = tid & 63, wave = __builtin_amdgcn_readfirstlane(tid >> 6);
    LAS float* scr = (LAS float*)(lds + wave * 16384);
    const int gw = vcu * NWAVES + wave, NGW = G * NWAVES;
    { const int gt = vcu * 512 + tid, NT = G * 512;
      bf16_t* FK = (bf16_t*)(p.ws + OFF_FK); bf16_t* FV = (bf16_t*)(p.ws + OFF_FV);
      bf16_t* GQ = (bf16_t*)(p.ws + OFF_GQ); bf16_t* GK = (bf16_t*)(p.ws + OFF_GK); bf16_t* GV = (bf16_t*)(p.ws + OFF_GV);
      float* FLOG = (float*)(p.ws + OFF_FLOG); float* GZ = (float*)(p.ws + OFF_GZ);
      for (int i = gt; i < 8 * 48 * 128; i += NT) { const int h = i / (48 * 128), r = i % (48 * 128); FK[(size_t)h * LR * 128 + r] = 0; FV[(size_t)h * LR * 128 + r] = 0;
          if (h < 4) { GQ[(size_t)h * LR * 128 + r] = 0; GK[(size_t)h * LR * 128 + r] = 0; } }
      for (int i = gt; i < 4 * 48 * 256; i += NT) { const int h = i / (48 * 256), r = i % (48 * 256); GV[(size_t)h * LR * 256 + r] = 0; }
      for (int i = gt; i < 8 * 48; i += NT) FLOG[i] = 0.f;
      for (int i = gt; i < 48 * 16; i += NT) GZ[i] = 0.f; }
    constexpr int I_IN = 193 * 32, I_OUT = 64 * 32, I_ALL = I_IN + I_OUT;
    auto issue = [&](TrLoad& t, int it, bf16_t*& dst, int& K, int& k0) {
        int r = it;
        if (r < I_IN) { const int nb = r % 193, kb = r / 193, n0 = nb * 32; K = DM; k0 = kb * 64; dst = (bf16_t*)(p.ws + OFF_WINT) + (size_t)n0 * DM;
            tr_issue(t, p.w_in, NPROJ, [&](int g) { const int n = n0 + 4 * g; if (n < 3072) return n; if (n < 6144) return n + 8; if (n < 6152) return n - 3072; if (n < 6168) return n; return -1; }, k0, lane); return; }
        r -= I_IN;
        if (r < I_OUT) { const int nb = r & 63, kb = r >> 6, n0 = nb * 32; K = DM; k0 = kb * 64; dst = (bf16_t*)(p.ws + OFF_WOUTT) + (size_t)n0 * DM;
            tr_issue(t, p.w_out, DM, [&](int g) { return n0 + 4 * g; }, k0, lane); return; }
    };
    { int r = gw, it = gw;
      while (r < SEQ + NMETA || it < I_ALL) {
        RowLoad ra, rb; TrLoad ta, tb; bf16_t* da = nullptr; bf16_t* db = nullptr; int Ka = 0, Kb = 0, k0a = 0, k0b = 0;
        const bool hr0 = r < SEQ + NMETA, hr1 = r + NGW < SEQ + NMETA, ht0 = it < I_ALL, ht1 = it + NGW < I_ALL;
        if (hr0) row_issue(ra, p, r, lane);
        if (hr1) row_issue(rb, p, r + NGW, lane);
        if (ht0) issue(ta, it, da, Ka, k0a);
        if (ht1) issue(tb, it + NGW, db, Kb, k0b);
        __builtin_amdgcn_sched_barrier(0);
        if (hr0) row_finish(ra, p, r, lane);
        if (hr1) row_finish(rb, p, r + NGW, lane);
        if (ht0) tr_finish(ta, da, Ka, k0a, scr, lane);
        if (ht1) tr_finish(tb, db, Kb, k0b, scr, lane);
        r += 2 * NGW; it += 2 * NGW;
      } }
}
__device__ __forceinline__ void phase_inproj(const P& p, LAS unsigned char* lds, int G, int bid) {
    { pg8::DenseSched S; S.init(SEQ, 6144, DM, G, bid, p.ws + OFF_A0, p.ws + OFF_WINT);
      EpiInproj E{p.ws};
      static_assert((SEQ / 256) * (6144 / 256) == 768 && DM / 64 == 32, "cast stream: 768 units x 64 phases x 512 float4 = the three expert weight families");
      const pg8::CastArgs CA{(const char*)p.wg, (const char*)p.wu, (const char*)p.wd, (char*)(p.ws + OFF_WG16), (char*)(p.ws + OFF_CDUMMY)};
      pg8::gemm_phase<EpiInproj, pg8::DenseSched, true, true, false, false, CAST_IN_GEMM>(lds, DM, S, E, &CA); }
    int tid = threadIdx.x; asm volatile("" : "+v"(tid));
    const int lane = tid & 63, w = __builtin_amdgcn_readfirstlane(tid >> 6), r16 = lane & 15, q = lane >> 4;
    LAS float* part = (LAS float*)lds;
    for (int j = bid; j < 192; j += G) {
        const bf16_t* Ap = (const bf16_t*)(p.ws + OFF_A0) + (size_t)(SEQ + r16) * DM + 256 * w + 8 * q;
        const bf16_t* Bp = (const bf16_t*)(p.ws + OFF_WINT) + (size_t)(32 * j + r16) * DM + 256 * w + 8 * q;
        f32x4 acc0 = (f32x4){0.f, 0.f, 0.f, 0.f}, acc1 = acc0;
#pragma unroll
        for (int ks = 0; ks < 8; ++ks) {
            const bf16x8 af = *(const bf16x8*)(Ap + 32 * ks), b0 = *(const bf16x8*)(Bp + 32 * ks), b1 = *(const bf16x8*)(Bp + (size_t)16 * DM + 32 * ks);
            acc0 = __builtin_amdgcn_mfma_f32_16x16x32_bf16(af, b0, acc0, 0, 0, 0);
            acc1 = __builtin_amdgcn_mfma_f32_16x16x32_bf16(af, b1, acc1, 0, 0, 0);
        }
#pragma unroll
        for (int i = 0; i < 4; ++i) { part[((w * 2 + 0) * 16 + 4 * q + i) * 16 + r16] = acc0[i]; part[((w * 2 + 1) * 16 + 4 * q + i) * 16 + r16] = acc1[i]; }
        __syncthreads();
        { const int m = tid >> 5, cl = tid & 31; float sum = 0.f;
#pragma unroll
          for (int ww = 0; ww < 8; ++ww) sum += part[((ww * 2 + (cl >> 4)) * 16 + m) * 16 + (cl & 15)];
          const int c = 32 * j + cl; size_t off; int stride; bool xonly;
          inproj_dest(c >> 7, off, stride, xonly);
          if (!xonly) ((bf16_t*)(p.ws + off))[(size_t)(48 + m) * stride + (c & 127)] = f2bf(sum); }
        __syncthreads();
    }
    for (int i = bid; i < 257; i += G) {
        const bf16_t* Ap = (const bf16_t*)(p.ws + OFF_A0) + (size_t)(32 * i + r16) * DM + 256 * w + 8 * q;
        const bf16_t* Bp = (const bf16_t*)(p.ws + OFF_WINT) + (size_t)(6144 + r16) * DM + 256 * w + 8 * q;
        f32x4 acc[2][2];
#pragma unroll
        for (int a_ = 0; a_ < 2; ++a_)
#pragma unroll
            for (int b_ = 0; b_ < 2; ++b_) acc[a_][b_] = (f32x4){0.f, 0.f, 0.f, 0.f};
#pragma unroll
        for (int ks = 0; ks < 8; ++ks) {
            const bf16x8 a0 = *(const bf16x8*)(Ap + 32 * ks), a1 = *(const bf16x8*)(Ap + (size_t)16 * DM + 32 * ks);
            const bf16x8 b0 = *(const bf16x8*)(Bp + 32 * ks), b1 = *(const bf16x8*)(Bp + (size_t)16 * DM + 32 * ks);
            acc[0][0] = __builtin_amdgcn_mfma_f32_16x16x32_bf16(a0, b0, acc[0][0], 0, 0, 0); acc[0][1] = __builtin_amdgcn_mfma_f32_16x16x32_bf16(a0, b1, acc[0][1], 0, 0, 0);
            acc[1][0] = __builtin_amdgcn_mfma_f32_16x16x32_bf16(a1, b0, acc[1][0], 0, 0, 0); acc[1][1] = __builtin_amdgcn_mfma_f32_16x16x32_bf16(a1, b1, acc[1][1], 0, 0, 0);
        }
#pragma unroll
        for (int a_ = 0; a_ < 2; ++a_)
#pragma unroll
            for (int b_ = 0; b_ < 2; ++b_)
#pragma unroll
                for (int ii = 0; ii < 4; ++ii) part[((w * 4 + a_ * 2 + b_) * 16 + 4 * q + ii) * 16 + r16] = acc[a_][b_][ii];
        __syncthreads();
#pragma unroll
        for (int o = 0; o < 2; ++o) { const int idx = tid + 512 * o, row = idx >> 5, col = idx & 31; float sum = 0.f;
#pragma unroll
            for (int ww = 0; ww < 8; ++ww) sum += part[((ww * 4 + (row >> 4) * 2 + (col >> 4)) * 16 + (row & 15)) * 16 + (col & 15)];
            const int prow = 32 * i + row;
            if (prow < SEQ + NMETA && col < 24) { const int lrow = prow < SEQ ? 64 + prow : 48 + (prow - SEQ);
                if (col < 8) ((float*)(p.ws + OFF_FLOG))[(size_t)lrow * 8 + col] = sum; else ((float*)(p.ws + OFF_GZ))[(size_t)lrow * 16 + (col - 8)] = sum; } }
        __syncthreads();
    }
}
__device__ __forceinline__ void phase_outproj(const P& p, LAS unsigned char* lds, int G, int bid) {
    pg8::DenseSched S; S.init(SEQ, DM, DM, G, bid, p.ws + OFF_MIX, p.ws + OFF_WOUTT);
    EpiOutproj E{p.x, p.out};
    pg8::gemm_phase<EpiOutproj, pg8::DenseSched, true, true>(lds, DM, S, E);
}
constexpr int MOE_PLAN_OFF = LDSCTL_OFF + 1024;
struct MoeLane { int e, ce, nt, nbig, nsm, hoff, ib4, is4, ib8, is8, tb4, ts4, tb8, ts8; };
__device__ __forceinline__ MoeLane moe_lane(const unsigned* cnt, int tid) {
    MoeLane m; m.e = tid & 31;
    m.ce = (int)cnt[m.e]; m.nt = (m.ce + 255) >> 8; const int lastrows = m.ce - (m.nt - 1) * 256;
    m.nbig = (m.nt > 0 && lastrows < 128) ? m.nt - 1 : m.nt; m.nsm = m.nt - m.nbig;
    int pb = m.nbig, ps = m.nsm, ph = m.nt * 256;
#pragma unroll
    for (int o = 1; o < 32; o <<= 1) { const int tb = shfl_from_i(pb, tid - o), ts = shfl_from_i(ps, tid - o), th = shfl_from_i(ph, tid - o); if (m.e >= o) { pb += tb; ps += ts; ph += th; } }
    const int totb = shfl_from_i(pb, 31), tots = shfl_from_i(ps, 31);
    m.hoff = ph - m.nt * 256; m.ib4 = pb * 4; m.is4 = ps * 4; m.ib8 = pb * 8; m.is8 = ps * 8; m.tb4 = totb * 4; m.ts4 = tots * 4; m.tb8 = totb * 8; m.ts8 = tots * 8;
    return m;
}
__device__ __forceinline__ void moe_rec(LAS unsigned char* lds, int k, const MoeLane& m, int tid, int ncol, bool small, int idx, int type) {
    const int incl = small ? (ncol == 4 ? m.is4 : m.is8) : (ncol == 4 ? m.ib4 : m.ib8);
    const int mine = (small ? m.nsm : m.nbig) * ncol, excl = incl - mine;
    const bool hit = idx >= 0 && idx >= excl && idx < incl && tid < 32;
    const unsigned long long bm = __ballot(hit);
    LAS int* rec = (LAS int*)(lds + MOE_PLAN_OFF) + k * 8;
    if (bm == 0ull) { if (tid == 0) rec[0] = -1; }
    else if (hit) { const int loc = idx - excl, rt = (small ? m.nbig : 0) + loc / ncol; rec[0] = m.e; rec[1] = rt; rec[2] = loc % ncol; rec[3] = m.ce; rec[4] = m.hoff;
                    const int nv = m.ce - rt * 256; rec[5] = nv > 256 ? 256 : nv; rec[6] = type; }
}
template <int PHASE> __device__ __forceinline__ void moe_plan(const unsigned* cnt, int G, int c, LAS unsigned char* lds) {
    int tid = threadIdx.x; asm volatile("" : "+v"(tid));
    if (tid < 64) {
        const MoeLane m = moe_lane(cnt, tid);
#pragma unroll 1
        for (int k = 0; k < 8; ++k) {
            if (PHASE == 0) moe_rec(lds, k, m, tid, 4, false, k * G + c, 0);
            else if (PHASE == 2) moe_rec(lds, k, m, tid, 8, true, k * G + c, 1);
            else {
                const int ns = m.ts4;
                if (ns >= G) {
                    const int nsk = (ns - c + G - 1) / G;
                    if (k < nsk) moe_rec(lds, k, m, tid, 4, true, k * G + c, 0); else moe_rec(lds, k, m, tid, 8, false, (k - nsk) * G + c, 1);
                } else if (c < ns) { if (k == 0) moe_rec(lds, k, m, tid, 4, true, c, 0); else if (k == 1) moe_rec(lds, k, m, tid, 8, false, c, 1); else moe_rec(lds, k, m, tid, 8, false, -1, 1); }
                else moe_rec(lds, k, m, tid, 8, false, ns + (c - ns) + k * (G - ns), 1);
            }
        }
    }
    __syncthreads();
}
__device__ __forceinline__ bool moe_unit_rec(LAS unsigned char* lds, int k, pg8::Unit& u, int& type) {
    if (k >= 8) return false;
    const volatile LAS int* rec = (const volatile LAS int*)(lds + MOE_PLAN_OFF) + k * 8;
    const int e = __builtin_amdgcn_readfirstlane(rec[0]);
    if (e < 0) return false;
    u.e = e; u.rt = __builtin_amdgcn_readfirstlane(rec[1]); u.pn = __builtin_amdgcn_readfirstlane(rec[2]); u.pm = 0;
    u.ce = __builtin_amdgcn_readfirstlane(rec[3]); u.hoff = __builtin_amdgcn_readfirstlane(rec[4]); u.nv = __builtin_amdgcn_readfirstlane(rec[5]);
    type = __builtin_amdgcn_readfirstlane(rec[6]);
    return true;
}
struct MoeDownSched {
    LAS unsigned char* lds; const char* HB; const char* DT; int k0;
    __device__ bool next(int i, pg8::Unit& u) const {
        int type; if (!moe_unit_rec(lds, k0 + i, u, type) || type != 1) return false;
        u.A = HB + (size_t)(u.hoff + u.rt * 256) * 1024; u.B = DT + ((size_t)u.e * 512 * DM + u.pn * 256) * 2; u.ldb = 4096u; u.bhs = 256u; return true;
    }
    __device__ __forceinline__ unsigned arow_off(const pg8::Unit&, int R) const { return (unsigned)(R * 1024); }
};
template <int PHASE> __device__ __forceinline__ void phase_moe(const P& p, LAS unsigned char* lds, int G, int bid) {
    moe_plan<PHASE>((const unsigned*)(p.ws + OFF_CTL), G, bid, lds);
    int k = 0;
    if (PHASE != 2) {
        EpiGateUp E{(bf16_t*)(p.ws + OFF_HBUF)};
        for (;; ++k) {
            pg8::OneUnitSched S; int type; if (!moe_unit_rec(lds, k, S.u, type) || type != 0) break;
            S.u.A = (const char*)(p.ws + OFF_U2); S.u.B = (const char*)(p.ws + OFF_WG16) + ((size_t)S.u.e * DM * 512 + S.u.pn * 128) * 2;
            S.u.ldb = 1024u; S.u.bhs = (unsigned)(OFF_WU16 - OFF_WG16);
            S.idx = (const int*)(p.ws + OFF_INVMAP) + (size_t)S.u.e * SEQ; S.shift = 1; S.rowbytes = DM * 2; S.rowadd = 0;
            pg8::gemm_phase<EpiGateUp, pg8::OneUnitSched, true, true, true, true>(lds, DM, S, E);
        }
    }
    if (PHASE != 0) {
        MoeDownSched S{lds, (const char*)(p.ws + OFF_HBUF), (const char*)(p.ws + OFF_WD16), k};
        EpiDown E{(bf16_t*)(p.ws + OFF_Y), (const int*)(p.ws + OFF_INVMAP), (const float*)(p.ws + OFF_WTS)};
        pg8::gemm_phase<EpiDown, MoeDownSched, true, true, true, true>(lds, 512, S, E);
    }
}

#include <hip/hip_bf16.h>
namespace fx {
using bf16 = __hip_bfloat16;
typedef short s16x4 __attribute__((ext_vector_type(4)));
typedef float f32x16 __attribute__((ext_vector_type(16)));
template <class A, class Bt> struct same_t { static constexpr bool v = false; };
template <class A> struct same_t<A, A> { static constexpr bool v = true; };
constexpr int D = 128; constexpr float THR = 8.f; constexpr bool WSKIP = false;
constexpr float SCALE = 0.08838834764831845f;
constexpr int NW = 8, QBLK = 32, KVBLK = 64, QB = NW * QBLK;
constexpr int SHM_V = KVBLK * D * 2, SHM_K = KVBLK * D * 2;
constexpr int FOX_BIAS_OFF = 2 * SHM_V + 2 * SHM_K + NW * 64 * 4;
#define KSWZ(row, colB) ((row) * 256 + ((colB) ^ (((row) & 7) << 4)))
#define SBAR() __builtin_amdgcn_sched_barrier(0)
__device__ __forceinline__ int v_st(int k, int c) { const int kk = (k & ~0xC) | ((k & 4) << 1) | ((k & 8) >> 1); return ((kk >> 3) * 4 + (c >> 5)) * 512 + ((kk & 7) * 32 + (c & 31)) * 2; }
__device__ __forceinline__ int v_rd_base(int lane) { return ((lane & 3) << 3) | (((lane >> 2) & 3) << 6) | (((lane >> 4) & 1) << 5) | (((lane >> 5) & 1) << 8); }
constexpr int v_rd_off(int d0, int ks, int half) { return d0 * 512 + ks * 4096 + half * 2048; }
__device__ __forceinline__ int crow(int r, int hi) { return (r & 3) + 8 * (r >> 2) + 4 * hi; }

__device__ __forceinline__ bf16x8 pack8(f32x4 a, f32x4 b) {
    u32x4 w = {cvtpk(a[0], a[1]), cvtpk(a[2], a[3]), cvtpk(b[0], b[1]), cvtpk(b[2], b[3])};
    return *reinterpret_cast<bf16x8*>(&w);
}
template <class T> __device__ __forceinline__ bf16x8 load8(const T* p) {
    if constexpr (same_t<T, float>::v) { return pack8(*(const f32x4*)p, *(const f32x4*)(p + 4)); }
    else { return *reinterpret_cast<const bf16x8*>(p); }
}
__device__ __forceinline__ void mask_tile(f32x16& p0, f32x16& p1, int dq, unsigned W) {
    const float NEG = -__builtin_inff();
#pragma unroll
    for (int r = 0; r < 16; ++r) {
        const int c = (r & 3) + 8 * (r >> 2);
        if ((unsigned)(dq - c) >= W) p0[r] = NEG;
        if ((unsigned)(dq - c - 32) >= W) p1[r] = NEG;
    }
}
__device__ __forceinline__ void partialSM(f32x16& p0, f32x16& p1, float& m_reg, float& mn, float& alpha) {
    float pmax = p0[0]; for (int r = 1; r < 16; ++r) pmax = fmaxf(pmax, p0[r]); for (int r = 0; r < 16; ++r) pmax = fmaxf(pmax, p1[r]);
    { auto rr = __builtin_amdgcn_permlane32_swap(__float_as_uint(pmax), __float_as_uint(pmax), false, false);
      pmax = fmaxf(__uint_as_float(rr[0]), __uint_as_float(rr[1])); }
    constexpr float C2 = 1.4426950408889634f * SCALE;
    if (__builtin_expect(__all((pmax - m_reg) * SCALE <= THR), 1)) { mn = m_reg; alpha = 1.f; }
    else { mn = fmaxf(m_reg, pmax); alpha = __builtin_amdgcn_exp2f((m_reg - mn) * C2); m_reg = mn; }
    const float mnL = -mn * C2;
    for (int r = 0; r < 16; ++r) p0[r] = fmaf(p0[r], C2, mnL); for (int r = 0; r < 16; ++r) p1[r] = fmaf(p1[r], C2, mnL);
    for (int r = 0; r < 16; ++r) p0[r] = __builtin_amdgcn_exp2f(p0[r]);
}
__device__ __forceinline__ void finishSM(f32x16& p0, f32x16& p1, float alpha, float& l_reg, bf16x8& pa0, bf16x8& pa1, bf16x8& pa2, bf16x8& pa3) {
    for (int r = 0; r < 16; ++r) p1[r] = __builtin_amdgcn_exp2f(p1[r]);
    float ps = 0; for (int r = 0; r < 16; ++r) ps += p0[r]; for (int r = 0; r < 16; ++r) ps += p1[r];
    { auto rr = __builtin_amdgcn_permlane32_swap(__float_as_uint(ps), __float_as_uint(ps), false, false);
      ps = __uint_as_float(rr[0]) + __uint_as_float(rr[1]); }
    l_reg = l_reg * alpha + ps;
#define PK4(P, B_, OUT) do { unsigned a0 = cvtpk(P[B_+0], P[B_+1]), a1 = cvtpk(P[B_+2], P[B_+3]);                          \
        unsigned b0 = cvtpk(P[B_+4], P[B_+5]), b1 = cvtpk(P[B_+6], P[B_+7]);                                             \
        auto r0 = __builtin_amdgcn_permlane32_swap(a0, b0, false, false); auto r1 = __builtin_amdgcn_permlane32_swap(a1, b1, false, false); \
        u32x4 w = {r0[0], r1[0], r0[1], r1[1]}; OUT = *reinterpret_cast<bf16x8*>(&w); } while (0)
    PK4(p0, 0, pa0); PK4(p0, 8, pa1); PK4(p1, 0, pa2); PK4(p1, 8, pa3);
#undef PK4
}
template <int KB, bool SK>
__device__ __forceinline__ void qkt(f32x16& p0, f32x16& p1, const char* K_lds, int r32, int hi, const bf16x8* qr, bool act, const float* bias) {
    if (SK && !act) { const float NEG = -__builtin_inff();
#pragma unroll
        for (int r = 0; r < 16; ++r) { p0[r] = NEG; p1[r] = NEG; } return; }
    { const f32x4* bp = (const f32x4*)(bias + 4 * hi);
#pragma unroll
      for (int g = 0; g < 4; ++g) { const f32x4 a = bp[2 * g], b = bp[8 + 2 * g];
          p0[4 * g] = a[0]; p0[4 * g + 1] = a[1]; p0[4 * g + 2] = a[2]; p0[4 * g + 3] = a[3];
          p1[4 * g] = b[0]; p1[4 * g + 1] = b[1]; p1[4 * g + 2] = b[2]; p1[4 * g + 3] = b[3]; } }
    const char* kb[4];
#pragma unroll
    for (int dd = 0; dd < 4; ++dd) kb[dd] = K_lds + KB * SHM_K + KSWZ(r32, (dd * 16 + hi * 8) * 2);
#pragma unroll
    for (int d0 = 0; d0 < 8; ++d0) { const char* a = kb[d0 & 3] + (d0 >> 2) * 128;
        bf16x8 b0 = *reinterpret_cast<const bf16x8*>(a);
        bf16x8 b1 = *reinterpret_cast<const bf16x8*>(a + 32 * 256);
        p0 = __builtin_amdgcn_mfma_f32_32x32x16_bf16(b0, qr[d0], p0, 0, 0, 0);
        p1 = __builtin_amdgcn_mfma_f32_32x32x16_bf16(b1, qr[d0], p1, 0, 0, 0); }
}
template <int VB, bool SK>
__device__ __forceinline__ void pv_tile(f32x16* o, int vb0, bf16x8 pa0, bf16x8 pa1, bf16x8 pa2, bf16x8 pa3, bool act) {
    if (SK && !act) return;
#define TRRD(dst, off) asm volatile("ds_read_b64_tr_b16 %0, %1 offset:%2" : "=&v"(dst) : "v"(vb0), "i"(off) : "memory")
#define PV_D0(d0) do { s16x4 l0, l1, l2, l3, h0, h1, h2, h3; constexpr int b_ = VB * SHM_V + v_rd_off(d0, 0, 0);     \
        TRRD(l0, b_); TRRD(h0, b_ + 2048); TRRD(l1, b_ + 4096); TRRD(h1, b_ + 6144); TRRD(l2, b_ + 8192); TRRD(h2, b_ + 10240); TRRD(l3, b_ + 12288); TRRD(h3, b_ + 14336); \
        asm volatile("s_waitcnt lgkmcnt(0)" ::: "memory"); SBAR();                 \
        o[d0] = __builtin_amdgcn_mfma_f32_32x32x16_bf16(pa0, (bf16x8){l0[0], l0[1], l0[2], l0[3], h0[0], h0[1], h0[2], h0[3]}, o[d0], 0, 0, 0);   \
        o[d0] = __builtin_amdgcn_mfma_f32_32x32x16_bf16(pa1, (bf16x8){l1[0], l1[1], l1[2], l1[3], h1[0], h1[1], h1[2], h1[3]}, o[d0], 0, 0, 0);   \
        o[d0] = __builtin_amdgcn_mfma_f32_32x32x16_bf16(pa2, (bf16x8){l2[0], l2[1], l2[2], l2[3], h2[0], h2[1], h2[2], h2[3]}, o[d0], 0, 0, 0);   \
        o[d0] = __builtin_amdgcn_mfma_f32_32x32x16_bf16(pa3, (bf16x8){l3[0], l3[1], l3[2], l3[3], h3[0], h3[1], h3[2], h3[3]}, o[d0], 0, 0, 0); } while (0)
    PV_D0(0); PV_D0(1); PV_D0(2); PV_D0(3);
#undef PV_D0
#undef TRRD
}

template <class TIn, class TOut> struct BlockRef { const TIn* Q; const TIn* K; const TIn* V; TOut* O; int P0; const float* bias; const float* g; int jlo; };
template <class TIn> struct Seam {
    bf16x8 qr[8];
    bf16x8 st_v0, st_v1, st_k0, st_k1; f32x4 sf0, sf1, sf2, sf3;
    f32x4 tq[16];
};
__device__ __forceinline__ int swa_jlo(int P0, int W) { const int lowk = P0 - W + 1; return lowk > 0 ? lowk / KVBLK : 0; }
#define ROW(p, k0, rr) ((p) + (size_t)((k0) + (rr)) * D + sc)
#define VMW() asm volatile("s_waitcnt vmcnt(0)" ::: "memory")
#define VMWN(n) asm volatile("s_waitcnt vmcnt(%0)" :: "i"(n) : "memory")
#define SLOAD_H(Kp, Vp, k0) do { S.st_v0 = load8<TIn>(ROW(Vp, k0, sr)); S.st_v1 = load8<TIn>(ROW(Vp, k0, 32 + sr));              \
                         S.st_k0 = load8<TIn>(ROW(Kp, k0, sr)); S.st_k1 = load8<TIn>(ROW(Kp, k0, 32 + sr)); } while (0)
#define SWRITE_HK(bf) do { *(bf16x8*)(K_lds + (bf) * SHM_K + kws) = S.st_k0; *(bf16x8*)(K_lds + (bf) * SHM_K + kws + 32 * 256) = S.st_k1; } while (0)
#define SWRITE_HV(bf) do { *(bf16x8*)(V_lds + (bf) * SHM_V + vst0) = S.st_v0; *(bf16x8*)(V_lds + (bf) * SHM_V + vst1) = S.st_v1; } while (0)
#define SWRITE_H(bf) do { SWRITE_HV(bf); SWRITE_HK(bf); } while (0)
#define SLOAD_F(p, k0) do { S.sf0 = *(const f32x4*)ROW(p, k0, sr); S.sf1 = *(const f32x4*)(ROW(p, k0, sr) + 4);                \
                            S.sf2 = *(const f32x4*)ROW(p, k0, 32 + sr); S.sf3 = *(const f32x4*)(ROW(p, k0, 32 + sr) + 4); } while (0)
#define SWRITE_KF(bf) do { *(bf16x8*)(K_lds + (bf) * SHM_K + kws) = pack8(S.sf0, S.sf1); *(bf16x8*)(K_lds + (bf) * SHM_K + kws + 32 * 256) = pack8(S.sf2, S.sf3); } while (0)
#define SWRITE_VF(bf) do { *(bf16x8*)(V_lds + (bf) * SHM_V + vst0) = pack8(S.sf0, S.sf1); *(bf16x8*)(V_lds + (bf) * SHM_V + vst1) = pack8(S.sf2, S.sf3); } while (0)
template <class TIn, class TOut>
__device__ __forceinline__ void causal_swa_prime(const BlockRef<TIn, TOut>& cur, int W, char* lds, Seam<TIn>& S) {
    constexpr bool F32 = same_t<TIn, float>::v;
    int tid = threadIdx.x; asm volatile("" : "+v"(tid));
    const int wid = __builtin_amdgcn_readfirstlane(tid >> 6), lane = tid & 63, r32 = lane & 31, hi = lane >> 5;
    const int sr = tid >> 4, sc = (tid & 15) * 8, kws = KSWZ(sr, sc * 2); char* K_lds = lds + 2 * SHM_V;
    const int kb0 = cur.jlo * KVBLK;
    for (int d0 = 0; d0 < 8; ++d0) S.qr[d0] = load8<TIn>(cur.Q + (size_t)(wid * QBLK + r32) * D + d0 * 16 + hi * 8);
    if constexpr (F32) { SLOAD_F((const float*)cur.K, kb0); VMW(); SWRITE_KF(0); SBAR(); SLOAD_F((const float*)cur.V, kb0); }
    else { SLOAD_H(cur.K, cur.V, kb0); VMW(); SWRITE_HK(0); }
    __syncthreads();
}
template <class TIn, class TOut>
__device__ __forceinline__ void causal_swa_block(const BlockRef<TIn, TOut>& cur, const BlockRef<TIn, TOut>& nxt, int skv, int W, char* lds, Seam<TIn>& S) {
    constexpr bool F32 = same_t<TIn, float>::v;
    int tid = threadIdx.x; asm volatile("" : "+v"(tid));
    const int wid = __builtin_amdgcn_readfirstlane(tid >> 6), lane = tid & 63, r32 = lane & 31, hi = lane >> 5;
    const int j_lo = cur.jlo;
    int j_hi = (cur.P0 + QB - 1) / KVBLK + 1; if (j_hi > skv / KVBLK) j_hi = skv / KVBLK;
    const int NT = j_hi - j_lo;
    const int kbn = swa_jlo(nxt.P0, W) * KVBLK;
    const int qlo = cur.P0 + wid * QBLK, qm = qlo + r32 - 4 * hi;
    char* V_lds = lds; char* K_lds = lds + 2 * SHM_V;
    float* ws = (float*)(lds + 2 * SHM_V + 2 * SHM_K) + wid * 64; float* li_l = ws, * al_l = ws + 32;
    float m_reg = -1e30f, l_reg = 0; f32x16 o[4] = {};
    const int sr = tid >> 4, sc = (tid & 15) * 8, vst0 = v_st(sr, sc), vst1 = v_st(32 + sr, sc), kws = KSWZ(sr, sc * 2);
    const int vb0 = (int)(uintptr_t)V_lds + v_rd_base(lane);
    const TIn* Kh = cur.K; const TIn* Vh = cur.V;
#define RESC(a) do { if (__any((a) < 1.f)) { if (hi == 0) al_l[r32] = (a); asm volatile("s_waitcnt lgkmcnt(0)" ::: "memory");              \
                     for (int d_ = 0; d_ < 4; ++d_) for (int r = 0; r < 16; ++r) o[d_][r] *= al_l[crow(r, hi)]; } } while (0)
#define KBASE(t) ((j_lo + (t)) * KVBLK)
#define BIAS(t) (cur.bias + (t) * KVBLK)
#define ACT(t) (KBASE(t) <= qlo + QBLK - 1 && KBASE(t) + KVBLK - 1 >= qlo - W + 1)
#define MASKT(P0_, P1_, t) do { const int kb_ = KBASE(t); if ((!SK || ACT(t)) && (kb_ + KVBLK - 1 > qlo || kb_ <= qlo + QBLK - 1 - W)) mask_tile(P0_, P1_, qm - kb_, (unsigned)W); } while (0)
    constexpr int NQL = F32 ? 16 : 8;
    constexpr bool SK = WSKIP && !F32;
#define SEAM_K0() do { VMWN(NQL); if constexpr (F32) { SWRITE_KF(0); SBAR(); SLOAD_F((const float*)nxt.V, kbn); } else { SWRITE_HK(0); } SBAR(); } while (0)
    f32x16 pA0, pA1, pB0, pB1; float mnA, mnB, alA, alB; bf16x8 pa0, pa1, pa2, pa3;
    if constexpr (F32) { VMW(); SWRITE_VF(0); SBAR(); } else { SWRITE_HV(0); SBAR(); }
    if (NT > 1) { if constexpr (F32) SLOAD_F((const float*)Kh, KBASE(1)); else SLOAD_H(Kh, Vh, KBASE(1)); }
    SBAR(); qkt<0, SK>(pA0, pA1, K_lds, r32, hi, S.qr, ACT(0), BIAS(0));
    if constexpr (F32) { if (NT > 1) { VMW(); SWRITE_KF(1); SBAR(); SLOAD_F((const float*)Vh, KBASE(1)); } }
    MASKT(pA0, pA1, 0); partialSM(pA0, pA1, m_reg, mnA, alA);
    if (NT > 1) { VMW(); if constexpr (F32) { SWRITE_VF(1); SBAR(); if (NT > 2) SLOAD_F((const float*)Kh, KBASE(2)); } else SWRITE_H(1); }
    __syncthreads();
#define HALF_STEP(PX0, PX1, mnX, alX, PY0, PY1, alY, t, KB, VB, SB) do {                                                      \
        SBAR(); qkt<KB, SK>(PX0, PX1, K_lds, r32, hi, S.qr, ACT(t), BIAS(t));                                             \
        finishSM(PY0, PY1, alY, l_reg, pa0, pa1, pa2, pa3); SBAR();                                                           \
        if ((t) + 1 < NT) { if constexpr (F32) { VMW(); SWRITE_KF(SB); SBAR(); SLOAD_F((const float*)Vh, KBASE((t) + 1)); }  \
                            else { SLOAD_H(Kh, Vh, KBASE((t) + 1)); } SBAR(); }                                               \
        pv_tile<VB, SK>(o, vb0, pa0, pa1, pa2, pa3, ACT((t) - 1)); MASKT(PX0, PX1, (t)); partialSM(PX0, PX1, m_reg, mnX, alX);                                        \
        __syncthreads();                                                                                                      \
        if ((t) + 1 < NT) { VMW(); if constexpr (F32) { SWRITE_VF(SB); SBAR(); if ((t) + 2 < NT) SLOAD_F((const float*)Kh, KBASE((t) + 2)); } \
                            else { SWRITE_H(SB); } }                                                                          \
        RESC(alX); __syncthreads(); } while (0)
    for (int t = 1; t + 1 < NT; t += 2) {
        HALF_STEP(pB0, pB1, mnB, alB, pA0, pA1, alA, t, 1, 0, 0);
        HALF_STEP(pA0, pA1, mnA, alA, pB0, pB1, alB, t + 1, 0, 1, 1);
    }
    const bool even = (NT & 1) == 0;
    if (even) { SBAR(); qkt<1, SK>(pB0, pB1, K_lds, r32, hi, S.qr, ACT(NT - 1), BIAS(NT - 1)); SBAR(); }
#define QROW(e) (nxt.Q + (size_t)(wid * QBLK + r32) * D + ((e) >> 1) * 16 + hi * 8 + ((e) & 1) * 4)
    if constexpr (F32) { SLOAD_F((const float*)nxt.K, kbn); SBAR();
#pragma unroll
        for (int e = 0; e < 8; ++e) S.tq[e] = *(const f32x4*)QROW(e); }
    SBAR();
    finishSM(pA0, pA1, alA, l_reg, pa0, pa1, pa2, pa3); SBAR();
    if constexpr (F32) {
#pragma unroll
        for (int e = 8; e < 16; ++e) S.tq[e] = *(const f32x4*)QROW(e); SBAR(); }
#undef QROW
    pv_tile<0, SK>(o, vb0, pa0, pa1, pa2, pa3, ACT(even ? NT - 2 : NT - 1));
    if (even) { MASKT(pB0, pB1, NT - 1); partialSM(pB0, pB1, m_reg, mnB, alB); __syncthreads(); RESC(alB);
        finishSM(pB0, pB1, alB, l_reg, pa0, pa1, pa2, pa3); SBAR(); pv_tile<1, SK>(o, vb0, pa0, pa1, pa2, pa3, ACT(NT - 1)); }
    SBAR();
    if (hi == 0) li_l[r32] = l_reg; asm volatile("s_waitcnt lgkmcnt(0)" ::: "memory");
    float rli[16];
#pragma unroll
    for (int r = 0; r < 16; ++r) rli[r] = __builtin_amdgcn_rcpf(li_l[crow(r, hi)]);
    {
        float rs[16];
#pragma unroll
        for (int r = 0; r < 16; ++r) { float s = 0.f;
#pragma unroll
            for (int d0 = 0; d0 < 4; ++d0) { o[d0][r] *= rli[r]; s += o[d0][r] * o[d0][r]; }
            s += sw_xor<1>(s); s += sw_xor<2>(s); s += sw_xor<4>(s); s += sw_xor<8>(s); s += sw_xor<16>(s);
            rs[r] = rsqrtf(s * (1.f / 128.f) + 1e-6f); }
        float gg[4];
#pragma unroll
        for (int d0 = 0; d0 < 4; ++d0) gg[d0] = cur.g[d0 * 32 + r32];
        TOut* Ow = cur.O + (size_t)(wid * QBLK) * 2048;
#pragma unroll
        for (int r = 0; r < 16; ++r) { const int orow = crow(r, hi);
#pragma unroll
            for (int d0 = 0; d0 < 4; ++d0) { const float v = o[d0][r] * rs[r] * gg[d0]; const float vn = sw_xor<1>(v);
                if ((r32 & 1) == 0) *(unsigned*)(Ow + (size_t)orow * 2048 + d0 * 32 + r32) = cvtpk(v, vn); } }
    }
    if constexpr (F32) {
#pragma unroll
        for (int d0 = 0; d0 < 8; ++d0) S.qr[d0] = pack8(S.tq[2 * d0], S.tq[2 * d0 + 1]); }
    __syncthreads();
#undef RESC
#undef KBASE
#undef BIAS
#undef ACT
#undef MASKT
#undef SEAM_K0
#undef HALF_STEP
}
#undef ROW
#undef VMW
#undef VMWN
#undef SLOAD_H
#undef SWRITE_HK
#undef SWRITE_HV
#undef SWRITE_H
#undef SLOAD_F
#undef SWRITE_KF
#undef SWRITE_VF
}

constexpr size_t OFF_NORMS = 32768;
__device__ __forceinline__ float sumsq8(uint4 v) {
    const float a0 = __uint_as_float(v.x << 16), a1 = __uint_as_float(v.x & 0xffff0000u), a2 = __uint_as_float(v.y << 16), a3 = __uint_as_float(v.y & 0xffff0000u);
    const float a4 = __uint_as_float(v.z << 16), a5 = __uint_as_float(v.z & 0xffff0000u), a6 = __uint_as_float(v.w << 16), a7 = __uint_as_float(v.w & 0xffff0000u);
    return (a0 * a0 + a1 * a1) + (a2 * a2 + a3 * a3) + (a4 * a4 + a5 * a5) + (a6 * a6 + a7 * a7);
}
__device__ __forceinline__ void phase_norms(const P& p, unsigned char* lds, int G, int bid) {
    int tid = threadIdx.x; asm volatile("" : "+v"(tid));
    const int lane = tid & 63, w = tid >> 6, sub = lane >> 4, l16 = lane & 15, gw = bid * NWAVES + w, NGW = G * NWAVES;
    float* red = (float*)lds;
    float mq[8], mk[8];
#pragma unroll
    for (int h = 0; h < 8; ++h) { mq[h] = 0.f; mk[h] = 0.f; }
    for (int g = gw; g < LR / 4; g += NGW) {
        uint4 vq[8], vk[8];
#pragma unroll
        for (int h = 0; h < 8; ++h) {
            vk[h] = *(const uint4*)((const bf16_t*)(p.ws + OFF_FK) + ((size_t)h * LR + g * 4 + sub) * 128 + l16 * 8);
            vq[h] = g < SEQ / 4 ? *(const uint4*)((const bf16_t*)(p.ws + OFF_FQ) + ((size_t)h * SEQ + g * 4 + sub) * 128 + l16 * 8) : make_uint4(0u, 0u, 0u, 0u);
        }
#pragma unroll
        for (int h = 0; h < 8; ++h) {
            float a = sumsq8(vq[h]), b = sumsq8(vk[h]);
            a += sw_xor<1>(a); b += sw_xor<1>(b); a += sw_xor<2>(a); b += sw_xor<2>(b);
            a += sw_xor<4>(a); b += sw_xor<4>(b); a += sw_xor<8>(a); b += sw_xor<8>(b);
            mq[h] = fmaxf(mq[h], a); mk[h] = fmaxf(mk[h], b);
        }
    }
#pragma unroll
    for (int h = 0; h < 8; ++h) { const float a = wave_max(mq[h]), b = wave_max(mk[h]); if (lane == 0) { red[(h * 2) * 8 + w] = a; red[(h * 2 + 1) * 8 + w] = b; } }
    __syncthreads();
    if (tid < 16) { float m = 0.f;
#pragma unroll
        for (int q = 0; q < 8; ++q) m = fmaxf(m, red[tid * 8 + q]);
        ((float*)(p.ws + OFF_NORMS))[(size_t)bid * 16 + tid] = m; }
    __syncthreads();
}

__device__ __forceinline__ void phase_fox(const P& p, unsigned char* lds_g, int G, int bid) {
    using namespace fx;
    for (int it = bid; it < 256; it += G) {
        int tid = threadIdx.x; asm volatile("" : "+v"(tid));
        const int lane = tid & 63, w = tid >> 6;
        const int h = it & 7, qb = 31 - (it >> 3);
        const int P0 = 64 + qb * 256, j_hi = (P0 + QB - 1) / KVBLK + 1;
        const float* CBh = (const float*)(p.ws + OFF_CB) + (size_t)h * LR;
        float* sc = (float*)(lds_g + FOX_BIAS_OFF);
        { float a = 0.f, b = 0.f; const float* NR = (const float*)(p.ws + OFF_NORMS);
          for (int i = tid; i < G; i += 512) { a = fmaxf(a, NR[(size_t)i * 16 + 2 * h]); b = fmaxf(b, NR[(size_t)i * 16 + 2 * h + 1]); }
          a = wave_max(a); b = wave_max(b); if (lane == 0) { sc[w] = a; sc[8 + w] = b; } }
        __syncthreads();
        float qm = 0.f, km = 0.f;
#pragma unroll
        for (int q = 0; q < 8; ++q) { qm = fmaxf(qm, sc[q]); km = fmaxf(km, sc[8 + q]); }
        const float T = 2.f * SCALE * sqrtf(qm * km) + 30.f;
        const float thr = CBh[P0] - T * (1.f / SCALE);
        const int j_lo = !FOX_SKIP ? (__syncthreads(), 0) : __syncthreads_count(tid < j_hi && !(CBh[64 * tid + 63 < LR ? 64 * tid + 63 : LR - 1] >= thr));
        { const f32x4* src = (const f32x4*)(CBh + j_lo * 64);
          f32x4* dst = (f32x4*)(lds_g + FOX_BIAS_OFF);
          for (int i = tid; i < (j_hi - j_lo) * 16; i += 512) dst[i] = src[i]; }
        __syncthreads();
        BlockRef<bf16, bf16> cur;
        cur.Q = (const bf16*)(p.ws + OFF_FQ) + ((size_t)h * SEQ + qb * 256) * 128;
        cur.K = (const bf16*)(p.ws + OFF_FK) + (size_t)h * LR * 128;
        cur.V = (const bf16*)(p.ws + OFF_FV) + (size_t)h * LR * 128;
        cur.O = (bf16*)(p.ws + OFF_MIX) + (size_t)(qb * 256) * DM + 1024 + h * 128;
        cur.P0 = P0; cur.bias = (const float*)(lds_g + FOX_BIAS_OFF); cur.g = p.fox_g; cur.jlo = j_lo;
        Seam<bf16> S;
        causal_swa_prime<bf16, bf16>(cur, 1 << 30, (char*)lds_g, S);
        causal_swa_block<bf16, bf16>(cur, cur, LR, 1 << 30, (char*)lds_g, S);
    }
}

constexpr size_t OFF_UB = OFF_A0;
constexpr size_t OFF_SB = OFF_GLAO;
constexpr size_t OFF_DEC = 65536;
constexpr size_t WS_END_GLA = OFF_DEC + (size_t)128 * 4 * 128 * 4;
static_assert(WS_END_GLA <= OFF_A0, "ws map");
namespace gla {
using fx::s16x4; using fx::f32x16;
constexpr int L_ZS = 0, L_SEG = 4096, L_EX = 6144, L_V = 8192, L_A0 = 40960, L_A1 = 58368, L_A2 = 75776;
constexpr int RS = 272;
constexpr int KTS = 144;
#define GLA_TRRD(dst, base, off) asm volatile("ds_read_b64_tr_b16 %0, %1 offset:%2" : "=&v"(dst) : "v"(base), "i"(off) : "memory")
#define GLA_PK4(P, B_, OUT) do { unsigned a0 = cvtpk(P[B_+0], P[B_+1]), a1 = cvtpk(P[B_+2], P[B_+3]);                          \
        unsigned b0 = cvtpk(P[B_+4], P[B_+5]), b1 = cvtpk(P[B_+6], P[B_+7]);                                             \
        auto r0 = __builtin_amdgcn_permlane32_swap(a0, b0, false, false); auto r1 = __builtin_amdgcn_permlane32_swap(a1, b1, false, false); \
        u32x4 w_ = {r0[0], r1[0], r0[1], r1[1]}; OUT = __builtin_bit_cast(bf16x8, w_); } while (0)

struct CastPlan { const f32x4* s[6]; u32x2* d[6]; };
__device__ __forceinline__ CastPlan cast_plan_p1(const P& p, int it) { CastPlan c;
#pragma unroll
    for (int k = 0; k < 4; ++k) { c.s[k] = (const f32x4*)p.wg + (size_t)it * 16384 + k * 4096; c.d[k] = (u32x2*)(p.ws + OFF_WG16) + (size_t)it * 16384 + k * 4096; }
#pragma unroll
    for (int k = 0; k < 2; ++k) { c.s[4 + k] = (const f32x4*)p.wu + (size_t)it * 16384 + k * 4096; c.d[4 + k] = (u32x2*)(p.ws + OFF_WU16) + (size_t)it * 16384 + k * 4096; }
    return c; }
__device__ __forceinline__ CastPlan cast_plan_p3(const P& p, int it) { CastPlan c;
#pragma unroll
    for (int k = 0; k < 2; ++k) { c.s[k] = (const f32x4*)p.wu + (size_t)it * 16384 + 8192 + k * 4096; c.d[k] = (u32x2*)(p.ws + OFF_WU16) + (size_t)it * 16384 + 8192 + k * 4096; }
#pragma unroll
    for (int k = 0; k < 4; ++k) { c.s[2 + k] = (const f32x4*)p.wd + (size_t)it * 16384 + k * 4096; c.d[2 + k] = (u32x2*)(p.ws + OFF_WD16) + (size_t)it * 16384 + k * 4096; }
    return c; }
#define CAST_ISSUE_ON(k) do { _Pragma("unroll") for (int j_ = 0; j_ < 8; ++j_) cv[j_] = nt_load(&cpl.s[k][j_ * 512 + tid]); } while (0)
#define CAST_FIN_ON(k) do { _Pragma("unroll") for (int j_ = 0; j_ < 8; ++j_) nt_store((u32x2){cvtpk(cv[j_][0], cv[j_][1]), cvtpk(cv[j_][2], cv[j_][3])}, &cpl.d[k][j_ * 512 + tid]); } while (0)
#define CAST_ISSUE_OFF(k) do { (void)cpl; (void)cv; } while (0)
#define CAST_FIN_OFF(k) do { } while (0)
#if CAST_IN_GEMM != 0
#define CAST_ISSUE(k) CAST_ISSUE_OFF(k)
#define CAST_FIN(k) CAST_FIN_OFF(k)
#else
#define CAST_ISSUE(k) CAST_ISSUE_ON(k)
#define CAST_FIN(k) CAST_FIN_ON(k)
#endif

__device__ __forceinline__ void stage_zv(const P& p, unsigned char* lds, int n, int h, int tid, bool with_z = true) {
    if (with_z && tid < 256) ((float4*)(lds + L_ZS))[tid] = ((const float4*)((const float*)(p.ws + OFF_GZ) + (size_t)n * 64 * 16))[tid];
    const bf16_t* GV = (const bf16_t*)(p.ws + OFF_GV) + ((size_t)h * LR + n * 64) * 256;
    const int sr = tid >> 4, sc = (tid & 15) * 8;
#pragma unroll
    for (int half = 0; half < 2; ++half)
#pragma unroll
        for (int kk = 0; kk < 2; ++kk) { const int key = sr + 32 * kk;
            const uint4 v = *(const uint4*)(GV + (size_t)key * 256 + half * 128 + sc);
            *(uint4*)(lds + L_V + half * 16384 + fx::v_st(key, sc)) = v; }
}
__device__ __forceinline__ void gate_compute(unsigned char* lds, int n, int tid, const float (&w2r)[16], float bgd, float (&b)[16], float& blast, float& bref) {
    const int d = tid & 127, rq = tid >> 7;
    const float* zs = (const float*)(lds + L_ZS);
    float run = 0.f;
#pragma unroll
    for (int ii = 0; ii < 16; ++ii) {
        const int i = rq * 16 + ii; const float4* z4 = (const float4*)(zs + i * 16);
        float lg = bgd;
#pragma unroll
        for (int q = 0; q < 4; ++q) { const float4 z = z4[q]; lg = fmaf(z.x, w2r[4 * q], lg); lg = fmaf(z.y, w2r[4 * q + 1], lg); lg = fmaf(z.z, w2r[4 * q + 2], lg); lg = fmaf(z.w, w2r[4 * q + 3], lg); }
        float la = logsigmoidf(lg) * (1.f / 16.f);
        if (n == 0 && i < 48) la = 0.f;
        run += la; b[ii] = run;
    }
    float la32;
    { const float4* z4 = (const float4*)(zs + 32 * 16); float lg = bgd;
#pragma unroll
      for (int q = 0; q < 4; ++q) { const float4 z = z4[q]; lg = fmaf(z.x, w2r[4 * q], lg); lg = fmaf(z.y, w2r[4 * q + 1], lg); lg = fmaf(z.z, w2r[4 * q + 2], lg); lg = fmaf(z.w, w2r[4 * q + 3], lg); }
      la32 = logsigmoidf(lg) * (1.f / 16.f); if (n == 0) la32 = 0.f; }
    float* seg = (float*)(lds + L_SEG);
    seg[rq * 128 + d] = run;
    __syncthreads();
    const float s0 = seg[d], s1 = seg[128 + d], s2 = seg[256 + d], s3 = seg[384 + d];
    const float prefix = (rq > 0 ? s0 : 0.f) + (rq > 1 ? s1 : 0.f) + (rq > 2 ? s2 : 0.f);
#pragma unroll
    for (int ii = 0; ii < 16; ++ii) b[ii] += prefix;
    blast = (s0 + s1) + (s2 + s3); bref = s0 + s1 + la32;
}

__device__ __forceinline__ void p1_item(const P& p, unsigned char* lds, int n, int h) {
    int tid = threadIdx.x; asm volatile("" : "+v"(tid));
    const int lane = tid & 63, w = __builtin_amdgcn_readfirstlane(tid >> 6), r = lane & 31, hh = lane >> 5;
    const int d = tid & 127, rq = tid >> 7;
    stage_zv(p, lds, n, h, tid);
    float kv[16], w2r[16];
    { const bf16_t* GK = (const bf16_t*)(p.ws + OFF_GK) + ((size_t)h * LR + n * 64 + rq * 16) * 128 + d;
#pragma unroll
      for (int ii = 0; ii < 16; ++ii) kv[ii] = bf2f(GK[(size_t)ii * 128]); }
#pragma unroll
    for (int r_ = 0; r_ < 16; ++r_) w2r[r_] = p.w2[r_ * 512 + h * 128 + d];
    const float bgd = p.bg[h * 128 + d];
    const CastPlan cpl = cast_plan_p1(p, n * 4 + h); f32x4 cv[8];
    CAST_ISSUE(0);
    __syncthreads();
    float b[16], blast, bref;
    gate_compute(lds, n, tid, w2r, bgd, b, blast, bref);
    CAST_FIN(0); CAST_ISSUE(1);
    { float* BB = (float*)(p.ws + OFF_BBUF) + (((size_t)n * 4 + h) * 64 + rq * 16) * 128 + d;
#pragma unroll
      for (int ii = 0; ii < 16; ++ii) BB[(size_t)ii * 128] = b[ii]; }
    { u32x4 w0, w1;
      float e[16];
#pragma unroll
      for (int ii = 0; ii < 16; ++ii) e[ii] = kv[ii] * fexp(blast - b[ii]);
      w0.x = cvtpk(e[0], e[1]); w0.y = cvtpk(e[2], e[3]); w0.z = cvtpk(e[4], e[5]); w0.w = cvtpk(e[6], e[7]);
      w1.x = cvtpk(e[8], e[9]); w1.y = cvtpk(e[10], e[11]); w1.z = cvtpk(e[12], e[13]); w1.w = cvtpk(e[14], e[15]);
      *(u32x4*)(lds + L_A0 + d * KTS + rq * 32) = w0; *(u32x4*)(lds + L_A0 + d * KTS + rq * 32 + 16) = w1;
      if (rq == 0) ((float*)(p.ws + OFF_DEC))[((size_t)n * 4 + h) * 128 + d] = fexp(blast); }
    CAST_FIN(1); CAST_ISSUE(2);
    __syncthreads();
    const int vb = (int)(uintptr_t)(lds + L_V) + fx::v_rd_base(lane) + (w >> 2) * 16384 + (w & 3) * 512;
    f32x16 acc[4];
#pragma unroll
    for (int db = 0; db < 4; ++db) acc[db] = f32x16{};
#define GLA_P1_KS(ks) do { s16x4 lo, hi4; GLA_TRRD(lo, vb, (ks) * 4096); GLA_TRRD(hi4, vb, (ks) * 4096 + 2048); \
        asm volatile("s_waitcnt lgkmcnt(0)" ::: "memory"); __builtin_amdgcn_sched_barrier(0); \
        const bf16x8 vf = (bf16x8){lo[0], lo[1], lo[2], lo[3], hi4[0], hi4[1], hi4[2], hi4[3]}; \
        _Pragma("unroll") for (int db = 0; db < 4; ++db) { const bf16x8 kf = *(const bf16x8*)(lds + L_A0 + (32 * db + r) * KTS + (16 * (ks) + 8 * hh) * 2); \
            acc[db] = __builtin_amdgcn_mfma_f32_32x32x16_bf16(vf, kf, acc[db], 0, 0, 0); } } while (0)
    GLA_P1_KS(0); GLA_P1_KS(1);
    CAST_FIN(2); CAST_ISSUE(3);
    GLA_P1_KS(2); GLA_P1_KS(3);
#undef GLA_P1_KS
    { unsigned char* stg = lds + 65536 + w * 8192;
#pragma unroll
      for (int x = 0; x < 16; ++x) { const int vrow = fx::crow(x, hh);
#pragma unroll
          for (int db = 0; db < 4; ++db) { const float v = acc[db][x], vn = sw_xor<1>(v);
              if ((r & 1) == 0) *(unsigned*)(stg + vrow * 256 + (32 * db + r) * 2) = cvtpk(v, vn); } }
      asm volatile("s_waitcnt lgkmcnt(0)" ::: "memory");
      CAST_FIN(3); CAST_ISSUE(4);
      bf16_t* UB = (bf16_t*)(p.ws + OFF_UB) + ((size_t)n * 4 + h) * 256 * 128 + (size_t)(32 * w) * 128;
#pragma unroll
      for (int i = 0; i < 8; ++i) { const int row = i * 4 + (lane >> 4), ch = lane & 15;
          *(u32x4*)(UB + (size_t)row * 128 + ch * 8) = *(const u32x4*)(stg + row * 256 + ch * 16); } }
    CAST_FIN(4); CAST_ISSUE(5);
    __syncthreads();
    CAST_FIN(5);
}

__device__ __forceinline__ void scan_thread(const P& p, int gid) {
    const int d2 = gid & 63, hv = gid >> 6, h = hv >> 8;
    const unsigned* UB = (const unsigned*)(p.ws + OFF_UB) + (size_t)hv * 64 + d2;
    unsigned* SB = (unsigned*)(p.ws + OFF_SB) + (size_t)hv * 64 + d2;
    const float2* DEC = (const float2*)(p.ws + OFF_DEC) + (size_t)h * 64 + d2;
    float s0 = 0.f, s1 = 0.f;
    for (int n0 = 0; n0 < 128; n0 += 32) {
        unsigned u[32]; float2 dc[32];
#pragma unroll
        for (int j = 0; j < 32; ++j) { u[j] = UB[(size_t)(n0 + j) * (4 * 256 * 64)]; dc[j] = DEC[(size_t)(n0 + j) * (4 * 64)]; }
#pragma unroll
        for (int j = 0; j < 32; ++j) {
            s0 = fmaf(dc[j].x, s0, __uint_as_float(u[j] << 16)); s1 = fmaf(dc[j].y, s1, __uint_as_float(u[j] & 0xffff0000u));
            SB[(size_t)(n0 + j) * (4 * 256 * 64)] = cvtpk(s0, s1);
        }
    }
}

#undef CAST_ISSUE
#undef CAST_FIN
#if CAST_IN_GEMM == 1
#define CAST_ISSUE(k) CAST_ISSUE_OFF(k)
#define CAST_FIN(k) CAST_FIN_OFF(k)
#else
#define CAST_ISSUE(k) CAST_ISSUE_ON(k)
#define CAST_FIN(k) CAST_FIN_ON(k)
#endif
__device__ __forceinline__ void p3_item(const P& p, unsigned char* lds, int n, int h) {
    int tid = threadIdx.x; asm volatile("" : "+v"(tid));
    const int lane = tid & 63, w = __builtin_amdgcn_readfirstlane(tid >> 6), r = lane & 31, hh = lane >> 5;
    const int d = tid & 127, rq = tid >> 7, rb = w & 1, cg = w >> 1;
    const bool fast = n < 128;
    float qv[16], kv[16], b[16], bref;
    { const size_t off = ((size_t)h * LR + n * 64 + rq * 16) * 128 + d;
      const bf16_t* GQ = (const bf16_t*)(p.ws + OFF_GQ) + off; const bf16_t* GK = (const bf16_t*)(p.ws + OFF_GK) + off;
#pragma unroll
      for (int ii = 0; ii < 16; ++ii) { qv[ii] = bf2f(GQ[(size_t)ii * 128]) * SCALE128; kv[ii] = bf2f(GK[(size_t)ii * 128]); } }
    if (fast) { const float* BB = (const float*)(p.ws + OFF_BBUF) + (((size_t)n * 4 + h) * 64) * 128 + d;
#pragma unroll
        for (int ii = 0; ii < 16; ++ii) b[ii] = BB[(size_t)(rq * 16 + ii) * 128];
        bref = BB[(size_t)32 * 128]; }
    stage_zv(p, lds, n, h, tid, !fast);
    const CastPlan cpl = cast_plan_p3(p, (n - 1) * 4 + h); f32x4 cv[8];
    CAST_ISSUE(0);
    __syncthreads();
    bf16x8 sfr[2][8];
    { const bf16_t* SB = (const bf16_t*)(p.ws + OFF_SB) + ((size_t)(n - 1) * 4 + h) * 256 * 128 + (size_t)(64 * cg + r) * 128 + 8 * hh;
#pragma unroll
      for (int tl = 0; tl < 2; ++tl)
#pragma unroll
          for (int s_ = 0; s_ < 8; ++s_) sfr[tl][s_] = *(const bf16x8*)(SB + (size_t)tl * 32 * 128 + 16 * s_); }
    if (!fast) { float w2r[16], blast;
#pragma unroll
        for (int r_ = 0; r_ < 16; ++r_) w2r[r_] = p.w2[r_ * 512 + h * 128 + d];
        gate_compute(lds, n, tid, w2r, p.bg[h * 128 + d], b, blast, bref); }
    const float ebref = fexp(bref);
#pragma unroll
    for (int ii = 0; ii < 16; ++ii) {
        const int i = rq * 16 + ii;
        const float eq = fexp(b[ii] - bref);
        *(bf16_t*)(lds + L_A0 + i * RS + d * 2) = f2bf(qv[ii] * eq);
        *(bf16_t*)(lds + L_A1 + i * RS + d * 2) = f2bf(qv[ii] * (eq * ebref));
        *(bf16_t*)(lds + L_A2 + i * RS + d * 2) = f2bf(kv[ii] * __builtin_amdgcn_rcpf(eq));
    }
    CAST_FIN(0); CAST_ISSUE(1);
    __syncthreads();
    f32x16 P0 = f32x16{}, P1v = f32x16{};
#pragma unroll
    for (int s_ = 0; s_ < 8; ++s_) {
        const bf16x8 qf = *(const bf16x8*)(lds + L_A0 + (32 * rb + r) * RS + (16 * s_ + 8 * hh) * 2);
        const bf16x8 k0 = *(const bf16x8*)(lds + L_A2 + r * RS + (16 * s_ + 8 * hh) * 2);
        P0 = __builtin_amdgcn_mfma_f32_32x32x16_bf16(k0, qf, P0, 0, 0, 0);
        if (rb) { const bf16x8 k1 = *(const bf16x8*)(lds + L_A2 + (32 + r) * RS + (16 * s_ + 8 * hh) * 2);
                  P1v = __builtin_amdgcn_mfma_f32_32x32x16_bf16(k1, qf, P1v, 0, 0, 0); }
    }
#pragma unroll
    for (int x = 0; x < 16; ++x) { const bool keep = fx::crow(x, hh) <= r; if (rb) { if (!keep) P1v[x] = 0.f; } else { if (!keep) P0[x] = 0.f; } }
    bf16x8 pa0, pa1, pa2, pa3;
    GLA_PK4(P0, 0, pa0); GLA_PK4(P0, 8, pa1); GLA_PK4(P1v, 0, pa2); GLA_PK4(P1v, 8, pa3);
    CAST_FIN(1); CAST_ISSUE(2);
    f32x16 o[2];
#pragma unroll
    for (int tl = 0; tl < 2; ++tl) {
        const int vblk = 2 * cg + tl;
        const int vb = (int)(uintptr_t)(lds + L_V) + fx::v_rd_base(lane) + (vblk >> 2) * 16384 + (vblk & 3) * 512;
        o[tl] = f32x16{};
#define GLA_PV(ks, PA) do { s16x4 lo, hi4; GLA_TRRD(lo, vb, (ks) * 4096); GLA_TRRD(hi4, vb, (ks) * 4096 + 2048); \
        asm volatile("s_waitcnt lgkmcnt(0)" ::: "memory"); __builtin_amdgcn_sched_barrier(0); \
        o[tl] = __builtin_amdgcn_mfma_f32_32x32x16_bf16(PA, (bf16x8){lo[0], lo[1], lo[2], lo[3], hi4[0], hi4[1], hi4[2], hi4[3]}, o[tl], 0, 0, 0); } while (0)
        GLA_PV(0, pa0); GLA_PV(1, pa1);
        if (rb) { GLA_PV(2, pa2); GLA_PV(3, pa3); }
#undef GLA_PV
#pragma unroll
        for (int s_ = 0; s_ < 8; ++s_) {
            const bf16x8 qh = *(const bf16x8*)(lds + L_A1 + (32 * rb + r) * RS + (16 * s_ + 8 * hh) * 2);
            o[tl] = __builtin_amdgcn_mfma_f32_32x32x16_bf16(qh, sfr[tl][s_], o[tl], 0, 0, 0);
        }
    }
    CAST_FIN(2); CAST_ISSUE(3);
    float* ex = (float*)(lds + L_EX);
#pragma unroll
    for (int x = 0; x < 16; ++x) { float s = o[0][x] * o[0][x] + o[1][x] * o[1][x];
        s += sw_xor<1>(s); s += sw_xor<2>(s); s += sw_xor<4>(s); s += sw_xor<8>(s); s += sw_xor<16>(s);
        if (r == 0) ex[(32 * rb + fx::crow(x, hh)) * 4 + cg] = s; }
    CAST_FIN(3); CAST_ISSUE(4);
    __syncthreads();
    const float g0 = p.gla_g[64 * cg + r], g1 = p.gla_g[64 * cg + 32 + r];
#pragma unroll
    for (int x = 0; x < 16; ++x) {
        const int row = 32 * rb + fx::crow(x, hh); const f32x4 e4 = *(const f32x4*)(ex + row * 4);
        const float rs = rsqrtf(((e4[0] + e4[1]) + (e4[2] + e4[3])) * (1.f / 256.f) + EPS);
        const size_t t = (size_t)(n - 1) * 64 + row;
        const bf16_t* GR = (const bf16_t*)(p.ws + OFF_GR) + t * 1024 + h * 256 + 64 * cg + r;
        bf16_t* MX = (bf16_t*)(p.ws + OFF_MIX) + t * DM + h * 256 + 64 * cg + r;
        const float v0 = o[0][x] * rs * g0 * siluf(bf2f(GR[0])), v1 = o[1][x] * rs * g1 * siluf(bf2f(GR[32]));
        const float v0n = sw_xor<1>(v0), v1n = sw_xor<1>(v1);
        if ((r & 1) == 0) { *(unsigned*)MX = cvtpk(v0, v0n); *(unsigned*)(MX + 32) = cvtpk(v1, v1n); }
    }
    CAST_FIN(4); CAST_ISSUE(5);
    __syncthreads();
    CAST_FIN(5);
}
}
__device__ __forceinline__ void phase_gla_p1(const P& p, unsigned char* lds, int G, int bid) { for (int it = bid; it < 512; it += G) gla::p1_item(p, lds, it >> 2, it & 3); }
__device__ __forceinline__ void phase_gla_scan(const P& p, int G, int bid) {
    int tid = threadIdx.x; asm volatile("" : "+v"(tid));
    const int per = (65536 + G - 1) / G;
    for (int i = tid; i < per; i += 512) { const int g = bid * per + i; if (g < 65536) gla::scan_thread(p, g); }
}
__device__ __forceinline__ void phase_gla_p3(const P& p, unsigned char* lds, int G, int bid) { for (int it = bid; it < 512; it += G) gla::p3_item(p, lds, 1 + (it >> 2), it & 3); }


__device__ __forceinline__ void cscan_head(const P& p, unsigned char* lds, int h) {
    int tid = threadIdx.x; asm volatile("" : "+v"(tid));
    const int lane = tid & 63, w = tid >> 6;
    const float* FLOG = (const float*)(p.ws + OFF_FLOG) + h;
    float* CB = (float*)(p.ws + OFF_CB) + (size_t)h * LR;
    const float bf = p.b_f[h];
    const int l0 = tid * 17;
    float v[17]; float run = 0.f;
#pragma unroll
    for (int k = 0; k < 17; ++k) { const int l = l0 + k; const float x = (l >= 48 && l < LR) ? FLOG[(size_t)l * 8] : 0.f; v[k] = x; }
#pragma unroll
    for (int k = 0; k < 17; ++k) { const int l = l0 + k; const float la = (l >= 48 && l < LR) ? logsigmoidf(v[k] + bf) : 0.f; run += la; v[k] = run; }
    float inc = run;
#pragma unroll
    for (int o = 1; o < 64; o <<= 1) { const float t = shfl_from(inc, lane - o); if (lane >= o) inc += t; }
    float* wt = (float*)lds;
    if (lane == 63) wt[w] = inc;
    __syncthreads();
    float woff = 0.f;
#pragma unroll
    for (int q = 0; q < 8; ++q) woff += (q < w) ? wt[q] : 0.f;
    const float pre = woff + (inc - run);
#pragma unroll
    for (int k = 0; k < 17; ++k) { const int l = l0 + k; if (l < LR) CB[l] = l >= 48 ? -(pre + v[k]) * (1.f / SCALE128) : -1e30f; }
    __syncthreads();
}
__device__ __forceinline__ void phase_cscan(const P& p, unsigned char* lds, int G, int bid) { for (int h = bid; h < 8; h += G) cscan_head(p, lds, h); }

__device__ __forceinline__ void router_row(const P& p, int t, int lane) {
    const float4* hr = (const float4*)(p.out + (size_t)t * DM);
    float4 u[8]; float ss = 0.f;
#pragma unroll
    for (int j = 0; j < 8; ++j) { u[j] = hr[lane + 64 * j]; ss += u[j].x * u[j].x + u[j].y * u[j].y + u[j].z * u[j].z + u[j].w * u[j].w; }
    ss = wave_sum(ss); const float rs = rsqrtf(ss * (1.f / DM) + EPS);
    uint2* U2 = (uint2*)((bf16_t*)(p.ws + OFF_U2) + (size_t)t * DM);
    float gl[4] = {0.f, 0.f, 0.f, 0.f};
#pragma unroll
    for (int j = 0; j < 8; ++j) {
        const float4 g = ((const float4*)p.g2)[lane + 64 * j];
        u[j].x *= rs * g.x; u[j].y *= rs * g.y; u[j].z *= rs * g.z; u[j].w *= rs * g.w;
        U2[lane + 64 * j] = make_uint2(cvtpk(u[j].x, u[j].y), cvtpk(u[j].z, u[j].w));
        const float4* wr = (const float4*)p.w_rg + (size_t)(lane + 64 * j) * 4;
        const float4 a = wr[0], b = wr[1], c = wr[2], d = wr[3];
        gl[0] += u[j].x * a.x + u[j].y * b.x + u[j].z * c.x + u[j].w * d.x;
        gl[1] += u[j].x * a.y + u[j].y * b.y + u[j].z * c.y + u[j].w * d.y;
        gl[2] += u[j].x * a.z + u[j].y * b.z + u[j].z * c.z + u[j].w * d.z;
        gl[3] += u[j].x * a.w + u[j].y * b.w + u[j].z * c.w + u[j].w * d.w;
    }
#pragma unroll
    for (int g = 0; g < 4; ++g) gl[g] = wave_sum(gl[g]) + p.b_rg[g];
    int gi = 0; float gm = gl[0];
#pragma unroll
    for (int g = 1; g < 4; ++g) if (gl[g] > gm) { gm = gl[g]; gi = g; }
    float gs = 0.f;
#pragma unroll
    for (int g = 0; g < 4; ++g) gs += expf(gl[g] - gm);
    const float p_g = 1.f / gs;
    float el[8] = {0.f, 0.f, 0.f, 0.f, 0.f, 0.f, 0.f, 0.f};
    const float4* we = (const float4*)(p.w_re + (size_t)gi * DM * 8);
#pragma unroll
    for (int j = 0; j < 8; ++j) {
        const float uu[4] = {u[j].x, u[j].y, u[j].z, u[j].w};
#pragma unroll
        for (int i = 0; i < 4; ++i) {
            const int k = 4 * (lane + 64 * j) + i;
            const float4 a = we[(size_t)k * 2], b = we[(size_t)k * 2 + 1];
            el[0] += uu[i] * a.x; el[1] += uu[i] * a.y; el[2] += uu[i] * a.z; el[3] += uu[i] * a.w;
            el[4] += uu[i] * b.x; el[5] += uu[i] * b.y; el[6] += uu[i] * b.z; el[7] += uu[i] * b.w;
        }
    }
#pragma unroll
    for (int e = 0; e < 8; ++e) el[e] = wave_sum(el[e]) + p.b_re[gi * 8 + e];
    int i0 = 0; float l0 = el[0];
#pragma unroll
    for (int e = 1; e < 8; ++e) if (el[e] > l0) { l0 = el[e]; i0 = e; }
    int i1 = -1; float l1 = -INFINITY;
#pragma unroll
    for (int e = 0; e < 8; ++e) if (e != i0 && el[e] > l1) { l1 = el[e]; i1 = e; }
    const float e1 = expf(l1 - l0), w0 = p_g / (1.f + e1), w1 = p_g * e1 / (1.f + e1);
    if (lane == 0) {
        unsigned* cnt = (unsigned*)(p.ws + OFF_CTL);
        int* invmap = (int*)(p.ws + OFF_INVMAP); float* wts = (float*)(p.ws + OFF_WTS);
        const int E0 = gi * 8 + i0, E1 = gi * 8 + i1;
        const unsigned p0 = atomicAdd(&cnt[E0], 1u); invmap[E0 * SEQ + p0] = t * 2; wts[t * 2] = w0;
        const unsigned p1 = atomicAdd(&cnt[E1], 1u); invmap[E1 * SEQ + p1] = t * 2 + 1; wts[t * 2 + 1] = w1;
    }
}
__device__ __forceinline__ void phase_router(const P& p, unsigned char* lds, int G, int bid) {
    int tid = threadIdx.x; asm volatile("" : "+v"(tid));
    const int lane = tid & 63, w = __builtin_amdgcn_readfirstlane(tid >> 6), r = lane & 15, q = lane >> 4;
    float* red = (float*)lds; float* rsc = (float*)(lds + 1024); float* part = (float*)(lds + 2048); float* lgt = (float*)(lds + 2048 + 49152);
    for (int rb = bid; rb < SEQ / 32; rb += G) {
        const int row0 = rb * 32;
        const float* pa0 = p.out + (size_t)(row0 + r) * DM + 256 * w + 4 * q;
        const float* pa1 = pa0 + (size_t)16 * DM;
        const float* pg = p.g2 + 256 * w + 4 * q;
        const float* pb0 = p.w_rg + (size_t)(256 * w + 4 * q) * 4 + (r < 4 ? r : 0);
        const float* pb1 = p.w_re + ((size_t)(r >> 3) * DM + 256 * w + 4 * q) * 8 + (r & 7);
        const float* pb2 = pb1 + (size_t)2 * DM * 8;
        const float m0 = r < 4 ? 1.f : 0.f;
        f32x4 acc[2][3];
#pragma unroll
        for (int rbk = 0; rbk < 2; ++rbk)
#pragma unroll
            for (int cb = 0; cb < 3; ++cb) acc[rbk][cb] = (f32x4){0.f, 0.f, 0.f, 0.f};
        float ss0 = 0.f, ss1 = 0.f;
#pragma unroll 2
        for (int t = 0; t < 16; ++t) {
            const f32x4 a0 = *(const f32x4*)(pa0 + 16 * t), a1 = *(const f32x4*)(pa1 + 16 * t), g4 = *(const f32x4*)(pg + 16 * t);
            ss0 += (a0[0] * a0[0] + a0[1] * a0[1]) + (a0[2] * a0[2] + a0[3] * a0[3]);
            ss1 += (a1[0] * a1[0] + a1[1] * a1[1]) + (a1[2] * a1[2] + a1[3] * a1[3]);
#pragma unroll
            for (int s_ = 0; s_ < 4; ++s_) {
                const float b0 = pb0[(16 * t + s_) * 4] * (g4[s_] * m0), b1 = pb1[(16 * t + s_) * 8] * g4[s_], b2 = pb2[(16 * t + s_) * 8] * g4[s_];
                acc[0][0] = __builtin_amdgcn_mfma_f32_16x16x4f32(a0[s_], b0, acc[0][0], 0, 0, 0); acc[1][0] = __builtin_amdgcn_mfma_f32_16x16x4f32(a1[s_], b0, acc[1][0], 0, 0, 0);
                acc[0][1] = __builtin_amdgcn_mfma_f32_16x16x4f32(a0[s_], b1, acc[0][1], 0, 0, 0); acc[1][1] = __builtin_amdgcn_mfma_f32_16x16x4f32(a1[s_], b1, acc[1][1], 0, 0, 0);
                acc[0][2] = __builtin_amdgcn_mfma_f32_16x16x4f32(a0[s_], b2, acc[0][2], 0, 0, 0); acc[1][2] = __builtin_amdgcn_mfma_f32_16x16x4f32(a1[s_], b2, acc[1][2], 0, 0, 0);
            }
        }
        ss0 += sw_xor<16>(ss0); ss0 = x32_sum(ss0); ss1 += sw_xor<16>(ss1); ss1 = x32_sum(ss1);
        if (q == 0) { red[w * 32 + r] = ss0; red[w * 32 + 16 + r] = ss1; }
#pragma unroll
        for (int rbk = 0; rbk < 2; ++rbk)
#pragma unroll
            for (int cb = 0; cb < 3; ++cb)
#pragma unroll
                for (int i = 0; i < 4; ++i) part[((w * 2 + rbk) * 16 + 4 * q + i) * 48 + 16 * cb + r] = acc[rbk][cb][i];
        __syncthreads();
        if (tid < 32) { float ss = 0.f;
#pragma unroll
            for (int ww = 0; ww < 8; ++ww) ss += red[ww * 32 + tid];
            rsc[tid] = rsqrtf(ss * (1.f / DM) + EPS); }
        for (int idx = tid; idx < 32 * 48; idx += 512) { const int row = idx / 48, col = idx - row * 48; float sum = 0.f;
#pragma unroll
            for (int ww = 0; ww < 8; ++ww) sum += part[((ww * 2 + (row >> 4)) * 16 + (row & 15)) * 48 + col];
            lgt[idx] = sum; }
        __syncthreads();
        { const float rs0 = rsc[r], rs1 = rsc[16 + r];
          bf16_t* U2 = (bf16_t*)(p.ws + OFF_U2) + (size_t)(row0 + r) * DM + 256 * w + 4 * q;
#pragma unroll 4
          for (int t = 0; t < 16; ++t) { const f32x4 g4 = *(const f32x4*)(pg + 16 * t);
              const f32x4 v0 = *(const f32x4*)(pa0 + 16 * t) * g4 * rs0, v1 = *(const f32x4*)(pa1 + 16 * t) * g4 * rs1;
              *(uint2*)(U2 + 16 * t) = make_uint2(cvtpk(v0[0], v0[1]), cvtpk(v0[2], v0[3]));
              *(uint2*)(U2 + (size_t)16 * DM + 16 * t) = make_uint2(cvtpk(v1[0], v1[1]), cvtpk(v1[2], v1[3])); } }
        if (tid < 32) {
            const int t = row0 + tid; const float rs = rsc[tid]; const float* L = lgt + tid * 48;
            float gl[4];
#pragma unroll
            for (int g = 0; g < 4; ++g) gl[g] = L[g] * rs + p.b_rg[g];
            int gi = 0; float gm = gl[0];
#pragma unroll
            for (int g = 1; g < 4; ++g) if (gl[g] > gm) { gm = gl[g]; gi = g; }
            float gs = 0.f;
#pragma unroll
            for (int g = 0; g < 4; ++g) gs += expf(gl[g] - gm);
            const float p_g = 1.f / gs;
            float el[8];
#pragma unroll
            for (int e = 0; e < 8; ++e) el[e] = L[16 + gi * 8 + e] * rs + p.b_re[gi * 8 + e];
            int i0 = 0; float l0 = el[0];
#pragma unroll
            for (int e = 1; e < 8; ++e) if (el[e] > l0) { l0 = el[e]; i0 = e; }
            int i1 = -1; float l1 = -INFINITY;
#pragma unroll
            for (int e = 0; e < 8; ++e) if (e != i0 && el[e] > l1) { l1 = el[e]; i1 = e; }
            const float e1 = expf(l1 - l0), w0 = p_g / (1.f + e1), w1 = p_g * e1 / (1.f + e1);
            unsigned* cnt = (unsigned*)(p.ws + OFF_CTL);
            int* invmap = (int*)(p.ws + OFF_INVMAP); float* wts = (float*)(p.ws + OFF_WTS);
            const int E0 = gi * 8 + i0, E1 = gi * 8 + i1;
            const unsigned p0 = atomicAdd(&cnt[E0], 1u); invmap[E0 * SEQ + p0] = t * 2; wts[t * 2] = w0;
            const unsigned p1 = atomicAdd(&cnt[E1], 1u); invmap[E1 * SEQ + p1] = t * 2 + 1; wts[t * 2 + 1] = w1;
        }
        __syncthreads();
    }
}
__device__ __forceinline__ void final_row(const P& p, int t, int lane) {
    float4* hr = (float4*)(p.out + (size_t)t * DM);
    const uint2* y0 = (const uint2*)((const bf16_t*)(p.ws + OFF_Y) + (size_t)t * DM);
    const uint2* y1 = (const uint2*)((const bf16_t*)(p.ws + OFF_Y) + (size_t)SEQ * DM + (size_t)t * DM);
    float4 v[8]; float ss = 0.f;
#pragma unroll
    for (int j = 0; j < 8; ++j) {
        { const f32x4 t_ = nt_load((const f32x4*)hr + lane + 64 * j); v[j] = make_float4(t_[0], t_[1], t_[2], t_[3]); }
        const u32x2 a_ = nt_load((const u32x2*)y0 + lane + 64 * j), b_ = nt_load((const u32x2*)y1 + lane + 64 * j); const uint2 a = make_uint2(a_[0], a_[1]), b = make_uint2(b_[0], b_[1]);
        v[j].x += __uint_as_float(a.x << 16) + __uint_as_float(b.x << 16);
        v[j].y += __uint_as_float(a.x & 0xffff0000u) + __uint_as_float(b.x & 0xffff0000u);
        v[j].z += __uint_as_float(a.y << 16) + __uint_as_float(b.y << 16);
        v[j].w += __uint_as_float(a.y & 0xffff0000u) + __uint_as_float(b.y & 0xffff0000u);
        ss += v[j].x * v[j].x + v[j].y * v[j].y + v[j].z * v[j].z + v[j].w * v[j].w;
    }
    ss = wave_sum(ss); float rs = rsqrtf(ss * (1.f / DM) + EPS);
#pragma unroll
    for (int j = 0; j < 8; ++j) {
        const float4 g = ((const float4*)p.gf)[lane + 64 * j];
        nt_store((f32x4){v[j].x * rs * g.x, v[j].y * rs * g.y, v[j].z * rs * g.z, v[j].w * rs * g.w}, (f32x4*)hr + lane + 64 * j);
    }
}
__device__ __forceinline__ void phase_final(const P& p, int G, int bid) {
    int tid = threadIdx.x; asm volatile("" : "+v"(tid));
    const int lane = tid & 63, gw = bid * NWAVES + (tid >> 6);
    for (int t = gw; t < SEQ; t += G * NWAVES) final_row(p, t, lane);
}

constexpr int CW_BAR = 4096;
constexpr size_t CTL_ZERO_BYTES = 32768;
#define XB_TMO      128
#define XB_XCNT(j)  (256  + 64 * (j))
#define XB_XSUB(j)  (1280 + 64 * (j))
#define XB_XGEN(j)  (2304 + 64 * (j))
#define XB_TOP      3328
#define XB_TOPGEN   3392
#define XCD_BAR_WORDS 3456
#define XB_SPIN_CAP (1u << 22)
static_assert((CW_BAR + XCD_BAR_WORDS) * 4 <= (int)CTL_ZERO_BYTES, "barrier words inside the memset region");
__device__ __forceinline__ unsigned xb_ld(unsigned* p)              { return __hip_atomic_load(p, __ATOMIC_RELAXED, __HIP_MEMORY_SCOPE_AGENT); }
__device__ __forceinline__ unsigned xb_add(unsigned* p, unsigned v) { return __hip_atomic_fetch_add(p, v, __ATOMIC_RELAXED, __HIP_MEMORY_SCOPE_AGENT); }
__device__ __forceinline__ unsigned xb_xcc_id() { return (unsigned)__builtin_amdgcn_s_getreg((3 << 11) | 20) & 0xFu; }
#define XB_SPIN(cond, bar) do { unsigned _sp = 0; while (cond) { __builtin_amdgcn_s_sleep(1); \
    if ((++_sp & 255u) == 0u) { if (xb_ld(&(bar)[XB_TMO])) break; if (_sp > XB_SPIN_CAP) { atomicAdd(&(bar)[XB_TMO], 1u); break; } } } } while (0)
struct XcdBarrier { unsigned* bar; unsigned x; volatile LAS unsigned* st; };
__device__ __forceinline__ XcdBarrier xcd_barrier_post(unsigned* bar, volatile LAS unsigned* st) {
    XcdBarrier b; b.bar = bar; b.x = xb_xcc_id(); b.st = st;
    if (threadIdx.x == 0) (void)xb_add(&bar[XB_XCNT(b.x)], 1u);
    return b;
}
__device__ __forceinline__ void xcd_barrier_complete(unsigned* bar, unsigned x, unsigned& nloc, unsigned& nx) {
    const unsigned G = gridDim.x * gridDim.y * gridDim.z;
    unsigned sum, cnt, mine, sp = 0u;
    for (;;) {
        sum = 0u; cnt = 0u; mine = 0u;
#pragma unroll
        for (unsigned j = 0; j < 16; ++j) { const unsigned c = xb_ld(&bar[XB_XCNT(j)]); sum += c; cnt += (c > 0u) ? 1u : 0u; mine = (j == x) ? c : mine; }
        if (sum == G) break;
        __builtin_amdgcn_s_sleep(1);
        if ((++sp & 255u) == 0u) { if (xb_ld(&bar[XB_TMO])) break; if (sp > XB_SPIN_CAP) { atomicAdd(&bar[XB_TMO], 1u); break; } }
    }
    nloc = mine > 0u ? mine : 1u; nx = cnt > 0u ? cnt : 1u;
}
__device__ __forceinline__ void xcd_barrier(const XcdBarrier& b) {
    asm volatile("s_waitcnt vmcnt(0)" ::: "memory");
    __syncthreads();
    if (threadIdx.x == 0) {
        unsigned* bar = b.bar;
        __builtin_amdgcn_s_waitcnt(0);
        unsigned nloc = b.st[0], nx = b.st[1];
        if (nloc == 0u) { xcd_barrier_complete(bar, b.x, nloc, nx); b.st[0] = nloc; b.st[1] = nx; }
        const unsigned old = xb_add(&bar[XB_XSUB(b.x)], 1u);
        const unsigned gen = old / nloc;
        if (old + 1u == (gen + 1u) * nloc) {
            __builtin_amdgcn_fence(__ATOMIC_RELEASE, "agent");
            asm volatile("s_waitcnt vmcnt(0)" ::: "memory");
            const unsigned og = xb_add(&bar[XB_TOP], 1u);
            const unsigned tg = og / nx;
            if (og + 1u == (tg + 1u) * nx) xb_add(&bar[XB_TOPGEN], 1u);
            else XB_SPIN(xb_ld(&bar[XB_TOPGEN]) == tg, bar);
            __builtin_amdgcn_fence(__ATOMIC_ACQUIRE, "agent");
            xb_add(&bar[XB_XGEN(b.x)], 1u);
            asm volatile("s_waitcnt vmcnt(0)" ::: "memory");
        } else {
            XB_SPIN(xb_ld(&bar[XB_XGEN(b.x)]) == gen, bar);
            __builtin_amdgcn_fence(__ATOMIC_ACQUIRE, "agent");
            asm volatile("s_waitcnt vmcnt(0)" ::: "memory");
        }
    }
    __syncthreads();
}

constexpr int P_OFF = MISC_OFF + 128;
static_assert(P_OFF + 50 * 4 <= LDS_BYTES, "P copy inside the LDS control area");
__device__ __forceinline__ unsigned long long lds_u64_uniform(const volatile LAS unsigned long long* s, int i) {
    const unsigned long long v = s[i];
    return ((unsigned long long)(unsigned)__builtin_amdgcn_readfirstlane((int)(unsigned)(v >> 32)) << 32) | (unsigned long long)(unsigned)__builtin_amdgcn_readfirstlane((int)(unsigned)v);
}
__device__ __forceinline__ P load_P(LAS unsigned char* lds) {
    const volatile LAS unsigned long long* s = (const volatile LAS unsigned long long*)(lds + P_OFF);
    P q;
    q.x = (const float*)(const GAS float*)lds_u64_uniform(s, 0); q.meta = (const float*)(const GAS float*)lds_u64_uniform(s, 1); q.g1 = (const float*)(const GAS float*)lds_u64_uniform(s, 2); q.w_in = (const float*)(const GAS float*)lds_u64_uniform(s, 3);
    q.b_f = (const float*)(const GAS float*)lds_u64_uniform(s, 4); q.w2 = (const float*)(const GAS float*)lds_u64_uniform(s, 5); q.bg = (const float*)(const GAS float*)lds_u64_uniform(s, 6); q.gla_g = (const float*)(const GAS float*)lds_u64_uniform(s, 7);
    q.fox_g = (const float*)(const GAS float*)lds_u64_uniform(s, 8); q.w_out = (const float*)(const GAS float*)lds_u64_uniform(s, 9); q.g2 = (const float*)(const GAS float*)lds_u64_uniform(s, 10); q.w_rg = (const float*)(const GAS float*)lds_u64_uniform(s, 11);
    q.b_rg = (const float*)(const GAS float*)lds_u64_uniform(s, 12); q.w_re = (const float*)(const GAS float*)lds_u64_uniform(s, 13); q.b_re = (const float*)(const GAS float*)lds_u64_uniform(s, 14); q.wg = (const float*)(const GAS float*)lds_u64_uniform(s, 15);
    q.wu = (const float*)(const GAS float*)lds_u64_uniform(s, 16); q.wd = (const float*)(const GAS float*)lds_u64_uniform(s, 17); q.gf = (const float*)(const GAS float*)lds_u64_uniform(s, 18); q.out = (float*)(GAS float*)lds_u64_uniform(s, 19);
    q.ws = (unsigned char*)(GAS unsigned char*)lds_u64_uniform(s, 20);
    return q;
}
__global__ void __launch_bounds__(512, 2) k_mega(P p) {
    extern __shared__ __attribute__((aligned(16))) unsigned char lds_raw[];
    LAS unsigned char* lds = (LAS unsigned char*)lds_raw;
    for (int u = threadIdx.x; u < (LDS_BYTES - LDSCTL_OFF) / 4; u += 512) ((LAS unsigned*)(lds + LDSCTL_OFF))[u] = 0u;
    __syncthreads();
    if (threadIdx.x == 0) { LAS unsigned long long* s = (LAS unsigned long long*)(lds + P_OFF);
        s[0] = (unsigned long long)p.x; s[1] = (unsigned long long)p.meta; s[2] = (unsigned long long)p.g1; s[3] = (unsigned long long)p.w_in; s[4] = (unsigned long long)p.b_f;
        s[5] = (unsigned long long)p.w2; s[6] = (unsigned long long)p.bg; s[7] = (unsigned long long)p.gla_g; s[8] = (unsigned long long)p.fox_g; s[9] = (unsigned long long)p.w_out;
        s[10] = (unsigned long long)p.g2; s[11] = (unsigned long long)p.w_rg; s[12] = (unsigned long long)p.b_rg; s[13] = (unsigned long long)p.w_re; s[14] = (unsigned long long)p.b_re;
        s[15] = (unsigned long long)p.wg; s[16] = (unsigned long long)p.wu; s[17] = (unsigned long long)p.wd; s[18] = (unsigned long long)p.gf; s[19] = (unsigned long long)p.out;
        s[20] = (unsigned long long)p.ws; }
    if (threadIdx.x == 0) ((LAS int*)(lds + P_OFF))[48] = (int)gridDim.x;
    (void)xcd_barrier_post((unsigned*)(p.ws + OFF_CTL) + CW_BAR, (volatile LAS unsigned*)(lds + MISC_OFF) + 8);
    __syncthreads();
#define LOAD_G() __builtin_amdgcn_readfirstlane(((const volatile LAS int*)(lds + P_OFF))[48])
#define BARRIER() do { XcdBarrier b_; b_.bar = (unsigned*)((unsigned char*)(GAS unsigned char*)lds_u64_uniform((const volatile LAS unsigned long long*)(lds + P_OFF), 20) + OFF_CTL) + CW_BAR; b_.x = xb_xcc_id(); \
        b_.st = (volatile LAS unsigned*)(lds + MISC_OFF) + 8; xcd_barrier(b_); } while (0)
#define DUPVAL() ((int)__builtin_amdgcn_readfirstlane(((const volatile unsigned*)((unsigned char*)(GAS unsigned char*)lds_u64_uniform((const volatile LAS unsigned long long*)(lds + P_OFF), 20) + OFF_CTL))[64]))
#define RUN(k, body) do { { const P q = load_P(lds); const int G = LOAD_G(), bid = blockIdx.x; body; } BARRIER(); \
        if (DUP_PHASE < 0 || DUP_PHASE == (k)) { if (DUP_PHASE == (k) || DUPVAL() == (k)) { { const P q = load_P(lds); const int G = LOAD_G(), bid = blockIdx.x; body; } BARRIER(); } } } while (0)
    RUN(1, phase_prep(q, lds, bid, G));
    RUN(2, phase_inproj(q, lds, G, bid));
    RUN(3, { phase_cscan(q, lds_raw, G, bid); phase_norms(q, lds_raw, G, bid); phase_gla_p1(q, lds_raw, G, bid); });
    RUN(5, { phase_gla_scan(q, G, bid); phase_fox(q, lds_raw, G, bid); });
    RUN(9, phase_gla_p3(q, lds_raw, G, bid));
    RUN(6, phase_outproj(q, lds, G, bid));
    RUN(100, phase_router(q, lds_raw, G, bid));
    RUN(7, phase_moe<0>(q, lds, G, bid));
    RUN(8, phase_moe<1>(q, lds, G, bid));
    RUN(10, phase_moe<2>(q, lds, G, bid));
#undef RUN
    { const P q = load_P(lds); const int G = LOAD_G(), bid = blockIdx.x; phase_final(q, G, bid); }
}

extern "C" void kernel_launch(void* const* d_in, const int* in_sizes, int n_in, void* d_out, int out_size, void* d_ws, size_t ws_size, hipStream_t stream) {
    static int grid = 0;
    if (grid == 0) {
        if (n_in != 19 || ws_size < WS_END2) { fprintf(stderr, "kernel_launch: bad args n_in=%d ws=%zu need %zu\n", n_in, ws_size, (size_t)WS_END2); grid = -1; return; }
        int dev = 0, cus = 0, per_cu = 0;
        if (hipGetDevice(&dev) != hipSuccess || hipDeviceGetAttribute(&cus, hipDeviceAttributeMultiprocessorCount, dev) != hipSuccess || cus <= 0) { fprintf(stderr, "kernel_launch: device query failed\n"); grid = -1; return; }
        if (hipFuncSetAttribute((const void*)k_mega, hipFuncAttributeMaxDynamicSharedMemorySize, LDS_BYTES) != hipSuccess) { fprintf(stderr, "kernel_launch: hipFuncSetAttribute failed\n"); grid = -1; return; }
        if (hipOccupancyMaxActiveBlocksPerMultiprocessor(&per_cu, (const void*)k_mega, 512, LDS_BYTES) != hipSuccess || per_cu < 1) { fprintf(stderr, "kernel_launch: occupancy query says %d blocks per CU\n", per_cu); (void)hipGetLastError(); grid = -1; return; }
        grid = cus;
    }
    if (grid < 0) return;
    P p{};
    p.x = (const float*)d_in[0]; p.meta = (const float*)d_in[1]; p.g1 = (const float*)d_in[2]; p.w_in = (const float*)d_in[3]; p.b_f = (const float*)d_in[4];
    p.w2 = (const float*)d_in[5]; p.bg = (const float*)d_in[6]; p.gla_g = (const float*)d_in[7]; p.fox_g = (const float*)d_in[8]; p.w_out = (const float*)d_in[9];
    p.g2 = (const float*)d_in[10]; p.w_rg = (const float*)d_in[11]; p.b_rg = (const float*)d_in[12]; p.w_re = (const float*)d_in[13]; p.b_re = (const float*)d_in[14];
    p.wg = (const float*)d_in[15]; p.wu = (const float*)d_in[16]; p.wd = (const float*)d_in[17]; p.gf = (const float*)d_in[18];
    p.out = (float*)d_out; p.ws = (unsigned char*)d_ws;
    (void)hipMemsetAsync((char*)d_ws + OFF_CTL, 0, CTL_ZERO_BYTES, stream);
    if (DUP_PHASE < 0) (void)hipMemsetAsync((char*)d_ws + OFF_CTL + 256, -DUP_PHASE - 1, 1, stream);
    hipLaunchKernelGGL(k_mega, dim3(grid), dim3(512), LDS_BYTES, stream, p);
}
```
